# Optimizing an MI355X kernel written in HIP

```python
import jax, jax.numpy as jnp
from jax import lax
import numpy as np

D_MODEL = 1024
BATCH = 16
SEQ = 2048
DEPTH = 4

HEAD_DIM = 64
ATT_WIDTH = D_MODEL // 2
CONV_WIDTH = D_MODEL - ATT_WIDTH
N_ATT_HEADS = ATT_WIDTH // HEAD_DIM
N_KV_GROUPS = 2
HEADS_PER_GROUP = N_ATT_HEADS // N_KV_GROUPS
CONV_K = 3
CMP_BLOCK = 32
CMP_STRIDE = 16
SEL_BLOCK = 64
N_SEL = 8
WINDOW = 512
Q_BLOCK = 128
D_FF = 2816
N_SUB = 3
EPS = 1e-6
NEG_INF = -1e30
FORCE_BONUS = 1e4
Q_COLS = N_ATT_HEADS * HEAD_DIM
KV_COLS = N_KV_GROUPS * HEAD_DIM
GATE_COLS = 3 * N_ATT_HEADS
IN_COLS = Q_COLS + 6 * KV_COLS + GATE_COLS + 3 * CONV_WIDTH

kernel_name = 'hymba_nsa_shortconv_macaron_adaln'


def rms_norm(x, g):
    xf = x.astype(jnp.float32)
    y = xf * lax.rsqrt(jnp.mean(xf * xf, axis=-1, keepdims=True) + EPS)
    return (y * g.astype(jnp.float32)).astype(x.dtype)


def pre_norm(x, g, shift, scale):
    return rms_norm(x, g) * (1 + scale[:, None, :]) + shift[:, None, :]


def swiglu(h, w_in, w_out):
    gate, up = jnp.split(h @ w_in, 2, axis=-1)
    return (jax.nn.silu(gate) * up) @ w_out


def masked_softmax(s, mask):
    s = jnp.where(mask, s.astype(jnp.float32), NEG_INF)
    return jax.nn.softmax(s, axis=-1)


def compress_blocks(k, pos, w1, w2):
    b, s, g, dh = k.shape
    nc = (s - CMP_BLOCK) // CMP_STRIDE + 1
    idx = jnp.arange(nc)[:, None] * CMP_STRIDE + jnp.arange(CMP_BLOCK)[None, :]
    blk = k[:, idx] + pos[None, None, :, None, :]
    flat = blk.transpose(0, 1, 3, 2, 4).reshape(b, nc, g, CMP_BLOCK * dh)
    return jax.nn.silu(flat @ w1) @ w2


def nsa_attention(q, kc, vc, ks, vs, kw, vw, gates, cmp_pos, w_cmp1, w_cmp2):
    b, s = q.shape[:2]
    q = q.reshape(b, s, N_KV_GROUPS, HEADS_PER_GROUP, HEAD_DIM) * (HEAD_DIM ** -0.5)
    t = jnp.arange(s)

    kcmp = compress_blocks(kc, cmp_pos[0], w_cmp1[0], w_cmp2[0])
    vcmp = compress_blocks(vc, cmp_pos[1], w_cmp1[1], w_cmp2[1])
    nc = kcmp.shape[1]
    blk_end = jnp.arange(nc) * CMP_STRIDE + CMP_BLOCK - 1
    cmp_mask = blk_end[None, :] <= t[:, None]
    p_cmp = masked_softmax(jnp.einsum('bsghd,bngd->bghsn', q, kcmp), cmp_mask)
    p_cmp = jnp.where(cmp_mask, p_cmp, 0.0)
    o_cmp = jnp.einsum('bghsn,bngd->bsghd', p_cmp.astype(vcmp.dtype), vcmp)

    nb = s // SEL_BLOCK
    cs = jnp.arange(nc) * CMP_STRIDE
    js = jnp.arange(nb) * SEL_BLOCK
    overlap = ((cs[:, None] < js[None, :] + SEL_BLOCK) &
               (cs[:, None] + CMP_BLOCK > js[None, :])).astype(jnp.float32)
    imp = jnp.einsum('bghsn,nj->bgsj', p_cmp, overlap)
    cur = t // SEL_BLOCK
    jb = jnp.arange(nb)
    blk_ok = jb[None, :] <= cur[:, None]
    forced = ((jb[None, :] == 0) | (jb[None, :] == cur[:, None]) |
              (jb[None, :] == cur[:, None] - 1)).astype(jnp.float32)
    imp = jnp.where(blk_ok, imp + FORCE_BONUS * forced, NEG_INF)
    n_sel = min(N_SEL, nb)
    top_val, top_idx = lax.top_k(imp, n_sel)
    top_ok = top_val > 0.5 * NEG_INF

    ks_blk = ks.reshape(b, nb, SEL_BLOCK, N_KV_GROUPS, HEAD_DIM).transpose(0, 3, 1, 2, 4)
    vs_blk = vs.reshape(b, nb, SEL_BLOCK, N_KV_GROUPS, HEAD_DIM).transpose(0, 3, 1, 2, 4)
    gather = jax.vmap(jax.vmap(lambda blocks, ids: blocks[ids]))
    kw_pad = jnp.pad(kw, ((0, 0), (WINDOW, 0), (0, 0), (0, 0)))
    vw_pad = jnp.pad(vw, ((0, 0), (WINDOW, 0), (0, 0), (0, 0)))
    n_keys = n_sel * SEL_BLOCK

    def query_block(i):
        t0 = i * Q_BLOCK
        tq = t0 + jnp.arange(Q_BLOCK)
        qc = lax.dynamic_slice_in_dim(q, t0, Q_BLOCK, axis=1)
        ic = lax.dynamic_slice_in_dim(top_idx, t0, Q_BLOCK, axis=2)
        okc = lax.dynamic_slice_in_dim(top_ok, t0, Q_BLOCK, axis=2)
        kg = gather(ks_blk, ic).reshape(b, N_KV_GROUPS, Q_BLOCK, n_keys, HEAD_DIM)
        vg = gather(vs_blk, ic).reshape(b, N_KV_GROUPS, Q_BLOCK, n_keys, HEAD_DIM)
        kpos = ic[..., None] * SEL_BLOCK + jnp.arange(SEL_BLOCK)
        sel_mask = ((kpos <= tq[:, None, None]) & okc[..., None]).reshape(
            b, N_KV_GROUPS, 1, Q_BLOCK, n_keys)
        p = masked_softmax(jnp.einsum('btghd,bgtkd->bghtk', qc, kg), sel_mask)
        o_sel = jnp.einsum('bghtk,bgtkd->btghd', p.astype(vg.dtype), vg)
        kwc = lax.dynamic_slice_in_dim(kw_pad, t0, Q_BLOCK + WINDOW, axis=1)
        vwc = lax.dynamic_slice_in_dim(vw_pad, t0, Q_BLOCK + WINDOW, axis=1)
        wpos = t0 - WINDOW + jnp.arange(Q_BLOCK + WINDOW)
        win_mask = ((wpos[None, :] <= tq[:, None]) & (wpos[None, :] > tq[:, None] - WINDOW) &
                    (wpos[None, :] >= 0))
        p = masked_softmax(jnp.einsum('btghd,bkgd->bghtk', qc, kwc), win_mask)
        o_win = jnp.einsum('bghtk,bkgd->btghd', p.astype(vwc.dtype), vwc)
        return o_sel, o_win

    o_sel, o_win = lax.map(query_block, jnp.arange(s // Q_BLOCK))

    def unblock(o):
        return o.transpose(1, 0, 2, 3, 4, 5).reshape(b, s, N_KV_GROUPS, HEADS_PER_GROUP, HEAD_DIM)

    g = jax.nn.sigmoid(gates.astype(jnp.float32)).astype(q.dtype).reshape(
        b, s, N_KV_GROUPS, HEADS_PER_GROUP, 3)
    o = g[..., 0:1] * o_cmp + g[..., 1:2] * unblock(o_sel) + g[..., 2:3] * unblock(o_win)
    return o.reshape(b, s, ATT_WIDTH)


def short_conv(h, b_gate, c_gate, conv_w, conv_b):
    u = c_gate * h
    s = u.shape[1]
    up = jnp.pad(u, ((0, 0), (CONV_K - 1, 0), (0, 0)))
    v = conv_b
    for k in range(CONV_K):
        v = v + up[:, k:k + s] * conv_w[k]
    return b_gate * v


def hybrid_mixer(h, w_in, cmp_pos, w_cmp1, w_cmp2, conv_w, conv_b, g_out, w_out):
    b, s, _ = h.shape
    z = h @ w_in
    sizes = [Q_COLS] + [KV_COLS] * 6 + [GATE_COLS] + [CONV_WIDTH] * 3
    offs = np.cumsum(sizes)[:-1].tolist()
    q, kc, vc, ks, vs, kw, vw, gates, hc, bg, cg = jnp.split(z, offs, axis=-1)

    def kv(a):
        return a.reshape(b, s, N_KV_GROUPS, HEAD_DIM)

    o_att = nsa_attention(q.reshape(b, s, N_ATT_HEADS, HEAD_DIM), kv(kc), kv(vc), kv(ks), kv(vs),
                          kv(kw), kv(vw), gates.reshape(b, s, N_ATT_HEADS, 3),
                          cmp_pos, w_cmp1, w_cmp2)
    o_conv = short_conv(hc, bg, cg, conv_w, conv_b)
    o = jnp.concatenate([rms_norm(o_att, g_out[:ATT_WIDTH]),
                         rms_norm(o_conv, g_out[ATT_WIDTH:])], axis=-1)
    return o @ w_out


def setup_inputs(seed: int = 0) -> dict:
    key = jax.random.key(seed)
    ks = jax.random.split(key, 16)

    def nrm(k, shape, s):
        return jax.random.normal(k, shape, jnp.float32) * s

    return {
        'x': nrm(ks[0], (BATCH, SEQ, D_MODEL), 1.0),
        'c': nrm(ks[1], (BATCH, D_MODEL), 1.0),
        'w_ada': nrm(ks[2], (DEPTH, D_MODEL, N_SUB * 3 * D_MODEL), D_MODEL ** -0.5),
        'b_ada': nrm(ks[3], (DEPTH, N_SUB * 3 * D_MODEL), 0.01),
        'g_norm': 1.0 + nrm(ks[4], (DEPTH, N_SUB, D_MODEL), 0.02),
        'w_ff_in': nrm(ks[5], (DEPTH, 2, D_MODEL, 2 * D_FF), D_MODEL ** -0.5),
        'w_ff_out': nrm(ks[6], (DEPTH, 2, D_FF, D_MODEL), D_FF ** -0.5),
        'w_mix_in': nrm(ks[7], (DEPTH, D_MODEL, IN_COLS), D_MODEL ** -0.5),
        'cmp_pos': nrm(ks[8], (DEPTH, 2, CMP_BLOCK, HEAD_DIM), 0.1),
        'w_cmp1': nrm(ks[9], (DEPTH, 2, CMP_BLOCK * HEAD_DIM, HEAD_DIM), (CMP_BLOCK * HEAD_DIM) ** -0.5),
        'w_cmp2': nrm(ks[10], (DEPTH, 2, HEAD_DIM, HEAD_DIM), HEAD_DIM ** -0.5),
        'conv_w': nrm(ks[11], (DEPTH, CONV_K, CONV_WIDTH), CONV_K ** -0.5),
        'conv_b': nrm(ks[12], (DEPTH, CONV_WIDTH), 0.01),
        'g_mix_out': 1.0 + nrm(ks[13], (DEPTH, D_MODEL), 0.02),
        'w_mix_out': nrm(ks[14], (DEPTH, D_MODEL, D_MODEL), D_MODEL ** -0.5),
        'g_final': 1.0 + nrm(ks[15], (D_MODEL,), 0.02),
    }


def reference(x, c, w_ada, b_ada, g_norm, w_ff_in, w_ff_out, w_mix_in, cmp_pos, w_cmp1, w_cmp2,
              conv_w, conv_b, g_mix_out, w_mix_out, g_final):
    bsz = c.shape[0]
    c_act = jax.nn.silu(c)
    for l in range(DEPTH):
        mod = (c_act @ w_ada[l] + b_ada[l]).reshape(bsz, N_SUB, 3, D_MODEL)
        h = pre_norm(x, g_norm[l, 0], mod[:, 0, 0], mod[:, 0, 1])
        x = x + 0.5 * mod[:, 0, 2][:, None, :] * swiglu(h, w_ff_in[l, 0], w_ff_out[l, 0])
        h = pre_norm(x, g_norm[l, 1], mod[:, 1, 0], mod[:, 1, 1])
        x = x + mod[:, 1, 2][:, None, :] * hybrid_mixer(
            h, w_mix_in[l], cmp_pos[l], w_cmp1[l], w_cmp2[l], conv_w[l], conv_b[l],
            g_mix_out[l], w_mix_out[l])
        h = pre_norm(x, g_norm[l, 2], mod[:, 2, 0], mod[:, 2, 1])
        x = x + 0.5 * mod[:, 2, 2][:, None, :] * swiglu(h, w_ff_in[l, 1], w_ff_out[l, 1])
    return rms_norm(x, g_final)
```

```cpp
#include <hip/hip_runtime.h>
#include <cstdio>
#include <cstdint>
namespace pg8 {
#define PG8_LAS __attribute__((address_space(3)))
typedef unsigned short bf16_t;
typedef short bf16x8 __attribute__((ext_vector_type(8)));
typedef float f32x4 __attribute__((ext_vector_type(4)));
typedef unsigned u32x4 __attribute__((ext_vector_type(4)));
constexpr int BM = 256, BK = 64, HALF = 128, HTB = HALF * BK * 2  , STAGE_BYTES = 8 * HTB, NXCD = 8, WGM = 8;

__host__ __device__ __forceinline__ int lds_byte(int r, int c) { const int st = (r >> 4) * 2 + (c >> 5), rr = r & 15, cc = c & 31, ob = rr * 64 + cc * 2; return st * 1024 + (ob ^ (((ob >> 9) & 1) << 5)); }
__host__ __device__ __forceinline__ void stage_rc(int b, int& R, int& C) { const int st = b / 1024, sb = b % 1024, swz = sb ^ (((sb >> 9) & 1) << 5); R = (st >> 1) * 16 + swz / 64; C = (st & 1) * 32 + (swz % 64) / 2; }
__host__ __device__ __forceinline__ int perm32(int rho) { const int n = rho >> 4, i = rho & 15; return 8 * (i >> 2) + 4 * n + (i & 3); }

__host__ __device__ __forceinline__ size_t tl_off(int row, int col, int K) { return ((size_t)((row >> 4) * (K >> 5) + (col >> 5)) << 10) + (size_t)(((row & 15) << 6) + ((col & 31) << 1)); }
struct Unit { int pm, pn; };
struct Gemm { const bf16_t* A; const bf16_t* Bt; int M, N, K; };

struct StaticOrder {
    int nM, nN, nwg, G, c;
    __host__ __device__ void init(int M, int N, int G_, int c_) { nM = M / BM; nN = N / BM; nwg = nM * nN; G = G_; c = c_; }
    __host__ __device__ bool next(int i, Unit& u) const {
        const long L = (long)i * G + c; if (L >= nwg) return false;
        int wgid = (int)L; { const int q = nwg / NXCD, r = nwg % NXCD, xcd = wgid % NXCD, off = wgid / NXCD; wgid = (xcd < r ? xcd * (q + 1) : r * (q + 1) + (xcd - r) * q) + off; }
        const int nig = WGM * nN, gid = wgid / nig, fm = gid * WGM, gsz = (nM - fm) < WGM ? (nM - fm) : WGM;
        u.pm = fm + ((wgid % nig) % gsz); u.pn = (wgid % nig) / gsz; return true;
    }
    __device__ __forceinline__ void a_ready(const Unit&) const {}
    __device__ __forceinline__ void done(const Unit&) const {}
};

#define PG8_GAS __attribute__((address_space(1)))
typedef float f32x2 __attribute__((ext_vector_type(2)));
typedef unsigned u32x2 __attribute__((ext_vector_type(2)));
typedef _Float16 f16x2_t __attribute__((ext_vector_type(2)));
__device__ __forceinline__ unsigned cvt_pk_f16(float lo, float hi) { f32x2 v = {lo, hi}; f16x2_t h = __builtin_convertvector(v, f16x2_t); return __builtin_bit_cast(unsigned, h); }
typedef _Float16 f16x4_t __attribute__((ext_vector_type(4)));
__device__ __forceinline__ f32x4 unpack_f16x4(u32x2 w) { const f16x4_t h = __builtin_bit_cast(f16x4_t, w); return __builtin_convertvector(h, f32x4); }
typedef __bf16 bf16x2_t __attribute__((ext_vector_type(2)));
__device__ __forceinline__ unsigned cvt_pk_bf16(float lo, float hi) { f32x2 v = {lo, hi}; bf16x2_t b = __builtin_convertvector(v, bf16x2_t); return __builtin_bit_cast(unsigned, b); }
__device__ __forceinline__ float silu_f(float x) { return x * __builtin_amdgcn_rcpf(1.0f + __builtin_amdgcn_exp2f(-1.4426950408889634f * x)); }

__device__ __forceinline__ float xsum16(float s) { return s + __shfl_xor(s, 16); }
__device__ __forceinline__ float xsum32(float s) { const auto r = __builtin_amdgcn_permlane32_swap(__float_as_uint(s), __float_as_uint(s), false, false); return __uint_as_float(r[0]) + __uint_as_float(r[1]); }
__device__ __forceinline__ void xl_prefetch_consumer(const float* rowsq, const float* biasrow, int pm, PG8_LAS unsigned char* xl, int, int) {
    int t_ = threadIdx.x; asm volatile("" : "+v"(t_)); const int lane = t_ & 63, wid = __builtin_amdgcn_readfirstlane(t_ >> 6);
    const float* src = rowsq + ((size_t)pm * 256 + 32 * wid) * 16 + 4 * lane;
    __builtin_amdgcn_global_load_lds((const unsigned*)src, (PG8_LAS unsigned*)(xl + wid * 2048), 16, 0, 0);
    __builtin_amdgcn_global_load_lds((const unsigned*)(src + 256), (PG8_LAS unsigned*)(xl + wid * 2048 + 1024), 16, 0, 0);
    if (wid == 0) __builtin_amdgcn_global_load_lds((const unsigned*)(biasrow + 4 * lane), (PG8_LAS unsigned*)(xl + 16384), 16, 0, 0);
}
__device__ __forceinline__ void epi_loads(float (&rs)[2][4], f32x4 (&bv)[4], PG8_LAS unsigned char* xl, int wr, int wc, int fr, int fq) {
    const unsigned ra = (unsigned)(size_t)xl + (unsigned)((wr * 64 + fr) * 64 + fq * 16);
    const unsigned ba = (unsigned)(size_t)xl + 16384u + (unsigned)((wc * 32 + 8 * fq) * 4);
    f32x4 p[2][4];
    asm volatile("ds_read_b128 %0, %12\n\tds_read_b128 %1, %12 offset:1024\n\tds_read_b128 %2, %12 offset:2048\n\tds_read_b128 %3, %12 offset:3072\n\t"
                 "ds_read_b128 %4, %12 offset:8192\n\tds_read_b128 %5, %12 offset:9216\n\tds_read_b128 %6, %12 offset:10240\n\tds_read_b128 %7, %12 offset:11264\n\t"
                 "ds_read_b128 %8, %13\n\tds_read_b128 %9, %13 offset:16\n\tds_read_b128 %10, %13 offset:512\n\tds_read_b128 %11, %13 offset:528\n\t"
                 "s_waitcnt lgkmcnt(0)"
                 : "=&v"(p[0][0]), "=&v"(p[0][1]), "=&v"(p[0][2]), "=&v"(p[0][3]), "=&v"(p[1][0]), "=&v"(p[1][1]), "=&v"(p[1][2]), "=&v"(p[1][3]), "=&v"(bv[0]), "=&v"(bv[1]), "=&v"(bv[2]), "=&v"(bv[3])
                 : "v"(ra), "v"(ba) : "memory");
#pragma unroll
    for (int ai = 0; ai < 2; ++ai)
#pragma unroll
        for (int m = 0; m < 4; ++m) { float s = (p[ai][m][0] + p[ai][m][1]) + (p[ai][m][2] + p[ai][m][3]); s = xsum32(xsum16(s)); rs[ai][m] = __builtin_amdgcn_rsqf(s * (1.0f / 1024.0f) + 1e-6f); }
}
__device__ __forceinline__ void zero4(f32x4& v) { float a, b, c, d;
    asm volatile("v_mov_b32 %0, 0\n\tv_mov_b32 %1, 0\n\tv_mov_b32 %2, 0\n\tv_mov_b32 %3, 0" : "=v"(a), "=v"(b), "=v"(c), "=v"(d)); v = (f32x4){a, b, c, d}; }
struct EpiBf16Plain {
    static constexpr bool PERM = true, AFTER_DRAIN = false, PREFETCH = true, MIDSCALE = false; static constexpr bool KSERP = true;
    __device__ __forceinline__ void prefetch(const Unit& u, PG8_LAS unsigned char* xl, int wid, int lane) const { xl_prefetch_consumer(rowsq, bias + (size_t)(u.pm >> 3) * bias_stride + u.pn * BM, u.pm, xl, wid, lane); }
    bf16_t* O; int ldc; const float* rowsq; const float* bias; int bias_stride; int qtiles;
    static constexpr float QSCALE = 0.125f * 1.4426950408889634f;
    __device__ __forceinline__ void operator()(f32x4 (&acc)[2][2][4][2], const Unit& u, int wr, int wc, int fr, int fq, PG8_LAS unsigned char* xl) const {
        const int row0 = u.pm * BM + wr * 64 + fr; const int col0 = u.pn * BM + wc * 32 + 8 * fq;
        const float* bp = bias + (size_t)(u.pm >> 3) * bias_stride + col0;
        f32x4 bvl[4]; float rsv[2][4]; epi_loads(rsv, bvl, xl, wr, wc, fr, fq);
        if (u.pn < qtiles) {
#pragma unroll
            for (int i = 0; i < 4; ++i) bvl[i] *= QSCALE;
#pragma unroll
            for (int ai = 0; ai < 2; ++ai)
#pragma unroll
                for (int m = 0; m < 4; ++m) rsv[ai][m] *= QSCALE; }
#pragma unroll
        for (int ai = 0; ai < 2; ++ai)
#pragma unroll
            for (int m = 0; m < 4; ++m) { const int row = row0 + ai * HALF + m * 16; const float rs = rsv[ai][m];
#pragma unroll
                for (int bj = 0; bj < 2; ++bj) { const f32x4 v0 = acc[ai][bj][m][0] * rs + bvl[2 * bj], v1 = acc[ai][bj][m][1] * rs + bvl[2 * bj + 1];
                    zero4(acc[ai][bj][m][0]); zero4(acc[ai][bj][m][1]);
                    u32x4 w; w.x = cvt_pk_bf16(v0[0], v0[1]); w.y = cvt_pk_bf16(v0[2], v0[3]); w.z = cvt_pk_bf16(v1[0], v1[1]); w.w = cvt_pk_bf16(v1[2], v1[3]);
                    *(PG8_GAS u32x4*)((char*)O + tl_off(row, col0 + bj * HALF, ldc)) = w; } }
    }
};
struct EpiSwiGLU {
    static constexpr bool PERM = true, AFTER_DRAIN = false, PREFETCH = true, MIDSCALE = false; static constexpr bool KSERP = true;
    __device__ __forceinline__ void prefetch(const Unit& u, PG8_LAS unsigned char* xl, int wid, int lane) const { xl_prefetch_consumer(rowsq, bias + (size_t)(u.pm >> 3) * bias_stride + u.pn * BM, u.pm, xl, wid, lane); }
    bf16_t* O; int ldo; const float* rowsq; const float* bias; int bias_stride;
    __device__ __forceinline__ void operator()(f32x4 (&acc)[2][2][4][2], const Unit& u, int wr, int wc, int fr, int fq, PG8_LAS unsigned char* xl) const {
        const int row0 = u.pm * BM + wr * 64 + fr; const int col0 = u.pn * HALF + wc * 32 + 8 * fq;
        const float* bp = bias + (size_t)(u.pm >> 3) * bias_stride + u.pn * BM + wc * 32 + 8 * fq;
        f32x4 bvl[4]; float rsv[2][4]; epi_loads(rsv, bvl, xl, wr, wc, fr, fq);
        const f32x4 bg0 = bvl[0], bg1 = bvl[1], bu0 = bvl[2], bu1 = bvl[3];
#pragma unroll
        for (int ai = 0; ai < 2; ++ai)
#pragma unroll
            for (int m = 0; m < 4; ++m) { const int row = row0 + ai * HALF + m * 16; const float rs = rsv[ai][m]; bf16_t* rowp = (bf16_t*)((char*)O + tl_off(row, col0, ldo));
                const f32x4 g0 = acc[ai][0][m][0] * rs + bg0, g1 = acc[ai][0][m][1] * rs + bg1, u0 = acc[ai][1][m][0] * rs + bu0, u1 = acc[ai][1][m][1] * rs + bu1;
                zero4(acc[ai][0][m][0]); zero4(acc[ai][0][m][1]); zero4(acc[ai][1][m][0]); zero4(acc[ai][1][m][1]);
                u32x4 w;
                w.x = cvt_pk_bf16(silu_f(g0[0]) * u0[0], silu_f(g0[1]) * u0[1]); w.y = cvt_pk_bf16(silu_f(g0[2]) * u0[2], silu_f(g0[3]) * u0[3]);
                w.z = cvt_pk_bf16(silu_f(g1[0]) * u1[0], silu_f(g1[1]) * u1[1]); w.w = cvt_pk_bf16(silu_f(g1[2]) * u1[2], silu_f(g1[3]) * u1[3]);
                *(PG8_GAS u32x4*)rowp = w; }
    }
};
struct EpiResid {
    static constexpr bool PERM = true, AFTER_DRAIN = false, PREFETCH = true, MIDSCALE = false; static constexpr bool KSERP = true;
    __device__ __forceinline__ void prefetch(const Unit& u, PG8_LAS unsigned char* xl, int, int) const {
        int t_ = threadIdx.x; asm volatile("" : "+v"(t_)); const int lane = t_ & 63, wid = __builtin_amdgcn_readfirstlane(t_ >> 6);
        if (wid == 0) __builtin_amdgcn_global_load_lds((const unsigned*)(gate + (size_t)(u.pm >> 3) * mod_stride + u.pn * BM + 4 * lane), (PG8_LAS unsigned*)(xl), 16, 0, 0);
        if (wid == 1) __builtin_amdgcn_global_load_lds((const unsigned*)(gn + u.pn * BM + 4 * lane), (PG8_LAS unsigned*)(xl + 1024), 16, 0, 0);
        if (wid == 2) __builtin_amdgcn_global_load_lds((const unsigned*)(scale + (size_t)(u.pm >> 3) * mod_stride + u.pn * BM + 4 * lane), (PG8_LAS unsigned*)(xl + 2048), 16, 0, 0);
    }
    unsigned* x16;   const float* gate; bf16_t* hs; const float* gn; const float* scale; float* rowsq; int mod_stride; float coef;
    __device__ __forceinline__ void operator()(f32x4 (&acc)[2][2][4][2], const Unit& u, int wr, int wc, int fr, int fq, PG8_LAS unsigned char* xl) const {
        const int row0 = u.pm * BM + wr * 64 + fr; const int col0 = u.pn * BM + wc * 32 + 8 * fq;
        f32x4 gv[2][2], av[2][2];
        { f32x4 sv[2][2]; const unsigned la = (unsigned)(size_t)xl + (unsigned)((wc * 32 + 8 * fq) * 4);
          asm volatile("ds_read_b128 %0, %12\n\tds_read_b128 %1, %12 offset:16\n\tds_read_b128 %2, %12 offset:512\n\tds_read_b128 %3, %12 offset:528\n\t"
                       "ds_read_b128 %4, %12 offset:1024\n\tds_read_b128 %5, %12 offset:1040\n\tds_read_b128 %6, %12 offset:1536\n\tds_read_b128 %7, %12 offset:1552\n\t"
                       "ds_read_b128 %8, %12 offset:2048\n\tds_read_b128 %9, %12 offset:2064\n\tds_read_b128 %10, %12 offset:2560\n\tds_read_b128 %11, %12 offset:2576\n\t"
                       "s_waitcnt lgkmcnt(0)"
                       : "=&v"(gv[0][0]), "=&v"(gv[0][1]), "=&v"(gv[1][0]), "=&v"(gv[1][1]), "=&v"(av[0][0]), "=&v"(av[0][1]), "=&v"(av[1][0]), "=&v"(av[1][1]), "=&v"(sv[0][0]), "=&v"(sv[0][1]), "=&v"(sv[1][0]), "=&v"(sv[1][1])
                       : "v"(la) : "memory");
#pragma unroll
          for (int bj = 0; bj < 2; ++bj)
#pragma unroll
              for (int n = 0; n < 2; ++n) { gv[bj][n] = gv[bj][n] * coef; av[bj][n] = av[bj][n] * (sv[bj][n] + 1.0f); } }
        u32x4 xa[2], xb[2], xc[2]; float sqv[8];
#define EPR_LOAD(dst, rg) do { const int rw_ = row0 + ((rg) >> 2) * HALF + ((rg) & 3) * 16; _Pragma("unroll") for (int bj = 0; bj < 2; ++bj) \
            dst[bj] = *(const PG8_GAS u32x4*)((const char*)x16 + tl_off(rw_, col0 + bj * HALF, 1024)); } while (0)
#define EPR_ROW(src, rg) do { const int ai_ = (rg) >> 2, m_ = (rg) & 3; const int rw_ = row0 + ai_ * HALF + m_ * 16; float sq_ = 0.f; \
            _Pragma("unroll") for (int bj = 0; bj < 2; ++bj) { const f32x4 x0 = unpack_f16x4((u32x2){src[bj].x, src[bj].y}) + gv[bj][0] * acc[ai_][bj][m_][0], x1 = unpack_f16x4((u32x2){src[bj].z, src[bj].w}) + gv[bj][1] * acc[ai_][bj][m_][1]; \
                { const u32x4 xw = {cvt_pk_f16(x0[0], x0[1]), cvt_pk_f16(x0[2], x0[3]), cvt_pk_f16(x1[0], x1[1]), cvt_pk_f16(x1[2], x1[3])}; *(PG8_GAS u32x4*)((char*)x16 + tl_off(rw_, col0 + bj * HALF, 1024)) = xw; } \
                sq_ += ((x0[0] * x0[0] + x0[1] * x0[1]) + (x0[2] * x0[2] + x0[3] * x0[3])) + ((x1[0] * x1[0] + x1[1] * x1[1]) + (x1[2] * x1[2] + x1[3] * x1[3])); \
                const f32x4 h0 = x0 * av[bj][0], h1 = x1 * av[bj][1]; const u32x4 w = {cvt_pk_bf16(h0[0], h0[1]), cvt_pk_bf16(h0[2], h0[3]), cvt_pk_bf16(h1[0], h1[1]), cvt_pk_bf16(h1[2], h1[3])}; \
                *(PG8_GAS u32x4*)((char*)hs + tl_off(rw_, col0 + bj * HALF, 1024)) = w; zero4(acc[ai_][bj][m_][0]); zero4(acc[ai_][bj][m_][1]); } \
            sqv[(rg)] = xsum32(xsum16(sq_)); } while (0)
        EPR_LOAD(xa, 0); EPR_LOAD(xb, 1);
        EPR_LOAD(xc, 2); EPR_ROW(xa, 0);
        EPR_LOAD(xa, 3); EPR_ROW(xb, 1);
        EPR_LOAD(xb, 4); EPR_ROW(xc, 2);
        EPR_LOAD(xc, 5); EPR_ROW(xa, 3);
        EPR_LOAD(xa, 6); EPR_ROW(xb, 4);
        EPR_LOAD(xb, 7); EPR_ROW(xc, 5);
        EPR_ROW(xa, 6);
        EPR_ROW(xb, 7);
#pragma unroll
        for (int j = 0; j < 2; ++j) { const float v_ = fq == 0 ? sqv[4 * j] : (fq == 1 ? sqv[4 * j + 1] : (fq == 2 ? sqv[4 * j + 2] : sqv[4 * j + 3]));
            *(PG8_GAS float*)(rowsq + (size_t)(row0 + j * HALF + fq * 16) * 16 + 4 * u.pn + wc) = v_; }
#undef EPR_LOAD
#undef EPR_ROW
    }
};


struct EpiResidMix : EpiResid {
    static constexpr bool MIDSCALE = true; static constexpr int MID_T = 8; static constexpr bool KSERP = false;
    const float* asq;
    __device__ __forceinline__ void prefetch(const Unit& u, PG8_LAS unsigned char* xl, int a_, int b_) const {
        EpiResid::prefetch(u, xl, a_, b_);
        int t_ = threadIdx.x; asm volatile("" : "+v"(t_)); const int lane = t_ & 63, wid = __builtin_amdgcn_readfirstlane(t_ >> 6);
        __builtin_amdgcn_global_load_lds((const unsigned*)(asq + ((size_t)u.pm * 256 + 32 * wid) * 8 + 4 * lane), (PG8_LAS unsigned*)(xl + 4096 + wid * 1024), 16, 0, 0);
    }
    __device__ __forceinline__ void midscale(f32x4 (&acc)[2][2][4][2], int wr, int fr, int fq, PG8_LAS unsigned char* xl) const {
        const unsigned la = (unsigned)(size_t)xl + 4096u + (unsigned)((wr * 64 + fr) * 32 + fq * 8);
        f32x2 p[2][4];
        asm volatile("ds_read_b64 %0, %8\n\tds_read_b64 %1, %8 offset:512\n\tds_read_b64 %2, %8 offset:1024\n\tds_read_b64 %3, %8 offset:1536\n\t"
                     "ds_read_b64 %4, %8 offset:4096\n\tds_read_b64 %5, %8 offset:4608\n\tds_read_b64 %6, %8 offset:5120\n\tds_read_b64 %7, %8 offset:5632\n\t"
                     "s_waitcnt lgkmcnt(0)"
                     : "=&v"(p[0][0]), "=&v"(p[0][1]), "=&v"(p[0][2]), "=&v"(p[0][3]), "=&v"(p[1][0]), "=&v"(p[1][1]), "=&v"(p[1][2]), "=&v"(p[1][3])
                     : "v"(la) : "memory");
#pragma unroll
        for (int ai = 0; ai < 2; ++ai)
#pragma unroll
            for (int m = 0; m < 4; ++m) { float sq = p[ai][m][0] + p[ai][m][1]; sq = xsum32(xsum16(sq)); const float r = __builtin_amdgcn_rsqf(sq * (1.0f / 512.0f) + 1e-6f);
#pragma unroll
                for (int bj = 0; bj < 2; ++bj)
#pragma unroll
                    for (int n = 0; n < 2; ++n) acc[ai][bj][m][n] *= r; }
    }
};
template <class Epi, class Sched, bool ALIGN_EPI = false, bool SP2 = false>
__device__ __forceinline__ void gemm_phase(PG8_LAS unsigned char* lds, const Gemm g, const Sched& S, const Epi& E) {
    int tid_ = threadIdx.x; asm volatile("" : "+v"(tid_)); const int tid = tid_, wid = __builtin_amdgcn_readfirstlane(tid >> 6), lane = tid & 63, wr = wid >> 2, wc = wid & 3, fr = lane & 15, fq = lane >> 4;
    const int K = g.K, nt = K / BK;
    unsigned voffA[2], voffB[2];
#pragma unroll
    for (int i = 0; i < 2; ++i) { int R, C; stage_rc(tid * 16 + i * 8192, R, C); const int Rb = Epi::PERM ? ((R & ~31) + perm32(R & 31)) : R;
        voffA[i] = (unsigned)tl_off(R, C, K); voffB[i] = (unsigned)tl_off(Rb, C, K); }
    const size_t kstep = (size_t)2048;
    const size_t hstep = (size_t)HALF * K * 2;
    const size_t tstep = 2 * hstep;
    const unsigned ldsw = (unsigned)wid * 1024u;
    const int aoff = lds_byte(wr * 64 + fr, fq * 8), boff = lds_byte(wc * 32 + fr, fq * 8);
#define PG8_SA(b, h) (((b) * 2 + (h)) * HTB)
#define PG8_SB(b, h) ((4 + (b) * 2 + (h)) * HTB)
#define PG8_STAGE(bufoff, gbase, voff) do { _Pragma("unroll") for (int _i = 0; _i < 2; ++_i) \
        __builtin_amdgcn_global_load_lds((const unsigned*)((const char*)(gbase) + (voff)[_i]), (PG8_LAS unsigned*)(lds + (bufoff) + ldsw + _i * 8192), 16, 0, 0); } while (0)
#define PG8_LDA(dst, b, h) do { _Pragma("unroll") for (int m = 0; m < 4; ++m) _Pragma("unroll") for (int k = 0; k < 2; ++k) dst[m][k] = *(const PG8_LAS bf16x8*)(lds + PG8_SA(b, h) + aoff + m * 2048 + k * 1024); } while (0)
#define PG8_LDB(dst, b, h) do { _Pragma("unroll") for (int n = 0; n < 2; ++n) _Pragma("unroll") for (int k = 0; k < 2; ++k) dst[n][k] = *(const PG8_LAS bf16x8*)(lds + PG8_SB(b, h) + boff + n * 2048 + k * 1024); } while (0)
#define PG8_MMA(ai, bj, At, Bt) do { __builtin_amdgcn_s_setprio(1); _Pragma("unroll") for (int m = 0; m < 4; ++m) _Pragma("unroll") for (int n = 0; n < 2; ++n) _Pragma("unroll") for (int k = 0; k < 2; ++k) \
        acc[ai][bj][m][n] = __builtin_amdgcn_mfma_f32_16x16x32_bf16(Bt[n][k], At[m][k], acc[ai][bj][m][n], 0, 0, 0); __builtin_amdgcn_s_setprio(0); } while (0)
#define PG8_WAIT_V(n) asm volatile("s_waitcnt vmcnt(" #n ")" ::: "memory")
#define PG8_WAIT_L(n) asm volatile("s_waitcnt lgkmcnt(" #n ")" ::: "memory")
#define PG8_BAR __builtin_amdgcn_s_barrier()
#define PG8_SCHED __builtin_amdgcn_sched_barrier(0)
    Unit cur, nxt; int ui = 0;
    if (!S.next(0, cur)) return;
    f32x4 acc[2][2][4][2];
#pragma unroll
    for (int a = 0; a < 2; ++a)
#pragma unroll
        for (int b = 0; b < 2; ++b)
#pragma unroll
            for (int m = 0; m < 4; ++m)
#pragma unroll
                for (int n = 0; n < 2; ++n) acc[a][b][m][n] = (f32x4){0.f, 0.f, 0.f, 0.f};
    bf16x8 At[4][2], B0[2][2], B1[2][2];
    const char* cA = (const char*)g.A + (size_t)cur.pm * tstep; const char* cB = (const char*)g.Bt + (size_t)cur.pn * tstep;
    S.a_ready(cur);
    if constexpr (Epi::PREFETCH) E.prefetch(cur, lds + STAGE_BYTES, wid, lane);
    if constexpr (SP2) {
        PG8_STAGE(PG8_SB(0, 0), cB, voffB); PG8_STAGE(PG8_SB(0, 1), cB + hstep, voffB); PG8_STAGE(PG8_SA(0, 0), cA, voffA); PG8_STAGE(PG8_SA(0, 1), cA + hstep, voffA);
        if (wr == 1) PG8_BAR;
        PG8_WAIT_V(2); PG8_BAR;
        PG8_STAGE(PG8_SB(1, 0), cB + kstep, voffB); PG8_STAGE(PG8_SA(1, 0), cA + kstep, voffA); PG8_STAGE(PG8_SB(1, 1), cB + hstep + kstep, voffB);
        PG8_WAIT_V(6); PG8_BAR;
    } else {
        PG8_STAGE(PG8_SB(0, 0), cB, voffB); PG8_STAGE(PG8_SA(0, 0), cA, voffA); PG8_STAGE(PG8_SB(0, 1), cB + hstep, voffB); PG8_STAGE(PG8_SA(0, 1), cA + hstep, voffA);
        if (wr == 1) PG8_BAR;
        PG8_WAIT_V(4); PG8_BAR;
        PG8_STAGE(PG8_SB(1, 0), cB + kstep, voffB); PG8_STAGE(PG8_SA(1, 0), cA + kstep, voffA); PG8_STAGE(PG8_SB(1, 1), cB + hstep + kstep, voffB);
        PG8_WAIT_V(6); PG8_BAR;
    }
    long ksc = (long)kstep;
    for (;;) {
        const bool has_next = S.next(ui + 1, nxt);
        const bool nrev = Epi::KSERP && has_next && (((ui + 1) & 1) != 0);
        const long ksn = has_next ? (nrev ? -(long)kstep : (long)kstep) : ksc;
        const size_t nofs = nrev ? (size_t)(nt - 1) * kstep : (size_t)0;
        const char* nA = has_next ? (const char*)g.A + (size_t)nxt.pm * tstep + nofs : cA; const char* nB = has_next ? (const char*)g.Bt + (size_t)nxt.pn * tstep + nofs : cB;
        for (int t = 0; t < nt; t += 2) {
            if constexpr (Epi::PREFETCH) { if (t == 2 && ui > 0) E.prefetch(cur, lds + STAGE_BYTES, wid, lane); }
            if constexpr (Epi::MIDSCALE) { if (t == Epi::MID_T) E.midscale(acc, wr, fr, fq, lds + STAGE_BYTES); }
            const bool last = (t == nt - 2);
            const char* a1 = cA + (long)(t + 1) * ksc;
            const char* a2 = last ? nA : cA + (long)(t + 2) * ksc; const char* b2 = last ? nB : cB + (long)(t + 2) * ksc;
            const long ks3 = last ? ksn : ksc;
            const char* a3 = a2 + ks3; const char* b3 = b2 + ks3;
            if (last && has_next) S.a_ready(nxt);
            if constexpr (SP2) {
            PG8_LDB(B0, 0, 0); PG8_LDB(B1, 0, 1); PG8_SCHED; PG8_LDA(At, 0, 0); PG8_STAGE(PG8_SA(1, 1), a1 + hstep, voffA);
            PG8_WAIT_V(8); PG8_WAIT_L(0); PG8_BAR; PG8_MMA(0, 0, At, B0); PG8_MMA(0, 1, At, B1); PG8_BAR; PG8_SCHED;
            PG8_LDA(At, 0, 1); PG8_STAGE(PG8_SB(0, 0), b2, voffB); PG8_STAGE(PG8_SB(0, 1), b2 + hstep, voffB); PG8_STAGE(PG8_SA(0, 0), a2, voffA);
            PG8_WAIT_V(8); PG8_WAIT_L(0); PG8_BAR; PG8_MMA(1, 0, At, B0); PG8_MMA(1, 1, At, B1); PG8_BAR; PG8_SCHED;
            PG8_LDB(B0, 1, 0); PG8_LDB(B1, 1, 1); PG8_SCHED; PG8_LDA(At, 1, 0); PG8_STAGE(PG8_SA(0, 1), a2 + hstep, voffA);
            PG8_WAIT_V(8); PG8_WAIT_L(0); PG8_BAR; PG8_MMA(0, 0, At, B0); PG8_MMA(0, 1, At, B1); PG8_BAR; PG8_SCHED;
            PG8_LDA(At, 1, 1); PG8_STAGE(PG8_SB(1, 0), b3, voffB); PG8_STAGE(PG8_SB(1, 1), b3 + hstep, voffB); PG8_STAGE(PG8_SA(1, 0), a3, voffA);
            PG8_WAIT_V(8); PG8_WAIT_L(0); PG8_BAR; PG8_MMA(1, 0, At, B0); PG8_MMA(1, 1, At, B1); PG8_BAR; PG8_SCHED;
            } else {
            PG8_LDB(B0, 0, 0); PG8_SCHED; PG8_LDA(At, 0, 0); PG8_STAGE(PG8_SA(1, 1), a1 + hstep, voffA);
            PG8_WAIT_L(8); PG8_BAR; PG8_WAIT_L(0); PG8_MMA(0, 0, At, B0); PG8_BAR; PG8_SCHED;
            PG8_LDB(B1, 0, 1); PG8_STAGE(PG8_SB(0, 0), b2, voffB);
            PG8_BAR; PG8_WAIT_L(0); PG8_MMA(0, 1, At, B1); PG8_BAR;
            PG8_LDA(At, 0, 1); PG8_STAGE(PG8_SA(0, 0), a2, voffA);
            PG8_BAR; PG8_WAIT_L(0); PG8_MMA(1, 0, At, B0); PG8_BAR; PG8_SCHED;
            PG8_STAGE(PG8_SB(0, 1), b2 + hstep, voffB);
            PG8_WAIT_V(6); PG8_BAR; PG8_MMA(1, 1, At, B1); PG8_BAR;
            PG8_LDB(B0, 1, 0); PG8_SCHED; PG8_LDA(At, 1, 0); PG8_STAGE(PG8_SA(0, 1), a2 + hstep, voffA);
            PG8_WAIT_L(8); PG8_BAR; PG8_WAIT_L(0); PG8_MMA(0, 0, At, B0); PG8_BAR; PG8_SCHED;
            PG8_LDB(B1, 1, 1); PG8_STAGE(PG8_SB(1, 0), b3, voffB);
            PG8_BAR; PG8_WAIT_L(0); PG8_MMA(0, 1, At, B1); PG8_BAR;
            PG8_LDA(At, 1, 1); PG8_STAGE(PG8_SA(1, 0), a3, voffA);
            PG8_BAR; PG8_WAIT_L(0); PG8_MMA(1, 0, At, B0); PG8_BAR; PG8_SCHED;
            PG8_STAGE(PG8_SB(1, 1), b3 + hstep, voffB);
            PG8_WAIT_V(6); PG8_BAR; PG8_MMA(1, 1, At, B1); PG8_BAR;
            }
        }
        if constexpr (ALIGN_EPI) { if (wr == 0) PG8_BAR; }
        if constexpr (!Epi::AFTER_DRAIN) { E(acc, cur, wr, wc, fr, fq, lds + STAGE_BYTES); S.done(cur); }
        if (!has_next) break;
        cur = nxt; cA = nA; cB = nB; ksc = ksn; ++ui;
        if constexpr (ALIGN_EPI) { if (wr == 1) PG8_BAR; }
    }
    PG8_WAIT_V(0);
    if constexpr (!ALIGN_EPI) { if (wr == 0) PG8_BAR; }
    PG8_BAR;
    if constexpr (Epi::AFTER_DRAIN) { E.fused(acc, cur, wr, wc, fr, fq, lds, wid, lane); S.done(cur); }
#undef PG8_SA
#undef PG8_SB
#undef PG8_STAGE
#undef PG8_LDA
#undef PG8_LDB
#undef PG8_MMA
#undef PG8_WAIT_V
#undef PG8_WAIT_L
#undef PG8_BAR
#undef PG8_SCHED
}
}
constexpr int NB = 16, SEQ = 2048, M = NB * SEQ, D = 1024, FF = 2816, NFI = 2 * FF, ZW = 3072, NIN = 2840, DEPTH = 4, MODW = 9216;
constexpr int ZKC = 512, ZVC = 640, ZKS = 768, ZVS = 896, ZKW = 1024, ZVW = 1152, ZHC = 1280, ZBG = 1792, ZCG = 2304, ZGT = 2816;
constexpr float EPS = 1e-6f;
constexpr float NEGB = -1e30f;
constexpr float C2 = 0.125f * 1.4426950408889634f;
constexpr float LOG2E = 1.4426950408889634f;

constexpr size_t MiB = 1u << 20;
constexpr size_t WS_CTL = 0, CTL_ZERO_BYTES = 64 * 1024;
constexpr size_t WS_MOD = 1 * MiB;
constexpr size_t WS_CB1 = 4 * MiB;
constexpr size_t WS_KCMP = 5 * MiB;
constexpr size_t WS_VCMP = 5 * MiB + 512 * 1024;
constexpr size_t WS_WC1T = 6 * MiB;
constexpr size_t WS_WMO = 8 * MiB;
constexpr size_t WS_WMI = 16 * MiB;
constexpr size_t WS_WFO = 40 * MiB;
constexpr size_t WS_WFI = 84 * MiB;
constexpr size_t WS_H = 172 * MiB;
constexpr size_t WS_ZB = 236 * MiB;
constexpr size_t WS_OATT = 428 * MiB;
constexpr size_t WS_SBW = 492 * MiB;
constexpr size_t WS_RSQ = 498 * MiB;
constexpr size_t WS_OMIX = 500 * MiB;
constexpr size_t WS_X = 564 * MiB;
constexpr size_t WS_ASQ = 628 * MiB;
constexpr size_t WS_END = 629 * MiB;
constexpr int CW_BAR = 4096;

constexpr int RING_BYTES = 131072;
constexpr int LDS_BYTES = 163840;
constexpr int CTRL_OFF = LDS_BYTES - 1024;
constexpr int MISC_OFF = CTRL_OFF + 320;

#define GAS __attribute__((address_space(1)))
#define LAS __attribute__((address_space(3)))
typedef unsigned short bf16;
typedef float f32x4 __attribute__((ext_vector_type(4)));
typedef float f32x16 __attribute__((ext_vector_type(16)));
typedef short bf16x8 __attribute__((ext_vector_type(8)));
typedef short s16x4 __attribute__((ext_vector_type(4)));
typedef unsigned u32x4 __attribute__((ext_vector_type(4)));
using pg8::u32x2;
typedef GAS unsigned gu32;
#define LBAR() do { asm volatile("s_waitcnt lgkmcnt(0)" ::: "memory"); __builtin_amdgcn_s_barrier(); asm volatile("" ::: "memory"); } while (0)
#define MFMA32(a, b, c) __builtin_amdgcn_mfma_f32_32x32x16_bf16((a), (b), (c), 0, 0, 0)
using pg8::cvt_pk_bf16;
using pg8::silu_f;

#define XB_TMO      128
#define XB_XCNT(j)  (256  + 64 * (j))
#define XB_XSUB(j)  (1280 + 64 * (j))
#define XB_XGEN(j)  (2304 + 64 * (j))
#define XB_TOP      3328
#define XB_TOPGEN   3392
#define XCD_BAR_WORDS 3456
#define XB_SPIN_CAP (1u << 18)

__device__ __forceinline__ unsigned xb_ld(unsigned* p)              { return __hip_atomic_load(p, __ATOMIC_RELAXED, __HIP_MEMORY_SCOPE_AGENT); }
__device__ __forceinline__ unsigned xb_add(unsigned* p, unsigned v) { return __hip_atomic_fetch_add(p, v, __ATOMIC_RELAXED, __HIP_MEMORY_SCOPE_AGENT); }
__device__ __forceinline__ unsigned xb_xcc_id() { return (unsigned)__builtin_amdgcn_s_getreg((3 << 11) | 20) & 0xFu; }
#define XB_SPIN(cond, bar) do { unsigned _sp = 0; while (cond) { __builtin_amdgcn_s_sleep(1); \
    if ((++_sp & 255u) == 0u) { if (xb_ld(&(bar)[XB_TMO])) break; if (_sp > XB_SPIN_CAP) { atomicAdd(&(bar)[XB_TMO], 1u); break; } } } } while (0)

struct XcdBarrier {
    unsigned* bar; unsigned x;
    volatile LAS unsigned* st;
};

__device__ __forceinline__ XcdBarrier xcd_barrier_post(unsigned* bar, volatile LAS unsigned* st) {
    XcdBarrier b; b.bar = bar; b.x = (unsigned)__builtin_amdgcn_readfirstlane((int)xb_xcc_id()); b.st = st;
    if (threadIdx.x == 0) (void)xb_add(&bar[XB_XCNT(b.x)], 1u);
    return b;
}
__device__ __forceinline__ void xcd_barrier_complete(unsigned* bar, unsigned x, unsigned& nloc, unsigned& nx) {
    const unsigned G = gridDim.x * gridDim.y * gridDim.z;
    unsigned sum, cnt, mine, sp = 0u;
    for (;;) {
        sum = 0u; cnt = 0u; mine = 0u;
#pragma unroll
        for (unsigned j = 0; j < 16; ++j) { const unsigned c = xb_ld(&bar[XB_XCNT(j)]); sum += c; cnt += (c > 0u) ? 1u : 0u; mine = (j == x) ? c : mine; }
        if (sum == G) break;
        __builtin_amdgcn_s_sleep(1);
        if ((++sp & 255u) == 0u) { if (xb_ld(&bar[XB_TMO])) break; if (sp > XB_SPIN_CAP) { atomicAdd(&bar[XB_TMO], 1u); break; } }
    }
    nloc = mine > 0u ? mine : 1u; nx = cnt > 0u ? cnt : 1u;
}

__device__ __forceinline__ void xcd_barrier(const XcdBarrier& b) {
    asm volatile("s_waitcnt vmcnt(0)" ::: "memory");
    __syncthreads();
    if (threadIdx.x == 0) {
        unsigned* bar = b.bar;
        __builtin_amdgcn_s_waitcnt(0);
        unsigned nloc = b.st[0], nx = b.st[1];
        if (nloc == 0u) { xcd_barrier_complete(bar, b.x, nloc, nx); b.st[0] = nloc; b.st[1] = nx; }
        const unsigned old = xb_add(&bar[XB_XSUB(b.x)], 1u);
        const unsigned gen = old / nloc;
        if (old + 1u == (gen + 1u) * nloc) {
            __builtin_amdgcn_fence(__ATOMIC_RELEASE, "agent");
            asm volatile("s_waitcnt vmcnt(0)" ::: "memory");
            const unsigned og = xb_add(&bar[XB_TOP], 1u);
            const unsigned tg = og / nx;
            if (og + 1u == (tg + 1u) * nx) xb_add(&bar[XB_TOPGEN], 1u);
            else XB_SPIN(xb_ld(&bar[XB_TOPGEN]) == tg, bar);
            __builtin_amdgcn_fence(__ATOMIC_ACQUIRE, "agent");
            xb_add(&bar[XB_XGEN(b.x)], 1u);
            asm volatile("s_waitcnt vmcnt(0)" ::: "memory");
        } else {
            XB_SPIN(xb_ld(&bar[XB_XGEN(b.x)]) == gen, bar);
            __builtin_amdgcn_fence(__ATOMIC_ACQUIRE, "agent");
            asm volatile("s_waitcnt vmcnt(0)" ::: "memory");
        }
    }
    __syncthreads();
}

__device__ __forceinline__ float shx(float v, int mask, int lane) { return __builtin_bit_cast(float, __builtin_amdgcn_ds_bpermute((lane ^ mask) << 2, __builtin_bit_cast(int, v))); }
__device__ __forceinline__ float max32x(float v) { const auto r = __builtin_amdgcn_permlane32_swap(__float_as_uint(v), __float_as_uint(v), false, false); return fmaxf(__uint_as_float(r[0]), __uint_as_float(r[1])); }
__device__ __forceinline__ float sum32x(float v) { const auto r = __builtin_amdgcn_permlane32_swap(__float_as_uint(v), __float_as_uint(v), false, false); return __uint_as_float(r[0]) + __uint_as_float(r[1]); }
template <int CTRL> __device__ __forceinline__ float dpp_f(float v) { return __builtin_bit_cast(float, __builtin_amdgcn_update_dpp(0, __builtin_bit_cast(int, v), CTRL, 0xf, 0xf, true)); }
__device__ __forceinline__ float sum8_dpp(float s) { s += dpp_f<0xB1>(s); s += dpp_f<0x4E>(s); s += dpp_f<0x141>(s); return s; }
__device__ __forceinline__ float sum16x(float v) { const auto r = __builtin_amdgcn_permlane16_swap(__float_as_uint(v), __float_as_uint(v), false, false); return __uint_as_float(r[0]) + __uint_as_float(r[1]); }
__device__ __forceinline__ float sum64_dpp(float s) { s = sum8_dpp(s); s += dpp_f<0x140>(s); s = sum16x(s); return sum32x(s); }
__device__ __forceinline__ float wave_sum(float v, int lane) { (void)lane; return sum64_dpp(v); }
__device__ __forceinline__ const bf16* zt(const bf16* zb, int row, int col) { return (const bf16*)((const char*)zb + pg8::tl_off(row, col, ZW)); }
__device__ __forceinline__ float bf2f(unsigned short h) { return __uint_as_float((unsigned)h << 16); }
__device__ __forceinline__ float bflo(unsigned w) { return __uint_as_float(w << 16); }
__device__ __forceinline__ float bfhi(unsigned w) { return __uint_as_float(w & 0xffff0000u); }
__device__ __forceinline__ float sigmoid_f(float x) { return __builtin_amdgcn_rcpf(1.0f + __builtin_amdgcn_exp2f(-LOG2E * x)); }
__device__ __forceinline__ int crow(int r, int hi) { return (r & 3) + 8 * (r >> 2) + 4 * hi; }

__device__ __forceinline__ int dst_row(int mode, int n) {
    if (mode == 1) { return n < FF ? (n >> 7) * 256 + (n & 127) : ((n - FF) >> 7) * 256 + 128 + ((n - FF) & 127); }
    if (mode == 2) { return n < 1280 ? n : (n < 1304 ? ZGT + (n - 1280) : n - 24); }
    return n;
}
__device__ __forceinline__ void transpose_item(const float* W, int K, int N, bf16* WT, LAS float* scr, int item, int lane, int mode, bool tiled = true) {
    const int nblk = (N + 63) >> 6, kb = item / nblk, nb = item - kb * nblk, k0 = 64 * kb, n0 = 64 * nb;
    const int kr = lane >> 4, c4 = (lane & 15) * 4; const bool inb = (n0 + c4) < N;
    const float* src = W + (size_t)(k0 + kr) * N + n0 + c4;
    f32x4 v[16];
#pragma unroll
    for (int i = 0; i < 16; ++i) v[i] = inb ? __builtin_nontemporal_load((const f32x4*)(src + (size_t)(4 * i) * N)) : (f32x4){0.f, 0.f, 0.f, 0.f};
#pragma unroll
    for (int i = 0; i < 16; ++i) { LAS float* d = scr + (4 * i + kr) * 65 + c4; d[0] = v[i].x; d[1] = v[i].y; d[2] = v[i].z; d[3] = v[i].w; }
    asm volatile("s_waitcnt lgkmcnt(0)" ::: "memory");
    const int c = lane & 7, r8 = lane >> 3;
#pragma unroll
    for (int j = 0; j < 8; ++j) { const int nl = r8 + 8 * j; const int n = n0 + nl; const LAS float* q = scr + (8 * c) * 65 + nl;
        u32x4 o; o.x = cvt_pk_bf16(q[0 * 65], q[1 * 65]); o.y = cvt_pk_bf16(q[2 * 65], q[3 * 65]); o.z = cvt_pk_bf16(q[4 * 65], q[5 * 65]); o.w = cvt_pk_bf16(q[6 * 65], q[7 * 65]);
        if (n < N) { if (tiled) *(u32x4*)((char*)WT + pg8::tl_off(dst_row(mode, n), k0 + 8 * c, K)) = o; else *(u32x4*)(WT + (size_t)dst_row(mode, n) * K + k0 + 8 * c) = o; } }
    asm volatile("s_waitcnt lgkmcnt(0)" ::: "memory");
}

struct Args { const float* in[16]; float* out; unsigned char* ws; };
typedef __attribute__((address_space(4))) const Args* ArgsP;
__device__ __forceinline__ ArgsP get_args() { unsigned long long p = (unsigned long long)__builtin_amdgcn_kernarg_segment_ptr(); asm volatile("" : "+s"(p)); return (ArgsP)p; }
struct Ctx { LAS unsigned char* L; int vcu, G, bx; };
__device__ __forceinline__ Ctx launder(const Ctx& c) { Ctx r; unsigned lb = (unsigned)(size_t)c.L; int v = c.vcu, g = c.G, bx = c.bx; asm volatile("" : "+s"(lb), "+s"(v), "+s"(g), "+s"(bx)); r.L = (LAS unsigned char*)(size_t)lb; r.vcu = v; r.G = g; r.bx = bx; return r; }
#define PHASE_IDS() int tid_ = threadIdx.x; asm volatile("" : "+v"(tid_)); const int tid = tid_; const int lane = tid & 63; const int wave = __builtin_amdgcn_readfirstlane(tid >> 6); (void)lane; (void)wave

__device__ __forceinline__ void prologue(const Ctx& C0) {
    PHASE_IDS(); const ArgsP A = get_args(); const Ctx C = launder(C0);
    {
        LAS float* scr = (LAS float*)(C.L + wave * 16640);
        const int gw = C.vcu * 8 + wave, NGW = C.G * 8;
        constexpr int I_FI = 16 * 88, I_FO = 44 * 16, I_MI = 16 * 45, I_MO = 16 * 16, I_C1 = 32 * 1;
        constexpr int N_FI = 8 * I_FI, N_FO = 8 * I_FO, N_MI = 4 * I_MI, N_MO = 4 * I_MO, N_C1 = 8 * I_C1;
        constexpr int NITEMS = N_FI + N_FO + N_MI + N_MO + N_C1;
        for (int it = gw; it < NITEMS; it += NGW) {
            int r = it;
            if (r < N_FI) { const int q = r / I_FI; transpose_item(A->in[5] + (size_t)q * D * NFI, D, NFI, (bf16*)(A->ws + WS_WFI) + (size_t)q * NFI * D, scr, r - q * I_FI, lane, 1); continue; } r -= N_FI;
            if (r < N_FO) { const int q = r / I_FO; transpose_item(A->in[6] + (size_t)q * FF * D, FF, D, (bf16*)(A->ws + WS_WFO) + (size_t)q * D * FF, scr, r - q * I_FO, lane, 0); continue; } r -= N_FO;
            if (r < N_MI) { const int q = r / I_MI; transpose_item(A->in[7] + (size_t)q * D * NIN, D, NIN, (bf16*)(A->ws + WS_WMI) + (size_t)q * ZW * D, scr, r - q * I_MI, lane, 2); continue; } r -= N_MI;
            if (r < N_MO) { const int q = r / I_MO; transpose_item(A->in[14] + (size_t)q * D * D, D, D, (bf16*)(A->ws + WS_WMO) + (size_t)q * D * D, scr, r - q * I_MO, lane, 0); continue; } r -= N_MO;
            { const int q = r / I_C1; transpose_item(A->in[9] + (size_t)q * 2048 * 64, 2048, 64, (bf16*)(A->ws + WS_WC1T) + (size_t)q * 64 * 2048, scr, r - q * I_C1, lane, 0, false); }
        }
        const int gt = C.vcu * 512 + tid, NGT = C.G * 512;
        for (int i = gt; i < 4 * 232 * 128; i += NGT) { const int l = i / (232 * 128), rr = i - l * (232 * 128); const int row = NIN + rr / 128, ch = rr & 127;
            *(u32x4*)((char*)((bf16*)(A->ws + WS_WMI) + (size_t)l * ZW * D) + pg8::tl_off(row, ch * 8, D)) = (u32x4){0u, 0u, 0u, 0u}; }
    }
    __syncthreads();
    {
        LAS float* cact = (LAS float*)C.L;
        LAS float* red = (LAS float*)(C.L + 65536);
        for (int i = tid; i < NB * D; i += 512) cact[i] = silu_f(A->in[1][i]);
        __syncthreads();
        const int cj = tid & 63, ks = tid >> 6;
        float* mod = (float*)(A->ws + WS_MOD);
        {
            const int c4 = (lane & 7) * 4, kk = lane >> 3;
            for (int item = C.vcu; item < DEPTH * (MODW / 32); item += C.G) {
                const int l = item / (MODW / 32), jb = item - l * (MODW / 32);
                const float* w = A->in[2] + (size_t)l * D * MODW + (size_t)(ks * 128 + kk) * MODW + jb * 32 + c4;
                f32x4 wv[16];
#pragma unroll
                for (int i = 0; i < 16; ++i) wv[i] = __builtin_nontemporal_load((const f32x4*)(w + (size_t)(8 * i) * MODW));
                f32x4 acc[16];
#pragma unroll
                for (int b = 0; b < 16; ++b) acc[b] = (f32x4){0.f, 0.f, 0.f, 0.f};
#pragma unroll
                for (int i = 0; i < 16; ++i) { const LAS float* cp = cact + ks * 128 + 8 * i + kk;
#pragma unroll
                    for (int b = 0; b < 16; ++b) acc[b] += wv[i] * cp[b * D]; }
#pragma unroll
                for (int b = 0; b < 16; ++b)
#pragma unroll
                    for (int e = 0; e < 4; ++e) { float s = acc[b][e]; s += dpp_f<0x128>(s); s = sum16x(s); acc[b][e] = sum32x(s); }
                if (kk == 0) {
#pragma unroll
                    for (int b = 0; b < 16; ++b) *(LAS f32x4*)(red + (ks * 16 + b) * 32 + c4) = acc[b]; }
                __syncthreads();
                { const int b = tid >> 5, c = tid & 31; float s = A->in[3][l * MODW + jb * 32 + c];
#pragma unroll
                  for (int q = 0; q < 8; ++q) s += red[(q * 16 + b) * 32 + c];
                  mod[((size_t)l * NB + b) * MODW + jb * 32 + c] = s; }
                __syncthreads();
            }
        }
        for (int item = C.vcu; item < 8; item += C.G) {
            const float* pos = A->in[8] + (size_t)item * 2048; const float* w1 = A->in[9] + (size_t)item * 2048 * 64;
            float s = 0.f;
            for (int k = ks * 256; k < ks * 256 + 256; ++k) s += pos[k] * w1[(size_t)k * 64 + cj];
            red[ks * 64 + cj] = s;
            __syncthreads();
            if (tid < 64) { float t = 0.f;
#pragma unroll
                for (int q = 0; q < 8; ++q) t += red[q * 64 + tid];
                ((float*)(A->ws + WS_CB1))[item * 64 + tid] = t; }
            __syncthreads();
        }
    }
}

typedef float f32x4v __attribute__((ext_vector_type(4)));
__device__ __forceinline__ void prologue2(const Ctx& C0) {
    PHASE_IDS(); const ArgsP A = get_args(); const Ctx C = launder(C0);
    const int gw = C.vcu * 8 + wave, NGW = C.G * 8;
    {
        const float* mod = (const float*)(A->ws + WS_MOD); float* sbw = (float*)(A->ws + WS_SBW);
        constexpr int T_FF = NFI / 16, T_MI = ZW / 16, T_L = 2 * T_FF + T_MI;
        const int bi = lane & 15, kq = lane >> 4;
        for (int it = gw; it < DEPTH * T_L; it += NGW) {
            const int l = it / T_L; int r = it - l * T_L; int sub, t; const bf16* Bt;
            if (r < T_FF) { sub = 0; t = r; Bt = (const bf16*)(A->ws + WS_WFI) + (size_t)(l * 2) * NFI * D; }
            else if (r < T_FF + T_MI) { sub = 1; t = r - T_FF; Bt = (const bf16*)(A->ws + WS_WMI) + (size_t)l * ZW * D; }
            else { sub = 2; t = r - T_FF - T_MI; Bt = (const bf16*)(A->ws + WS_WFI) + (size_t)(l * 2 + 1) * NFI * D; }
            const float* sh = mod + ((size_t)l * NB + bi) * MODW + sub * 3072 + 8 * kq;
            const char* bp = (const char*)Bt + pg8::tl_off(16 * t + bi, 8 * kq, D);
            f32x4v acc = {0.f, 0.f, 0.f, 0.f};
#pragma unroll 8
            for (int s = 0; s < 32; ++s) { const f32x4 a0 = *(const f32x4*)(sh + 32 * s), a1 = *(const f32x4*)(sh + 32 * s + 4);
                const u32x4 aw = {cvt_pk_bf16(a0.x, a0.y), cvt_pk_bf16(a0.z, a0.w), cvt_pk_bf16(a1.x, a1.y), cvt_pk_bf16(a1.z, a1.w)};
                const bf16x8 bv = *(const bf16x8*)(bp + 1024 * s);
                acc = __builtin_amdgcn_mfma_f32_16x16x32_bf16(__builtin_bit_cast(bf16x8, aw), bv, acc, 0, 0, 0); }
            float* op = sbw + ((size_t)(3 * l + sub) * NB + 4 * kq) * NFI + 16 * t + bi;
#pragma unroll
            for (int e = 0; e < 4; ++e) op[(size_t)e * NFI] = acc[e];
        }
    }
    {
        const float* xin = A->in[0]; bf16* hs = (bf16*)(A->ws + WS_H); float* rowsq = (float*)(A->ws + WS_RSQ); unsigned* x16 = (unsigned*)(A->ws + WS_X);
        const float* g = A->in[4]; const float* mod = (const float*)(A->ws + WS_MOD);
        const int rr = lane >> 2, ch = lane & 3;
        for (int rb = gw; rb < M / 16; rb += NGW) {
            const int row = 16 * rb + rr, b = row >> 11;
            const float* sc = mod + (size_t)b * MODW + D; const float* xr = xin + (size_t)row * D;
            float s = 0.f;
#pragma unroll 4
            for (int cb = 0; cb < 32; ++cb) { const int c = 32 * cb + 8 * ch;
                const f32x4 v0 = __builtin_nontemporal_load((const f32x4*)(xr + c)), v1 = __builtin_nontemporal_load((const f32x4*)(xr + c + 4));
                s += ((v0.x * v0.x + v0.y * v0.y) + (v0.z * v0.z + v0.w * v0.w)) + ((v1.x * v1.x + v1.y * v1.y) + (v1.z * v1.z + v1.w * v1.w));
                const f32x4 y0 = v0 * *(const f32x4*)(g + c) * (*(const f32x4*)(sc + c) + 1.0f), y1 = v1 * *(const f32x4*)(g + c + 4) * (*(const f32x4*)(sc + c + 4) + 1.0f);
                const u32x4 o = {cvt_pk_bf16(y0.x, y0.y), cvt_pk_bf16(y0.z, y0.w), cvt_pk_bf16(y1.x, y1.y), cvt_pk_bf16(y1.z, y1.w)};
                *(u32x4*)((char*)hs + pg8::tl_off(row, c, D)) = o;
                const u32x4 xw = {pg8::cvt_pk_f16(v0.x, v0.y), pg8::cvt_pk_f16(v0.z, v0.w), pg8::cvt_pk_f16(v1.x, v1.y), pg8::cvt_pk_f16(v1.z, v1.w)};
                *(u32x4*)((char*)x16 + pg8::tl_off(row, c, D)) = xw; }
            s += dpp_f<0xB1>(s); s += dpp_f<0x4E>(s);
            *(f32x4*)(rowsq + (size_t)row * 16 + 4 * ch) = (f32x4){ch == 0 ? s : 0.f, 0.f, 0.f, 0.f};
        }
    }
}
__device__ __forceinline__ void finalnorm_phase(const Ctx& C0) {
    PHASE_IDS(); const ArgsP A = get_args(); const Ctx C = launder(C0);
    const unsigned char* x16 = A->ws + WS_X; float* out = A->out; const float* g = A->in[15]; const float* rowsq = (const float*)(A->ws + WS_RSQ);
    const int gw = C.vcu * 8 + wave, NGW = C.G * 8;
    const int rr = lane >> 2, ch = lane & 3;
    for (int rb = gw; rb < M / 16; rb += NGW) {
        const int row = 16 * rb + rr;
        const f32x4 q = *(const f32x4*)(rowsq + (size_t)row * 16 + 4 * ch);
        float s = (q.x + q.y) + (q.z + q.w);
        s += dpp_f<0xB1>(s); s += dpp_f<0x4E>(s);
        const float rstd = __builtin_amdgcn_rsqf(s * (1.0f / D) + EPS);
        float* orow = out + (size_t)row * D;
#pragma unroll 8
        for (int cb = 0; cb < 32; ++cb) { const int c = 32 * cb + 8 * ch;
            const u32x4 p = *(const u32x4*)(x16 + pg8::tl_off(row, c, D));
            const f32x4 v0 = pg8::unpack_f16x4((u32x2){p.x, p.y}), v1 = pg8::unpack_f16x4((u32x2){p.z, p.w});
            *(f32x4*)(orow + c) = v0 * rstd * *(const f32x4*)(g + c); *(f32x4*)(orow + c + 4) = v1 * rstd * *(const f32x4*)(g + c + 4); }
    }
}
__device__ __forceinline__ void unpack8(const u32x4 w, float (&f)[8]) {
    f[0] = bflo(w.x); f[1] = bfhi(w.x); f[2] = bflo(w.y); f[3] = bfhi(w.y); f[4] = bflo(w.z); f[5] = bfhi(w.z); f[6] = bflo(w.w); f[7] = bfhi(w.w);
}
__device__ __forceinline__ void postmix_phase(const Ctx& C0, int l) {
    PHASE_IDS(); const ArgsP A = get_args(); const Ctx C = launder(C0);
    const float* oatt = (const float*)(A->ws + WS_OATT); const bf16* z = (const bf16*)(A->ws + WS_ZB); bf16* omix = (bf16*)(A->ws + WS_OMIX);
    const float* conv_w = A->in[11] + (size_t)l * 3 * 512; const float* conv_b = A->in[12] + (size_t)l * 512; const float* gout = A->in[13] + (size_t)l * D;
    const int gw = C.vcu * 8 + wave, NGW = C.G * 8; const int c8 = lane * 8;
    float w0[8], w1[8], w2[8], cb[8], ga[8], gc[8];
#pragma unroll
    for (int e = 0; e < 8; ++e) { w0[e] = conv_w[c8 + e]; w1[e] = conv_w[512 + c8 + e]; w2[e] = conv_w[1024 + c8 + e]; cb[e] = conv_b[c8 + e]; ga[e] = gout[c8 + e]; gc[e] = gout[512 + c8 + e]; }
    for (int ch = gw; ch < M / 16; ch += NGW) {
        const int row0 = ch * 16; const int s0 = row0 & (SEQ - 1);
        float um2[8], um1[8];
        if (s0 == 0) {
#pragma unroll
            for (int e = 0; e < 8; ++e) { um2[e] = 0.f; um1[e] = 0.f; }
        } else {
            float a[8], b[8];
            unpack8(*(const u32x4*)(z + (size_t)(row0 - 2) * ZW + ZHC + c8), a); unpack8(*(const u32x4*)(z + (size_t)(row0 - 2) * ZW + ZCG + c8), b);
#pragma unroll
            for (int e = 0; e < 8; ++e) um2[e] = a[e] * b[e];
            unpack8(*(const u32x4*)(z + (size_t)(row0 - 1) * ZW + ZHC + c8), a); unpack8(*(const u32x4*)(z + (size_t)(row0 - 1) * ZW + ZCG + c8), b);
#pragma unroll
            for (int e = 0; e < 8; ++e) um1[e] = a[e] * b[e];
        }
        f32x4 na0 = *(const f32x4*)(oatt + (size_t)row0 * 512 + c8), na1 = *(const f32x4*)(oatt + (size_t)row0 * 512 + c8 + 4);
        u32x4 nhc = *(const u32x4*)(z + (size_t)row0 * ZW + ZHC + c8), nbg = *(const u32x4*)(z + (size_t)row0 * ZW + ZBG + c8), ncg = *(const u32x4*)(z + (size_t)row0 * ZW + ZCG + c8);
        for (int i = 0; i < 16; ++i) {
            const size_t row = (size_t)(row0 + i);
            const f32x4 a0 = na0, a1 = na1; const u32x4 whc = nhc, wbg = nbg, wcg = ncg;
            { const size_t rn = (size_t)(row0 + (i < 15 ? i + 1 : 15));
              na0 = *(const f32x4*)(oatt + rn * 512 + c8); na1 = *(const f32x4*)(oatt + rn * 512 + c8 + 4);
              nhc = *(const u32x4*)(z + rn * ZW + ZHC + c8); nbg = *(const u32x4*)(z + rn * ZW + ZBG + c8); ncg = *(const u32x4*)(z + rn * ZW + ZCG + c8); }
            float ss = (a0.x * a0.x + a0.y * a0.y) + (a0.z * a0.z + a0.w * a0.w) + (a1.x * a1.x + a1.y * a1.y) + (a1.z * a1.z + a1.w * a1.w);
            float hc[8], bg[8], cg[8], oc[8];
            unpack8(whc, hc); unpack8(wbg, bg); unpack8(wcg, cg);
            float s2 = 0.f;
#pragma unroll
            for (int e = 0; e < 8; ++e) { const float u = cg[e] * hc[e]; const float v = cb[e] + um2[e] * w0[e] + um1[e] * w1[e] + u * w2[e]; oc[e] = bg[e] * v; s2 += oc[e] * oc[e]; um2[e] = um1[e]; um1[e] = u; }
#pragma unroll
            for (int o = 1; o < 64; o <<= 1) { ss += shx(ss, o, lane); s2 += shx(s2, o, lane); }
            const float rs = __builtin_amdgcn_rsqf(ss * (1.0f / 512.0f) + EPS), rc = __builtin_amdgcn_rsqf(s2 * (1.0f / 512.0f) + EPS);
            u32x4 o;
            o.x = cvt_pk_bf16(a0.x * rs * ga[0], a0.y * rs * ga[1]); o.y = cvt_pk_bf16(a0.z * rs * ga[2], a0.w * rs * ga[3]);
            o.z = cvt_pk_bf16(a1.x * rs * ga[4], a1.y * rs * ga[5]); o.w = cvt_pk_bf16(a1.z * rs * ga[6], a1.w * rs * ga[7]);
            *(u32x4*)(omix + row * D + c8) = o;
            o.x = cvt_pk_bf16(oc[0] * rc * gc[0], oc[1] * rc * gc[1]); o.y = cvt_pk_bf16(oc[2] * rc * gc[2], oc[3] * rc * gc[3]);
            o.z = cvt_pk_bf16(oc[4] * rc * gc[4], oc[5] * rc * gc[5]); o.w = cvt_pk_bf16(oc[6] * rc * gc[6], oc[7] * rc * gc[7]);
            *(u32x4*)(omix + row * D + 512 + c8) = o;
        }
    }
}

__device__ __forceinline__ void compress_phase(const Ctx& C0, int l) {
    PHASE_IDS(); const ArgsP A = get_args(); const Ctx C = launder(C0);
    const bf16* z = (const bf16*)(A->ws + WS_ZB); const bf16* w1T = (const bf16*)(A->ws + WS_WC1T) + (size_t)l * 2 * 64 * 2048; const float* cb1 = (const float*)(A->ws + WS_CB1) + l * 128;
    const float* w2 = A->in[10] + (size_t)l * 2 * 4096; bf16* kcmp = (bf16*)(A->ws + WS_KCMP); bf16* vcmp = (bf16*)(A->ws + WS_VCMP);
    const int wid = wave, r = lane & 31, h = lane >> 5;
    LAS float* part = (LAS float*)C.L;
    LAS float* y1 = (LAS float*)(C.L + 65536);
    for (int task = C.vcu; task < 256; task += C.G) {
        const int nt = task & 3, kv = (task >> 2) & 1, g = (task >> 3) & 1, b = task >> 4;
        const int colb = ZKC + kv * 128 + 64 * g;
        const int tokbase = 16 * (nt * 32 + r);
        const bf16* zb = z + (size_t)b * SEQ * ZW;
        const bf16* wT = w1T + (size_t)kv * 64 * 2048 + (size_t)r * 2048 + 8 * h;
        f32x16 acc0, acc1;
#pragma unroll
        for (int i = 0; i < 16; ++i) { acc0[i] = 0.f; acc1[i] = 0.f; }
#pragma unroll
        for (int ii = 0; ii < 4; ++ii) { const int i = wid * 4 + ii; int tok = tokbase + i; tok = tok > SEQ - 1 ? SEQ - 1 : tok;
            const bf16* b0p = wT + i * 64; const bf16* b1p = b0p + 32 * 2048;
#pragma unroll
            for (int dd = 0; dd < 4; ++dd) { const bf16x8 av = *(const bf16x8*)zt(zb, tok, colb + 8 * h + 16 * dd), b0 = *(const bf16x8*)(b0p + 16 * dd), b1 = *(const bf16x8*)(b1p + 16 * dd);
                acc0 = MFMA32(av, b0, acc0); acc1 = MFMA32(av, b1, acc1); } }
#pragma unroll
        for (int i = 0; i < 16; ++i) { const int nl = crow(i, h); part[(wid * 32 + nl) * 64 + r] = acc0[i]; part[(wid * 32 + nl) * 64 + 32 + r] = acc1[i]; }
        __syncthreads();
        const int nl = tid >> 4, oq = (tid & 15) * 4;
        { f32x4 s = *(const f32x4*)(cb1 + kv * 64 + oq);
#pragma unroll
          for (int w = 0; w < 8; ++w) s += *(const LAS f32x4*)(part + (w * 32 + nl) * 64 + oq);
          f32x4 y; y.x = silu_f(s.x); y.y = silu_f(s.y); y.z = silu_f(s.z); y.w = silu_f(s.w);
          *(LAS f32x4*)(y1 + nl * 64 + oq) = y; }
        __syncthreads();
        { f32x4 acc = {0.f, 0.f, 0.f, 0.f}; const float* w2p = w2 + kv * 4096 + oq;
          for (int o = 0; o < 64; ++o) { const float yv = y1[nl * 64 + o]; acc += *(const f32x4*)(w2p + o * 64) * yv; }
          const int n = nt * 32 + nl; if (n == 127) acc = (f32x4){0.f, 0.f, 0.f, 0.f};
          u32x2 ov; ov.x = cvt_pk_bf16(acc.x, acc.y); ov.y = cvt_pk_bf16(acc.z, acc.w);
          *(u32x2*)((kv ? vcmp : kcmp) + ((size_t)(b * 2 + g) * 128 + n) * 64 + oq) = ov; }
        __syncthreads();
    }
}

constexpr float MFLOOR = -1e20f;
constexpr int AK = 0, AV = 24576, AWS = 57344, AIMP = 59392, ASEL = 93184, AOT = 93440;
static_assert(AOT + 65536 <= CTRL_OFF, "attention LDS map");
typedef short v4i16_t __attribute__((ext_vector_type(4)));
__device__ __forceinline__ s16x4 vtr(const LAS unsigned char* p) { return __builtin_bit_cast(s16x4, __builtin_amdgcn_ds_read_tr16_b64_v4i16((LAS v4i16_t*)p)); }
#define PACKF(X, S) __builtin_bit_cast(bf16x8, (u32x4){cvt_pk_bf16(X[8 * (S)], X[8 * (S) + 1]), cvt_pk_bf16(X[8 * (S) + 2], X[8 * (S) + 3]), cvt_pk_bf16(X[8 * (S) + 4], X[8 * (S) + 5]), cvt_pk_bf16(X[8 * (S) + 6], X[8 * (S) + 7])})
#define PV_STEP(PF, KS) do { const bf16x8 pf_ = (PF); const int vo_ = ((KS) >> 2) * 8192 + ((KS) & 3) * 1024; \
    { const s16x4 lo_ = vtr(vp + vo_), hi_ = vtr(vp + vo_ + 512); const bf16x8 vf_ = {lo_[0], lo_[1], lo_[2], lo_[3], hi_[0], hi_[1], hi_[2], hi_[3]}; o0 = MFMA32(pf_, vf_, o0); } \
    { const s16x4 lo_ = vtr(vp + vo_ + 4096), hi_ = vtr(vp + vo_ + 4608); const bf16x8 vf_ = {lo_[0], lo_[1], lo_[2], lo_[3], hi_[0], hi_[1], hi_[2], hi_[3]}; o1 = MFMA32(pf_, vf_, o1); } } while (0)

constexpr int SLOTB = 8192, RK = 0, RV = 3 * SLOTB;
constexpr float MFL = -1000.0f;
typedef const LAS unsigned char* lcp;
__device__ __forceinline__ void glds16(const void* gsrc, unsigned lds_dst) { unsigned keep;
    asm volatile("s_mov_b32 %0, m0\n\ts_mov_b32 m0, %2\n\ts_nop 0\n\tglobal_load_lds_dwordx4 %1, off\n\ts_mov_b32 m0, %0" : "=&s"(keep) : "v"(gsrc), "s"(lds_dst) : "memory"); }
__device__ __forceinline__ void kload8(bf16x8* kf, lcp kp) {
    kf[0] = *(const LAS bf16x8*)(kp);        kf[1] = *(const LAS bf16x8*)(kp + 512);
    kf[2] = *(const LAS bf16x8*)(kp + 2048); kf[3] = *(const LAS bf16x8*)(kp + 2560);
    kf[4] = *(const LAS bf16x8*)(kp + 4096); kf[5] = *(const LAS bf16x8*)(kp + 4608);
    kf[6] = *(const LAS bf16x8*)(kp + 6144); kf[7] = *(const LAS bf16x8*)(kp + 6656); }
__device__ __forceinline__ void kload2(bf16x8* kf, lcp kp, int j) { kf[2 * j] = *(const LAS bf16x8*)(kp + j * 2048); kf[2 * j + 1] = *(const LAS bf16x8*)(kp + j * 2048 + 512); }
#define SBAR() __builtin_amdgcn_sched_barrier(0)
#define WAIT_BAR(N) asm volatile("s_waitcnt vmcnt(" #N ") lgkmcnt(0)\n\ts_barrier" ::: "memory")
#define MX3(a, b, c) __builtin_fmaxf(__builtin_fmaxf((a), (b)), (c))
__device__ __forceinline__ float rowmax32(const f32x16& C0, const f32x16& C1) {
    float a = MX3(C0[0], C0[1], C1[0]), b = MX3(C0[2], C0[3], C1[1]); a = MX3(a, C1[2], C1[3]);
#pragma unroll
    for (int r = 4; r < 16; r += 4) { a = MX3(a, C0[r], C0[r + 1]); b = MX3(b, C0[r + 2], C0[r + 3]); a = MX3(a, C1[r], C1[r + 1]); b = MX3(b, C1[r + 2], C1[r + 3]); }
    return max32x(__builtin_fmaxf(a, b)); }
__device__ __forceinline__ void attn_issue(LAS unsigned char* L, const bf16* zb, int kcol, int vcol, int jlo, int n, int tid_in, int wid) {
    int tid = tid_in; asm volatile("" : "+v"(tid)); const int lane = tid & 63;
    const unsigned lds0 = (unsigned)(size_t)L;
    const bf16* ksrc = zt(zb, 64 * jlo + lane, kcol + wid * 8);
    const bf16* vsrc = zt(zb, 64 * jlo + 16 * (wid & 3) + (lane >> 2), vcol + (wid >> 2) * 32 + (lane & 3) * 8);
    const unsigned kdst = lds0 + RK + wid * 1024, vdst = lds0 + RV + wid * 1024;
    glds16(ksrc, (unsigned)__builtin_amdgcn_readfirstlane(kdst)); glds16(vsrc, (unsigned)__builtin_amdgcn_readfirstlane(vdst));
    if (n > 1) glds16(ksrc + (size_t)64 * ZW, (unsigned)__builtin_amdgcn_readfirstlane(kdst + SLOTB));
    if (n > 2) glds16(ksrc + (size_t)128 * ZW, (unsigned)__builtin_amdgcn_readfirstlane(kdst + 2 * SLOTB));
    if (n > 1) glds16(vsrc + (size_t)64 * ZW, (unsigned)__builtin_amdgcn_readfirstlane(vdst + SLOTB));
}
template <int MODE, bool PRE = false, int THRL = 8>
__device__ __forceinline__ void attn_branch(LAS unsigned char* L, const bf16* zb, int kcol, int vcol, int jlo, int jhi, int qt, int qrel, unsigned selbits,
                                            const bf16x8 (&qr)[4], f32x16& o0, f32x16& o1, float& lout, int tid_in, int wid) {
    int tid = tid_in; asm volatile("" : "+v"(tid)); const int lane = tid & 63;
    const int r32 = lane & 31, hi = lane >> 5;
    const unsigned lds0 = (unsigned)(size_t)L;
    LAS float* wsf = (LAS float*)(L + AWS) + wid * 64;
    const int n = jhi - jlo + 1;
    const bf16* ksrc = zt(zb, 64 * jlo + lane, kcol + wid * 8);
    const bf16* vsrc = zt(zb, 64 * jlo + 16 * (wid & 3) + (lane >> 2), vcol + (wid >> 2) * 32 + (lane & 3) * 8);
    const unsigned kdst = lds0 + RK + wid * 1024, vdst = lds0 + RV + wid * 1024;
#define DMA_K(t, slot) glds16(ksrc + (size_t)(t) * 64 * ZW, (unsigned)__builtin_amdgcn_readfirstlane(kdst + (slot)))
#define DMA_V(t, slot) glds16(vsrc + (size_t)(t) * 64 * ZW, (unsigned)__builtin_amdgcn_readfirstlane(vdst + (slot)))
    const lcp kp0 = L + RK + hi * 1024 + r32 * 16;
    const lcp vp0 = L + RV + ((lane >> 4) & 1) * 32 + (lane & 3) * 8 + (4 * hi + ((lane & 15) >> 2)) * 64;
    const int clim = qrel - 4 * hi;
    if (!PRE) {
        LBAR();
        DMA_K(0, 0); DMA_V(0, 0); if (n > 1) DMA_K(1, SLOTB); if (n > 2) DMA_K(2, 2 * SLOTB); if (n > 1) DMA_V(1, SLOTB);
    }
    float mhat = 0.f, l_reg = 0.f; f32x16 o[2];
#pragma unroll
    for (int i = 0; i < 16; ++i) { o[0][i] = 0.f; o[1][i] = 0.f; }
    f32x16 negm;
#pragma unroll
    for (int i = 0; i < 16; ++i) negm[i] = 0.f;
    asm volatile("" : "+v"(negm));
    if (n > 2) WAIT_BAR(4); else if (n > 1) WAIT_BAR(3); else WAIT_BAR(1);
    f32x16 pA0, pA1, pB0, pB1;
    bool resc = false;
#define CAUSAL(P0, P1) do { _Pragma("unroll") for (int r = 0; r < 16; ++r) { const int c0 = (r & 3) + 8 * (r >> 2); P0[r] = (c0 <= clim) ? P0[r] : NEGB; P1[r] = (c0 + 32 <= clim) ? P1[r] : NEGB; } } while (0)
    {
        const lcp kb = L + RK + hi * 1024 + r32 * 16;
#pragma unroll
        for (int d0 = 0; d0 < 4; ++d0) { const bf16x8 b0 = *(const LAS bf16x8*)(kb + d0 * 2048), b1 = *(const LAS bf16x8*)(kb + d0 * 2048 + 512);
            if (d0 == 0) { pA0 = MFMA32(b0, qr[0], negm); pA1 = MFMA32(b1, qr[0], negm); } else { pA0 = MFMA32(b0, qr[d0], pA0); pA1 = MFMA32(b1, qr[d0], pA1); } }
        if (MODE == 1 && qt >= 8) {
#pragma unroll
            for (int r = 0; r < 16; ++r) { const int c0 = (r & 3) + 8 * (r >> 2); pA0[r] = (c0 > clim) ? pA0[r] : NEGB; pA1[r] = (c0 + 32 > clim) ? pA1[r] : NEGB; }
        }
        if (n == 1) CAUSAL(pA0, pA1);
        const float rm = rowmax32(pA0, pA1);
        const float dl = __builtin_fmaxf(rm, MFL); mhat = dl;
#pragma unroll
        for (int r = 0; r < 16; ++r) { pA0[r] -= dl; pA1[r] -= dl; }
#pragma unroll
        for (int r = 0; r < 16; ++r) negm[r] = -mhat;
        asm volatile("" : "+v"(negm));
#pragma unroll
        for (int r = 0; r < 16; ++r) { pA0[r] = __builtin_amdgcn_exp2f(pA0[r]); pA1[r] = __builtin_amdgcn_exp2f(pA1[r]); }
    }
    WAIT_BAR(0);
    if (n > 3) DMA_K(3, 0);
    if (n > 2) DMA_V(2, 2 * SLOTB);
    int sl_prev = 0, sl_cur = SLOTB, sl_next = 2 * SLOTB;
#define ROT() do { sl_prev = sl_cur; sl_cur = sl_next; sl_next = (sl_next == 2 * SLOTB) ? 0 : sl_next + SLOTB; } while (0)
    bf16x8 kf[8];
    kload8(kf, kp0 + sl_cur);
    WAIT_BAR(2);
#define RESC() do { if (resc) { asm volatile("s_waitcnt lgkmcnt(0)" ::: "memory"); \
        _Pragma("unroll") for (int d_ = 0; d_ < 2; ++d_) _Pragma("unroll") for (int r = 0; r < 16; ++r) o[d_][r] *= wsf[crow(r, hi)]; } } while (0)
    s16x4 vlo[8], vhi[8]; u32x4 pw0, pw1, pw2, pw3;
#define PKW(P, B) cvt_pk_bf16(P[B], P[B + 1])
#define PAF(k) __builtin_bit_cast(bf16x8, pw##k)
#define VFR(i) (bf16x8){vlo[i][0], vlo[i][1], vlo[i][2], vlo[i][3], vhi[i][0], vhi[i][1], vhi[i][2], vhi[i][3]}
#define PIN(x) asm volatile("" : "+v"(x))
#define GAPA(MF, A0, A1, A2, A3, W0, W1, PW) do { MF; sacc += A0; sacc += A1; sacc += A2; sacc += A3; PIN(sacc); W0; W1; PIN(PW); SBAR(); } while (0)
#define EX(v) __builtin_amdgcn_exp2f(v)
#define GAPB(MF, X, B) do { MF; X[B] = EX(X[B]); X[B + 1] = EX(X[B + 1]); X[B + 2] = EX(X[B + 2]); X[B + 3] = EX(X[B + 3]); PIN(X); SBAR(); } while (0)
#define VRD(i) do { vlo[i] = vtr(vp_ + (((i) >> 2) * 4096 + ((i) & 3) * 1024)); vhi[i] = vtr(vp_ + (((i) >> 2) * 4096 + ((i) & 3) * 1024 + 512)); } while (0)
#define KRD(G, j) do { if (G) { kload2(kf, kp0 + sl_next, j); SBAR(); } } while (0)
#define STEP(C0, C1, P0, P1, t, GK, GV, GL) do { \
    if (MODE == 0) { const float nv_ = ((selbits >> (t)) & 1u) ? -mhat : NEGB; _Pragma("unroll") for (int r = 0; r < 16; ++r) negm[r] = nv_; PIN(negm); } \
    SBAR(); \
    const lcp vp_ = vp0 + ((((t) - 1) & 3) * SLOTB); \
    VRD(0); SBAR(); float sacc = (P0[0] + P0[1]); \
    GAPA(C0 = MFMA32(kf[0], qr[0], negm), P0[2], P0[3], P0[4], P0[5],     pw0[0] = PKW(P0, 0), pw0[1] = PKW(P0, 2), pw0); \
    VRD(4); SBAR(); GAPA(C1 = MFMA32(kf[1], qr[0], negm), P0[6], P0[7], P0[8], P0[9],     pw0[2] = PKW(P0, 4), pw0[3] = PKW(P0, 6), pw0); \
    VRD(1); SBAR(); GAPA(C0 = MFMA32(kf[2], qr[1], C0),   P0[10], P0[11], P0[12], P0[13], pw1[0] = PKW(P0, 8), pw1[1] = PKW(P0, 10), pw1); \
    VRD(5); SBAR(); GAPA(C1 = MFMA32(kf[3], qr[1], C1),   P0[14], P0[15], P1[0], P1[1],   pw1[2] = PKW(P0, 12), pw1[3] = PKW(P0, 14), pw1); \
    VRD(2); SBAR(); GAPA(C0 = MFMA32(kf[4], qr[2], C0),   P1[2], P1[3], P1[4], P1[5],     pw2[0] = PKW(P1, 0), pw2[1] = PKW(P1, 2), pw2); \
    VRD(6); SBAR(); GAPA(C1 = MFMA32(kf[5], qr[2], C1),   P1[6], P1[7], P1[8], P1[9],     pw2[2] = PKW(P1, 4), pw2[3] = PKW(P1, 6), pw2); \
    VRD(3); SBAR(); GAPA(C0 = MFMA32(kf[6], qr[3], C0),   P1[10], P1[11], P1[12], P1[13], pw3[0] = PKW(P1, 8), pw3[1] = PKW(P1, 10), pw3); \
    VRD(7); SBAR(); GAPA(C1 = MFMA32(kf[7], qr[3], C1),   P1[14], P1[15], 0.f, 0.f,       pw3[2] = PKW(P1, 12), pw3[3] = PKW(P1, 14), pw3); \
    l_reg += sacc; \
    if (GK) { DMA_K((t) + 3, sl_cur); } if (GV) { DMA_V((t) + 2, (((t) + 2) & 3) * SLOTB); } \
    if ((t) == n - 1) CAUSAL(C0, C1); \
    { float rm = rowmax32(C0, C1); \
      resc = false; \
      if (__builtin_expect(__any(rm > (float)THRL), 0)) { const float dl = __builtin_fmaxf(rm, 0.f); mhat += dl; \
        _Pragma("unroll") for (int r = 0; r < 16; ++r) { C0[r] -= dl; C1[r] -= dl; } \
        _Pragma("unroll") for (int r = 0; r < 16; ++r) negm[r] = -mhat; asm volatile("" : "+v"(negm)); \
        const float f = __builtin_amdgcn_exp2f(-dl); l_reg *= f; if (hi == 0) wsf[r32] = f; resc = true; } } \
    SBAR(); \
    GAPB(o[0] = MFMA32(PAF(0), VFR(0), o[0]), C0, 0); \
    GAPB(o[1] = MFMA32(PAF(0), VFR(4), o[1]), C0, 4); \
    KRD(GL, 0); GAPB(o[0] = MFMA32(PAF(1), VFR(1), o[0]), C0, 8); \
    KRD(GL, 1); GAPB(o[1] = MFMA32(PAF(1), VFR(5), o[1]), C0, 12); \
    KRD(GL, 2); GAPB(o[0] = MFMA32(PAF(2), VFR(2), o[0]), C1, 0); \
    KRD(GL, 3); GAPB(o[1] = MFMA32(PAF(2), VFR(6), o[1]), C1, 4); \
    GAPB(o[0] = MFMA32(PAF(3), VFR(3), o[0]), C1, 8); \
    GAPB(o[1] = MFMA32(PAF(3), VFR(7), o[1]), C1, 12); \
    } while (0)
#define ENDW(tt) do { if ((tt) + 3 < n) { WAIT_BAR(3); } else if ((tt) + 2 < n) { WAIT_BAR(2); } else if ((tt) + 1 < n) { WAIT_BAR(1); } else { WAIT_BAR(0); } } while (0)
    int t = 1;
    for (; t + 1 < n; t += 2) {
        STEP(pB0, pB1, pA0, pA1, t, (t + 3 < n), (t + 2 < n), (t + 1 < n));         ENDW(t);     RESC(); ROT();
        STEP(pA0, pA1, pB0, pB1, t + 1, (t + 4 < n), (t + 3 < n), (t + 2 < n));     ENDW(t + 1); RESC(); ROT();
    }
    if (t < n) {
        STEP(pB0, pB1, pA0, pA1, t, false, false, false); WAIT_BAR(0); RESC(); ROT();
        pA0 = pB0; pA1 = pB1;
    }
    { float sacc = pA0[0] + pA0[1];
#pragma unroll
      for (int r = 2; r < 16; ++r) sacc += pA0[r];
#pragma unroll
      for (int r = 0; r < 16; ++r) sacc += pA1[r];
      l_reg += sacc;
      pw0 = (u32x4){PKW(pA0, 0), PKW(pA0, 2), PKW(pA0, 4), PKW(pA0, 6)}; pw1 = (u32x4){PKW(pA0, 8), PKW(pA0, 10), PKW(pA0, 12), PKW(pA0, 14)};
      pw2 = (u32x4){PKW(pA1, 0), PKW(pA1, 2), PKW(pA1, 4), PKW(pA1, 6)}; pw3 = (u32x4){PKW(pA1, 8), PKW(pA1, 10), PKW(pA1, 12), PKW(pA1, 14)};
      const lcp vp_ = vp0 + (((n - 1) & 3) * SLOTB);
#pragma unroll
      for (int i = 0; i < 8; ++i) VRD(i);
      o[0] = MFMA32(PAF(0), VFR(0), o[0]); o[1] = MFMA32(PAF(0), VFR(4), o[1]);
      o[0] = MFMA32(PAF(1), VFR(1), o[0]); o[1] = MFMA32(PAF(1), VFR(5), o[1]);
      o[0] = MFMA32(PAF(2), VFR(2), o[0]); o[1] = MFMA32(PAF(2), VFR(6), o[1]);
      o[0] = MFMA32(PAF(3), VFR(3), o[0]); o[1] = MFMA32(PAF(3), VFR(7), o[1]); }
#undef PKW
#undef PAF
#undef VFR
#undef PIN
#undef GAPA
#undef GAPB
#undef EX
#undef VRD
#undef KRD
#undef STEP
#undef ENDW
#undef RESC
#undef ROT
#undef CAUSAL
#undef DMA_K
#undef DMA_V
    o0 = o[0]; o1 = o[1];
    lout = sum32x(l_reg);
}

__device__ __forceinline__ void unit_geom(int U, int& b, int& g, int& qt) { const int v = U & 255, ii = U >> 8, s = v & 7, bgp = v >> 3; b = bgp >> 1; g = bgp & 1; const unsigned w = (s == 0 ? 0x080a0c1cu : s == 1 ? 0x07090b1fu : s == 2 ? 0x030f1617u : s == 3 ? 0x01131419u : s == 4 ? 0x050d1218u : s == 5 ? 0x04061a1bu : s == 6 ? 0x000e151eu : 0x0210111du); qt = (int)((w >> (8 * ii)) & 255u); }
__device__ __forceinline__ void cmp_issue(LAS unsigned char* L, const bf16* kc, const bf16* vc, int tid_in, int wid) {
    int tid = tid_in; asm volatile("" : "+v"(tid)); const int lane = tid & 63;
    const unsigned lds0 = (unsigned)(size_t)L;
    const bf16* ksrc = kc + (size_t)lane * 64 + wid * 8;
    const bf16* vsrc = vc + (size_t)(16 * (wid & 3) + (lane >> 2)) * 64 + (wid >> 2) * 32 + (lane & 3) * 8;
    const unsigned kdst = lds0 + RK + wid * 1024, vdst = lds0 + RV + wid * 1024;
    glds16(ksrc, (unsigned)__builtin_amdgcn_readfirstlane(kdst)); glds16(ksrc + 64 * 64, (unsigned)__builtin_amdgcn_readfirstlane(kdst + SLOTB));
    glds16(vsrc, (unsigned)__builtin_amdgcn_readfirstlane(vdst)); glds16(vsrc + 64 * 64, (unsigned)__builtin_amdgcn_readfirstlane(vdst + SLOTB));
}
__device__ __forceinline__ void attn_phase(const Ctx& C0, int l) {
    PHASE_IDS(); const ArgsP A = get_args(); const Ctx C = launder(C0);
    const bf16* z = (const bf16*)(A->ws + WS_ZB); const bf16* kcmp = (const bf16*)(A->ws + WS_KCMP); const bf16* vcmp = (const bf16*)(A->ws + WS_VCMP); bf16* omix = (bf16*)(A->ws + WS_OMIX); float* asq = (float*)(A->ws + WS_ASQ);
    const float* conv_w = A->in[11] + (size_t)l * 3 * 512; const float* conv_b = A->in[12] + (size_t)l * 512; const float* gout = A->in[13] + (size_t)l * D;
    LAS unsigned char* L = C.L;
    const int wid = wave, hh = wid & 3, th = wid >> 2;
    if (wid >= 4) __builtin_amdgcn_s_setprio(1);
    bf16x8 qn[4]; unsigned short gn0, gn1, gn2;
#define UNIT_FETCH(UU) do { int b_, g_, qt_; unit_geom((UU), b_, g_, qt_); int tf_ = tid_; asm volatile("" : "+v"(tf_)); const int lf_ = tf_ & 63; \
        const bf16* zbq_ = z + (size_t)b_ * SEQ * ZW; const int rq_ = 64 * qt_ + 32 * th + (lf_ & 31); \
        _Pragma("unroll") for (int d0 = 0; d0 < 4; ++d0) qn[d0] = *(const bf16x8*)zt(zbq_, rq_, 64 * (4 * g_ + hh) + 16 * d0 + 8 * (lf_ >> 5)); \
        { const int gc_ = ZGT + 3 * (4 * g_ + hh); gn0 = *zt(zbq_, rq_, gc_); gn1 = *zt(zbq_, rq_, gc_ + 1); gn2 = *zt(zbq_, rq_, gc_ + 2); } \
        cmp_issue(L, kcmp + (size_t)(b_ * 2 + g_) * 128 * 64, vcmp + (size_t)(b_ * 2 + g_) * 128 * 64, tid_, wid); } while (0)
    if (C.vcu < 1024) UNIT_FETCH(C.vcu);
    for (int U = C.vcu; U < 1024; U += C.G) {
        int tid = tid_; asm volatile("" : "+v"(tid)); const int lane = tid & 63, r32 = lane & 31, hi = lane >> 5;
        LAS float* wsf = (LAS float*)(L + AWS) + wid * 64;
        LAS float* imp = (LAS float*)(L + AIMP); LAS unsigned* sel = (LAS unsigned*)(L + ASEL);
        int b, g, qt; unit_geom(U, b, g, qt);
        const int head = 4 * g + hh, qrel = 32 * th + r32, tq = 64 * qt + qrel;
        const bf16* zb = z + (size_t)b * SEQ * ZW;
        bf16x8 qr[4];
#pragma unroll
        for (int d0 = 0; d0 < 4; ++d0) qr[d0] = qn[d0];
        const float sg0 = sigmoid_f(bf2f(gn0)), sg1 = sigmoid_f(bf2f(gn1)), sg2 = sigmoid_f(bf2f(gn2));
        f32x16 o0, o1;
#pragma unroll
        for (int i = 0; i < 16; ++i) { o0[i] = 0.f; o1[i] = 0.f; }
        LAS float* otl = (LAS float*)(L + AOT) + wid * 2048 + lane;
        const lcp kp = L + RK + hi * 1024 + r32 * 16;
        const lcp vp = L + RV + ((lane >> 4) & 1) * 32 + (lane & 3) * 8 + (4 * hi + ((lane & 15) >> 2)) * 64;
        {
            WAIT_BAR(0);
            const int nlim = ((tq - 31) >> 4) - 4 * hi;
            f32x16 pu[4];
#pragma unroll
            for (int u = 0; u < 4; ++u) {
#pragma unroll
                for (int i = 0; i < 16; ++i) pu[u][i] = 0.f;
#pragma unroll
                for (int d0 = 0; d0 < 4; ++d0) { const bf16x8 a = *(const LAS bf16x8*)(kp + (u >> 1) * SLOTB + (u & 1) * 512 + d0 * 2048); pu[u] = MFMA32(a, qr[d0], pu[u]); } }
            float mx = MFLOOR;
#pragma unroll
            for (int u = 0; u < 4; ++u)
#pragma unroll
                for (int r = 0; r < 16; ++r) { pu[u][r] = (32 * u + (r & 3) + 8 * (r >> 2) <= nlim) ? pu[u][r] : NEGB; mx = fmaxf(mx, pu[u][r]); }
            mx = max32x(mx);
            float ls = 0.f;
#pragma unroll
            for (int u = 0; u < 4; ++u)
#pragma unroll
                for (int r = 0; r < 16; ++r) { pu[u][r] = __builtin_amdgcn_exp2f(pu[u][r] - mx); ls += pu[u][r]; }
            ls = sum32x(ls);
            const float inv = ls > 0.f ? __builtin_amdgcn_rcpf(ls) : 0.f;
            {
                LAS float* ip = imp + ((size_t)hh * 64 + qrel) * 33;
                float prevrecv = 0.f;
#pragma unroll
                for (int u = 0; u < 4; ++u) {
#pragma unroll
                    for (int q4 = 0; q4 < 4; ++q4) { const int k = 4 * u + q4;
                        const float gs = ((pu[u][4 * q4] + pu[u][4 * q4 + 1]) + (pu[u][4 * q4 + 2] + pu[u][4 * q4 + 3])) * inv; const float le = pu[u][4 * q4 + 3] * inv;
                        const auto rr = __builtin_amdgcn_permlane32_swap(__float_as_uint(le), __float_as_uint(le), false, false);
                        const float recv = __uint_as_float(hi ? rr[0] : rr[1]);
                        const float prev = hi ? recv : prevrecv;
                        ip[2 * k + hi] = gs + prev; prevrecv = recv; }
                    PV_STEP(PACKF(pu[u], 0), 2 * u); PV_STEP(PACKF(pu[u], 1), 2 * u + 1); }
            }
            if (hi == 0) wsf[r32] = sg0 * inv;
            asm volatile("s_waitcnt lgkmcnt(0)" ::: "memory");
#pragma unroll
            for (int r = 0; r < 16; ++r) { const float w = wsf[crow(r, hi)]; otl[r * 64] = o0[r] * w; otl[(16 + r) * 64] = o1[r] * w; }
        }
        LBAR();
        attn_issue(L, zb, ZKS + 64 * g, ZVS + 64 * g, 0, qt + 1, tid, wid);
        {
            const int tok = tid >> 3, part = tid & 7;
            const LAS float* i0 = imp + (size_t)tok * 33;
            unsigned long long key[4];
#pragma unroll
            for (int q = 0; q < 4; ++q) { const int j = part + 8 * q; const float vj = ((i0[j] + i0[64 * 33 + j]) + i0[2 * 64 * 33 + j]) + i0[3 * 64 * 33 + j];
                key[q] = (j >= 1 && j <= qt - 2) ? (((unsigned long long)__float_as_uint(vj) << 32) | (unsigned)(32 - j)) : 0ull; }
            unsigned bits = 0u;
            if (qt > 7) {
#pragma unroll
                for (int round = 0; round < 5; ++round) {
                    unsigned long long m = key[0] > key[1] ? key[0] : key[1]; { const unsigned long long m2 = key[2] > key[3] ? key[2] : key[3]; m = m > m2 ? m : m2; }
                    { const unsigned long long o_ = ((unsigned long long)(unsigned)__builtin_amdgcn_update_dpp(0, (int)(m >> 32), 0xB1, 0xf, 0xf, true) << 32) | (unsigned)__builtin_amdgcn_update_dpp(0, (int)m, 0xB1, 0xf, 0xf, true); m = m > o_ ? m : o_; }
                    { const unsigned long long o_ = ((unsigned long long)(unsigned)__builtin_amdgcn_update_dpp(0, (int)(m >> 32), 0x4E, 0xf, 0xf, true) << 32) | (unsigned)__builtin_amdgcn_update_dpp(0, (int)m, 0x4E, 0xf, 0xf, true); m = m > o_ ? m : o_; }
                    { const unsigned long long o_ = ((unsigned long long)(unsigned)__builtin_amdgcn_update_dpp(0, (int)(m >> 32), 0x141, 0xf, 0xf, true) << 32) | (unsigned)__builtin_amdgcn_update_dpp(0, (int)m, 0x141, 0xf, 0xf, true); m = m > o_ ? m : o_; }
#pragma unroll
                    for (int q = 0; q < 4; ++q) { const bool hit = key[q] == m; bits |= hit ? (1u << (part + 8 * q)) : 0u; key[q] = hit ? 0ull : key[q]; }
                }
                bits |= (unsigned)__builtin_amdgcn_update_dpp(0, (int)bits, 0xB1, 0xf, 0xf, true);
                bits |= (unsigned)__builtin_amdgcn_update_dpp(0, (int)bits, 0x4E, 0xf, 0xf, true);
                bits |= (unsigned)__builtin_amdgcn_update_dpp(0, (int)bits, 0x141, 0xf, 0xf, true);
            }
            if (part == 0) sel[tok] = bits | ((qt <= 7) ? ((2u << qt) - 1u) : (1u | (1u << qt) | (1u << (qt - 1))));
        }
        LBAR();
        const unsigned selbits = sel[qrel];
        { float lsum;
          attn_branch<0, true>(L, zb, ZKS + 64 * g, ZVS + 64 * g, 0, qt, qt, qrel, selbits, qr, o0, o1, lsum, tid, wid);
          if (hi == 0) wsf[r32] = sg1 * __builtin_amdgcn_rcpf(lsum);
          asm volatile("s_waitcnt lgkmcnt(0)" ::: "memory");
#pragma unroll
          for (int r = 0; r < 16; ++r) { const float w = wsf[crow(r, hi)]; otl[r * 64] += o0[r] * w; otl[(16 + r) * 64] += o1[r] * w; } }
        { float lsum;
          attn_branch<1>(L, zb, ZKW + 64 * g, ZVW + 64 * g, qt >= 8 ? qt - 8 : 0, qt, qt, qrel, 0u, qr, o0, o1, lsum, tid, wid);
          if (hi == 0) wsf[r32] = sg2 * __builtin_amdgcn_rcpf(lsum);
          asm volatile("s_waitcnt lgkmcnt(0)" ::: "memory");
#pragma unroll
          for (int r = 0; r < 16; ++r) { const float w = wsf[crow(r, hi)]; otl[r * 64] += o0[r] * w; otl[(16 + r) * 64] += o1[r] * w; }
          asm volatile("s_waitcnt lgkmcnt(0)" ::: "memory"); }
        LBAR();
        if (U + C.G < 1024) UNIT_FETCH(U + C.G);
        const int c8 = lane * 8; const int tk0 = 64 * qt + 32 * g + 4 * wid;
        u32x4 whc[4], wbg[4], wcg[4], wpa[2], wpb[2];
        { const int tp = tk0 >= 2 ? tk0 - 2 : 0;
#pragma unroll
          for (int i = 0; i < 2; ++i) { wpa[i] = *(const u32x4*)zt(zb, tp + i, ZHC + c8); wpb[i] = *(const u32x4*)zt(zb, tp + i, ZCG + c8); }
#pragma unroll
          for (int i = 0; i < 4; ++i) { whc[i] = *(const u32x4*)zt(zb, tk0 + i, ZHC + c8); wbg[i] = *(const u32x4*)zt(zb, tk0 + i, ZBG + c8); wcg[i] = *(const u32x4*)zt(zb, tk0 + i, ZCG + c8); } }
        { const LAS float* ow = (const LAS float*)(L + AOT) + wid * 2048; const size_t rowb = (size_t)b * SEQ + 64 * qt + 32 * th;
          const int d = 8 * (lane & 7);
          const f32x4 g0 = *(const f32x4*)(gout + 64 * head + d), g1 = *(const f32x4*)(gout + 64 * head + d + 4);
#pragma unroll
          for (int i = 0; i < 4; ++i) { const int q = i * 8 + (lane >> 3);
              const LAS float* src = ow + (16 * (d >> 5) + (q & 3) + 4 * (q >> 3)) * 64 + (d & 31) + 32 * ((q >> 2) & 1);
              const f32x4 v0 = *(const LAS f32x4*)src, v1 = *(const LAS f32x4*)(src + 4);
              float ss = (v0.x * v0.x + v0.y * v0.y) + (v0.z * v0.z + v0.w * v0.w) + (v1.x * v1.x + v1.y * v1.y) + (v1.z * v1.z + v1.w * v1.w);
              ss = sum8_dpp(ss);
              const u32x4 w4 = {cvt_pk_bf16(v0.x * g0.x, v0.y * g0.y), cvt_pk_bf16(v0.z * g0.z, v0.w * g0.w), cvt_pk_bf16(v1.x * g1.x, v1.y * g1.y), cvt_pk_bf16(v1.z * g1.z, v1.w * g1.w)};
              *(u32x4*)((char*)omix + pg8::tl_off((int)(rowb + q), 64 * head + d, D)) = w4;
              if ((lane & 7) == 0) asq[(rowb + q) * 8 + head] = ss; } }
        { float w0[8], w1[8], w2[8], cb[8], gc[8];
#pragma unroll
          for (int e = 0; e < 8; ++e) { w0[e] = conv_w[c8 + e]; w1[e] = conv_w[512 + c8 + e]; w2[e] = conv_w[1024 + c8 + e]; cb[e] = conv_b[c8 + e]; gc[e] = gout[512 + c8 + e]; }
          float um2[8], um1[8];
          { float ta[8], tb[8]; const float zf = tk0 == 0 ? 0.f : 1.f;
            unpack8(wpa[0], ta); unpack8(wpb[0], tb);
#pragma unroll
            for (int e = 0; e < 8; ++e) um2[e] = ta[e] * tb[e] * zf;
            unpack8(wpa[1], ta); unpack8(wpb[1], tb);
#pragma unroll
            for (int e = 0; e < 8; ++e) um1[e] = ta[e] * tb[e] * zf; }
          float oc[4][8], s2[4];
#pragma unroll
          for (int i = 0; i < 4; ++i) {
              float hc[8], bg[8], cg[8];
              unpack8(whc[i], hc); unpack8(wbg[i], bg); unpack8(wcg[i], cg);
              s2[i] = 0.f;
#pragma unroll
              for (int e = 0; e < 8; ++e) { const float u = cg[e] * hc[e]; const float v = cb[e] + um2[e] * w0[e] + um1[e] * w1[e] + u * w2[e]; oc[i][e] = bg[e] * v; s2[i] += oc[i][e] * oc[i][e]; um2[e] = um1[e]; um1[e] = u; } }
#pragma unroll
          for (int i = 0; i < 4; ++i) s2[i] = sum64_dpp(s2[i]);
#pragma unroll
          for (int i = 0; i < 4; ++i) { const float rc = __builtin_amdgcn_rsqf(s2[i] * (1.0f / 512.0f) + EPS);
              u32x4 o;
              o.x = cvt_pk_bf16(oc[i][0] * rc * gc[0], oc[i][1] * rc * gc[1]); o.y = cvt_pk_bf16(oc[i][2] * rc * gc[2], oc[i][3] * rc * gc[3]);
              o.z = cvt_pk_bf16(oc[i][4] * rc * gc[4], oc[i][5] * rc * gc[5]); o.w = cvt_pk_bf16(oc[i][6] * rc * gc[6], oc[i][7] * rc * gc[7]);
              *(u32x4*)((char*)omix + pg8::tl_off(b * SEQ + tk0 + i, 512 + c8, D)) = o; } }
    }
#undef UNIT_FETCH
    asm volatile("s_waitcnt lgkmcnt(0)" ::: "memory"); __builtin_amdgcn_s_barrier();
    __builtin_amdgcn_s_setprio(0);
}

__global__ void __launch_bounds__(512, 2) nsa_fwd(Args args) {
    extern __shared__ __attribute__((aligned(16))) unsigned char lds[];
    Ctx C;
    C.L = (LAS unsigned char*)lds;
    C.G = gridDim.x; C.bx = blockIdx.x; { const int bx = blockIdx.x; C.vcu = (C.G % 8 == 0) ? (bx % 8) * (C.G / 8) + bx / 8 : bx; }
    for (int u = threadIdx.x; u < (LDS_BYTES - CTRL_OFF) / 4; u += 512) ((LAS unsigned*)(C.L + CTRL_OFF))[u] = 0u;
    __syncthreads();
    XcdBarrier bar = xcd_barrier_post((unsigned*)(args.ws + WS_CTL) + CW_BAR, (volatile LAS unsigned*)(C.L + MISC_OFF + 32));

#define GRID_SYNC() do { XcdBarrier b_ = bar; unsigned long long bp_ = (unsigned long long)b_.bar; unsigned bx_ = b_.x; asm volatile("" : "+s"(bp_), "+s"(bx_)); b_.bar = (unsigned*)bp_; b_.x = bx_; xcd_barrier(b_); } while (0)
    prologue(C);
    GRID_SYNC();
    prologue2(C);
    GRID_SYNC();

    for (int l = 0; l < DEPTH; ++l) {
        for (int half = 0; half < 2; ++half) {
            const int sub = half ? 2 : 0;
            { const ArgsP A = get_args(); const Ctx Cl = launder(C);
              pg8::Gemm g{(const bf16*)(A->ws + WS_H), (const bf16*)(A->ws + WS_WFI) + (size_t)(l * 2 + half) * NFI * D, M, NFI, D}; pg8::StaticOrder S; S.init(M, NFI, Cl.G, Cl.bx);
              pg8::EpiSwiGLU E{(bf16*)(A->ws + WS_ZB), FF, (const float*)(A->ws + WS_RSQ), (const float*)(A->ws + WS_SBW) + (size_t)(3 * l + sub) * NB * NFI, NFI};
              pg8::gemm_phase<pg8::EpiSwiGLU, pg8::StaticOrder, true, true>(Cl.L, g, S, E); }
            GRID_SYNC();
            { const ArgsP A = get_args(); const Ctx Cl = launder(C);
              const int nl = half ? (l < DEPTH - 1 ? l + 1 : l) : l, nsub = half ? 0 : 1;
              const float* modn = (const float*)(A->ws + WS_MOD) + (size_t)nl * NB * MODW + nsub * 3072;
              pg8::Gemm g{(const bf16*)(A->ws + WS_ZB), (const bf16*)(A->ws + WS_WFO) + (size_t)(l * 2 + half) * D * FF, M, D, FF}; pg8::StaticOrder S; S.init(M, D, Cl.G, Cl.bx);
              pg8::EpiResid E{(unsigned*)(A->ws + WS_X), (const float*)(A->ws + WS_MOD) + (size_t)l * NB * MODW + sub * 3072 + 2048,
                              (bf16*)(A->ws + WS_H), A->in[4] + (size_t)(nl * 3 + nsub) * D, modn + 1024, (float*)(A->ws + WS_RSQ), MODW, 0.5f};
              pg8::gemm_phase<pg8::EpiResid, pg8::StaticOrder, true, true>(Cl.L, g, S, E); }
            GRID_SYNC();
            if (half == 0) {
                { const ArgsP A = get_args(); const Ctx Cl = launder(C);
                  pg8::Gemm g{(const bf16*)(A->ws + WS_H), (const bf16*)(A->ws + WS_WMI) + (size_t)l * ZW * D, M, ZW, D}; pg8::StaticOrder S; S.init(M, ZW, Cl.G, Cl.bx);
                  pg8::EpiBf16Plain E{(bf16*)(A->ws + WS_ZB), ZW, (const float*)(A->ws + WS_RSQ), (const float*)(A->ws + WS_SBW) + (size_t)(3 * l + 1) * NB * NFI, NFI, 2};
                  pg8::gemm_phase<pg8::EpiBf16Plain, pg8::StaticOrder, true, true>(Cl.L, g, S, E); }
                GRID_SYNC();
                compress_phase(C, l);
                GRID_SYNC();
                attn_phase(C, l);
                GRID_SYNC();
                { const ArgsP A = get_args(); const Ctx Cl = launder(C);
                  const float* modn = (const float*)(A->ws + WS_MOD) + (size_t)l * NB * MODW + 2 * 3072;
                  pg8::Gemm g{(const bf16*)(A->ws + WS_OMIX), (const bf16*)(A->ws + WS_WMO) + (size_t)l * D * D, M, D, D}; pg8::StaticOrder S; S.init(M, D, Cl.G, Cl.bx);
                  pg8::EpiResidMix E; E.x16 = (unsigned*)(A->ws + WS_X); E.gate = (const float*)(A->ws + WS_MOD) + (size_t)l * NB * MODW + 3072 + 2048; E.hs = (bf16*)(A->ws + WS_H);
                  E.gn = A->in[4] + (size_t)(l * 3 + 2) * D; E.scale = modn + 1024; E.rowsq = (float*)(A->ws + WS_RSQ); E.mod_stride = MODW; E.coef = 1.0f; E.asq = (const float*)(A->ws + WS_ASQ);
                  pg8::gemm_phase<pg8::EpiResidMix, pg8::StaticOrder, true, true>(Cl.L, g, S, E); }
                GRID_SYNC();
            }
        }
    }
    finalnorm_phase(C);
}

extern "C" void kernel_launch(void* const* d_in, const int* in_sizes, int n_in, void* d_out, int out_size, void* d_ws, size_t ws_size, hipStream_t stream) {
    static int grid = 0;
    if (grid == 0) {
        if (n_in != 16 || in_sizes[0] != M * D || out_size != M * D || ws_size < WS_END) { fprintf(stderr, "kernel_launch: unexpected shapes (n_in %d, in0 %d, out %d, ws %zu); nothing launched\n", n_in, n_in > 0 ? in_sizes[0] : -1, out_size, ws_size); grid = -1; return; }
        int dev = 0, cus = 0;
        if (hipGetDevice(&dev) != hipSuccess || hipDeviceGetAttribute(&cus, hipDeviceAttributeMultiprocessorCount, dev) != hipSuccess) { grid = -1; return; }
        if (hipFuncSetAttribute((const void*)nsa_fwd, hipFuncAttributeMaxDynamicSharedMemorySize, LDS_BYTES) != hipSuccess) { fprintf(stderr, "kernel_launch: hipFuncSetAttribute failed\n"); grid = -1; return; }
        int per_cu = 0;
        if (hipOccupancyMaxActiveBlocksPerMultiprocessor(&per_cu, (const void*)nsa_fwd, 512, LDS_BYTES) != hipSuccess || per_cu < 1) fprintf(stderr, "kernel_launch: occupancy query reports %d\n", per_cu);
        (void)hipGetLastError();
        grid = cus;
    }
    if (grid < 0) return;
    if (hipMemsetAsync((char*)d_ws + WS_CTL, 0, CTL_ZERO_BYTES, stream) != hipSuccess) return;
    Args a{};
    for (int i = 0; i < 16; ++i) a.in[i] = (const float*)d_in[i];
    a.out = (float*)d_out; a.ws = (unsigned char*)d_ws;
    hipLaunchKernelGGL(nsa_fwd, dim3(grid), dim3(512), LDS_BYTES, stream, a);
}
```

```cpp
#include <hip/hip_runtime.h>
#include <cstdio>
#include <cstdint>
namespace pg8 {
#define PG8_LAS __attribute__((address_space(3)))
typedef unsigned short bf16_t;
typedef short bf16x8 __attribute__((ext_vector_type(8)));
typedef float f32x4 __attribute__((ext_vector_type(4)));
typedef unsigned u32x4 __attribute__((ext_vector_type(4)));
constexpr int BM = 256, BK = 64, HALF = 128, HTB = HALF * BK * 2  , STAGE_BYTES = 8 * HTB, NXCD = 8, WGM = 8;

__host__ __device__ __forceinline__ int lds_byte(int r, int c) { const int st = (r >> 4) * 2 + (c >> 5), rr = r & 15, cc = c & 31, ob = rr * 64 + cc * 2; return st * 1024 + (ob ^ (((ob >> 9) & 1) << 5)); }
__host__ __device__ __forceinline__ void stage_rc(int b, int& R, int& C) { const int st = b / 1024, sb = b % 1024, swz = sb ^ (((sb >> 9) & 1) << 5); R = (st >> 1) * 16 + swz / 64; C = (st & 1) * 32 + (swz % 64) / 2; }
__host__ __device__ __forceinline__ int perm32(int rho) { const int n = rho >> 4, i = rho & 15; return 8 * (i >> 2) + 4 * n + (i & 3); }

__host__ __device__ __forceinline__ size_t tl_off(int row, int col, int K) { return ((size_t)((row >> 4) * (K >> 5) + (col >> 5)) << 10) + (size_t)(((row & 15) << 6) + ((col & 31) << 1)); }
struct Unit { int pm, pn; };
struct Gemm { const bf16_t* A; const bf16_t* Bt; int M, N, K; };

struct StaticOrder {
    int nM, nN, nwg, G, c;
    __host__ __device__ void init(int M, int N, int G_, int c_) { nM = M / BM; nN = N / BM; nwg = nM * nN; G = G_; c = c_; }
    __host__ __device__ bool next(int i, Unit& u) const {
        const long L = (long)i * G + c; if (L >= nwg) return false;
        int wgid = (int)L; { const int q = nwg / NXCD, r = nwg % NXCD, xcd = wgid % NXCD, off = wgid / NXCD; wgid = (xcd < r ? xcd * (q + 1) : r * (q + 1) + (xcd - r) * q) + off; }
        const int nig = WGM * nN, gid = wgid / nig, fm = gid * WGM, gsz = (nM - fm) < WGM ? (nM - fm) : WGM;
        u.pm = fm + ((wgid % nig) % gsz); u.pn = (wgid % nig) / gsz; return true;
    }
    __device__ __forceinline__ void a_ready(const Unit&) const {}
    __device__ __forceinline__ void done(const Unit&) const {}
};

#define PG8_GAS __attribute__((address_space(1)))
typedef float f32x2 __attribute__((ext_vector_type(2)));
typedef unsigned u32x2 __attribute__((ext_vector_type(2)));
typedef _Float16 f16x2_t __attribute__((ext_vector_type(2)));
__device__ __forceinline__ unsigned cvt_pk_f16(float lo, float hi) { f32x2 v = {lo, hi}; f16x2_t h = __builtin_convertvector(v, f16x2_t); return __builtin_bit_cast(unsigned, h); }
typedef _Float16 f16x4_t __attribute__((ext_vector_type(4)));
__device__ __forceinline__ f32x4 unpack_f16x4(u32x2 w) { const f16x4_t h = __builtin_bit_cast(f16x4_t, w); return __builtin_convertvector(h, f32x4); }
typedef __bf16 bf16x2_t __attribute__((ext_vector_type(2)));
__device__ __forceinline__ unsigned cvt_pk_bf16(float lo, float hi) { f32x2 v = {lo, hi}; bf16x2_t b = __builtin_convertvector(v, bf16x2_t); return __builtin_bit_cast(unsigned, b); }
__device__ __forceinline__ float silu_f(float x) { return x * __builtin_amdgcn_rcpf(1.0f + __builtin_amdgcn_exp2f(-1.4426950408889634f * x)); }

__device__ __forceinline__ float xsum16(float s) { return s + __shfl_xor(s, 16); }
__device__ __forceinline__ float xsum32(float s) { const auto r = __builtin_amdgcn_permlane32_swap(__float_as_uint(s), __float_as_uint(s), false, false); return __uint_as_float(r[0]) + __uint_as_float(r[1]); }
__device__ __forceinline__ void xl_prefetch_consumer(const float* rowsq, const float* biasrow, int pm, PG8_LAS unsigned char* xl, int, int) {
    int t_ = threadIdx.x; asm volatile("" : "+v"(t_)); const int lane = t_ & 63, wid = __builtin_amdgcn_readfirstlane(t_ >> 6);
    if (wid < 4) __builtin_amdgcn_global_load_lds((const unsigned*)(rowsq + (size_t)wid * (128 * 256) + (size_t)pm * 256 + 4 * lane), (PG8_LAS unsigned*)(xl + wid * 1024), 16, 0, 0);
    if (wid == 4) __builtin_amdgcn_global_load_lds((const unsigned*)(biasrow + 4 * lane), (PG8_LAS unsigned*)(xl + 16384), 16, 0, 0);
}
__device__ __forceinline__ void epi_loads(float (&rs)[2][4], f32x4 (&bv)[4], PG8_LAS unsigned char* xl, int wr, int wc, int fr, int fq) {
    const unsigned ra = (unsigned)(size_t)xl + (unsigned)(fq * 1024 + (wr * 64 + fr) * 4);
    const unsigned ba = (unsigned)(size_t)xl + 16384u + (unsigned)((wc * 32 + 8 * fq) * 4);
    float p[2][4];
    asm volatile("ds_read_b32 %0, %12\n\tds_read_b32 %1, %12 offset:64\n\tds_read_b32 %2, %12 offset:128\n\tds_read_b32 %3, %12 offset:192\n\t"
                 "ds_read_b32 %4, %12 offset:512\n\tds_read_b32 %5, %12 offset:576\n\tds_read_b32 %6, %12 offset:640\n\tds_read_b32 %7, %12 offset:704\n\t"
                 "ds_read_b128 %8, %13\n\tds_read_b128 %9, %13 offset:16\n\tds_read_b128 %10, %13 offset:512\n\tds_read_b128 %11, %13 offset:528\n\t"
                 "s_waitcnt lgkmcnt(0)"
                 : "=&v"(p[0][0]), "=&v"(p[0][1]), "=&v"(p[0][2]), "=&v"(p[0][3]), "=&v"(p[1][0]), "=&v"(p[1][1]), "=&v"(p[1][2]), "=&v"(p[1][3]), "=&v"(bv[0]), "=&v"(bv[1]), "=&v"(bv[2]), "=&v"(bv[3])
                 : "v"(ra), "v"(ba) : "memory");
#pragma unroll
    for (int ai = 0; ai < 2; ++ai)
#pragma unroll
        for (int m = 0; m < 4; ++m) { float s = xsum32(xsum16(p[ai][m])); rs[ai][m] = __builtin_amdgcn_rsqf(s * (1.0f / 1024.0f) + 1e-6f); }
}
__device__ __forceinline__ void zero4(f32x4& v) { float a, b, c, d;
    asm volatile("v_mov_b32 %0, 0\n\tv_mov_b32 %1, 0\n\tv_mov_b32 %2, 0\n\tv_mov_b32 %3, 0" : "=v"(a), "=v"(b), "=v"(c), "=v"(d)); v = (f32x4){a, b, c, d}; }
struct EpiBf16Plain {
    static constexpr bool PERM = true, AFTER_DRAIN = false, PREFETCH = true, MIDSCALE = false; static constexpr bool KSERP = true;
    __device__ __forceinline__ void prefetch(const Unit& u, PG8_LAS unsigned char* xl, int wid, int lane) const { xl_prefetch_consumer(rowsq, bias + (size_t)(u.pm >> 3) * bias_stride + u.pn * BM, u.pm, xl, wid, lane); }
    bf16_t* O; int ldc; const float* rowsq; const float* bias; int bias_stride; int qtiles;
    static constexpr float QSCALE = 0.125f * 1.4426950408889634f;
    __device__ __forceinline__ void operator()(f32x4 (&acc)[2][2][4][2], const Unit& u, int wr, int wc, int fr, int fq, PG8_LAS unsigned char* xl) const {
        const int row0 = u.pm * BM + wr * 64 + fr; const int col0 = u.pn * BM + wc * 32 + 8 * fq;
        const float* bp = bias + (size_t)(u.pm >> 3) * bias_stride + col0;
        f32x4 bvl[4]; float rsv[2][4]; epi_loads(rsv, bvl, xl, wr, wc, fr, fq);
        if (u.pn < qtiles) {
#pragma unroll
            for (int i = 0; i < 4; ++i) bvl[i] *= QSCALE;
#pragma unroll
            for (int ai = 0; ai < 2; ++ai)
#pragma unroll
                for (int m = 0; m < 4; ++m) rsv[ai][m] *= QSCALE; }
#pragma unroll
        for (int ai = 0; ai < 2; ++ai)
#pragma unroll
            for (int m = 0; m < 4; ++m) { const int row = row0 + ai * HALF + m * 16; const float rs = rsv[ai][m];
#pragma unroll
                for (int bj = 0; bj < 2; ++bj) { const f32x4 v0 = acc[ai][bj][m][0] * rs + bvl[2 * bj], v1 = acc[ai][bj][m][1] * rs + bvl[2 * bj + 1];
                    zero4(acc[ai][bj][m][0]); zero4(acc[ai][bj][m][1]);
                    u32x4 w; w.x = cvt_pk_bf16(v0[0], v0[1]); w.y = cvt_pk_bf16(v0[2], v0[3]); w.z = cvt_pk_bf16(v1[0], v1[1]); w.w = cvt_pk_bf16(v1[2], v1[3]);
                    *(PG8_GAS u32x4*)((char*)O + tl_off(row, col0 + bj * HALF, ldc)) = w; } }
    }
};
struct EpiSwiGLU {
    static constexpr bool PERM = true, AFTER_DRAIN = false, PREFETCH = true, MIDSCALE = false; static constexpr bool KSERP = true;
    __device__ __forceinline__ void prefetch(const Unit& u, PG8_LAS unsigned char* xl, int wid, int lane) const { xl_prefetch_consumer(rowsq, bias + (size_t)(u.pm >> 3) * bias_stride + u.pn * BM, u.pm, xl, wid, lane); }
    bf16_t* O; int ldo; const float* rowsq; const float* bias; int bias_stride;
    __device__ __forceinline__ void operator()(f32x4 (&acc)[2][2][4][2], const Unit& u, int wr, int wc, int fr, int fq, PG8_LAS unsigned char* xl) const {
        const int row0 = u.pm * BM + wr * 64 + fr; const int col0 = u.pn * HALF + wc * 32 + 8 * fq;
        const float* bp = bias + (size_t)(u.pm >> 3) * bias_stride + u.pn * BM + wc * 32 + 8 * fq;
        f32x4 bvl[4]; float rsv[2][4]; epi_loads(rsv, bvl, xl, wr, wc, fr, fq);
        const f32x4 bg0 = bvl[0], bg1 = bvl[1], bu0 = bvl[2], bu1 = bvl[3];
#pragma unroll
        for (int ai = 0; ai < 2; ++ai)
#pragma unroll
            for (int m = 0; m < 4; ++m) { const int row = row0 + ai * HALF + m * 16; const float rs = rsv[ai][m]; bf16_t* rowp = (bf16_t*)((char*)O + tl_off(row, col0, ldo));
                const f32x4 g0 = acc[ai][0][m][0] * rs + bg0, g1 = acc[ai][0][m][1] * rs + bg1, u0 = acc[ai][1][m][0] * rs + bu0, u1 = acc[ai][1][m][1] * rs + bu1;
                zero4(acc[ai][0][m][0]); zero4(acc[ai][0][m][1]); zero4(acc[ai][1][m][0]); zero4(acc[ai][1][m][1]);
                u32x4 w;
                w.x = cvt_pk_bf16(silu_f(g0[0]) * u0[0], silu_f(g0[1]) * u0[1]); w.y = cvt_pk_bf16(silu_f(g0[2]) * u0[2], silu_f(g0[3]) * u0[3]);
                w.z = cvt_pk_bf16(silu_f(g1[0]) * u1[0], silu_f(g1[1]) * u1[1]); w.w = cvt_pk_bf16(silu_f(g1[2]) * u1[2], silu_f(g1[3]) * u1[3]);
                *(PG8_GAS u32x4*)rowp = w; }
    }
};
struct EpiResid {
    static constexpr bool PERM = true, AFTER_DRAIN = false, PREFETCH = true, MIDSCALE = false; static constexpr bool KSERP = true;
    __device__ __forceinline__ void prefetch(const Unit& u, PG8_LAS unsigned char* xl, int, int) const {
        int t_ = threadIdx.x; asm volatile("" : "+v"(t_)); const int lane = t_ & 63, wid = __builtin_amdgcn_readfirstlane(t_ >> 6);
        if (wid == 0) __builtin_amdgcn_global_load_lds((const unsigned*)(gate + (size_t)(u.pm >> 3) * mod_stride + u.pn * BM + 4 * lane), (PG8_LAS unsigned*)(xl), 16, 0, 0);
        if (wid == 1) __builtin_amdgcn_global_load_lds((const unsigned*)(gn + u.pn * BM + 4 * lane), (PG8_LAS unsigned*)(xl + 1024), 16, 0, 0);
        if (wid == 2) __builtin_amdgcn_global_load_lds((const unsigned*)(scale + (size_t)(u.pm >> 3) * mod_stride + u.pn * BM + 4 * lane), (PG8_LAS unsigned*)(xl + 2048), 16, 0, 0);
    }
    unsigned* x16;   const float* gate; bf16_t* hs; const float* gn; const float* scale; float* rowsq; int mod_stride; float coef;
    __device__ __forceinline__ void operator()(f32x4 (&acc)[2][2][4][2], const Unit& u, int wr, int wc, int fr, int fq, PG8_LAS unsigned char* xl) const {
        const int row0 = u.pm * BM + wr * 64 + fr; const int col0 = u.pn * BM + wc * 32 + 8 * fq;
        f32x4 gv[2][2], av[2][2];
        { f32x4 sv[2][2]; const unsigned la = (unsigned)(size_t)xl + (unsigned)((wc * 32 + 8 * fq) * 4);
          asm volatile("ds_read_b128 %0, %12\n\tds_read_b128 %1, %12 offset:16\n\tds_read_b128 %2, %12 offset:512\n\tds_read_b128 %3, %12 offset:528\n\t"
                       "ds_read_b128 %4, %12 offset:1024\n\tds_read_b128 %5, %12 offset:1040\n\tds_read_b128 %6, %12 offset:1536\n\tds_read_b128 %7, %12 offset:1552\n\t"
                       "ds_read_b128 %8, %12 offset:2048\n\tds_read_b128 %9, %12 offset:2064\n\tds_read_b128 %10, %12 offset:2560\n\tds_read_b128 %11, %12 offset:2576\n\t"
                       "s_waitcnt lgkmcnt(0)"
                       : "=&v"(gv[0][0]), "=&v"(gv[0][1]), "=&v"(gv[1][0]), "=&v"(gv[1][1]), "=&v"(av[0][0]), "=&v"(av[0][1]), "=&v"(av[1][0]), "=&v"(av[1][1]), "=&v"(sv[0][0]), "=&v"(sv[0][1]), "=&v"(sv[1][0]), "=&v"(sv[1][1])
                       : "v"(la) : "memory");
#pragma unroll
          for (int bj = 0; bj < 2; ++bj)
#pragma unroll
              for (int n = 0; n < 2; ++n) { gv[bj][n] = gv[bj][n] * coef; av[bj][n] = av[bj][n] * (sv[bj][n] + 1.0f); } }
        u32x4 xa[2], xb[2], xc[2]; float sqv[8];
#define EPR_LOAD(dst, rg) do { const int rw_ = row0 + ((rg) >> 2) * HALF + ((rg) & 3) * 16; _Pragma("unroll") for (int bj = 0; bj < 2; ++bj) \
            dst[bj] = *(const PG8_GAS u32x4*)((const char*)x16 + tl_off(rw_, col0 + bj * HALF, 1024)); } while (0)
#define EPR_ROW(src, rg) do { const int ai_ = (rg) >> 2, m_ = (rg) & 3; const int rw_ = row0 + ai_ * HALF + m_ * 16; float sq_ = 0.f; \
            _Pragma("unroll") for (int bj = 0; bj < 2; ++bj) { const f32x4 x0 = unpack_f16x4((u32x2){src[bj].x, src[bj].y}) + gv[bj][0] * acc[ai_][bj][m_][0], x1 = unpack_f16x4((u32x2){src[bj].z, src[bj].w}) + gv[bj][1] * acc[ai_][bj][m_][1]; \
                { const u32x4 xw = {cvt_pk_f16(x0[0], x0[1]), cvt_pk_f16(x0[2], x0[3]), cvt_pk_f16(x1[0], x1[1]), cvt_pk_f16(x1[2], x1[3])}; *(PG8_GAS u32x4*)((char*)x16 + tl_off(rw_, col0 + bj * HALF, 1024)) = xw; } \
                sq_ += ((x0[0] * x0[0] + x0[1] * x0[1]) + (x0[2] * x0[2] + x0[3] * x0[3])) + ((x1[0] * x1[0] + x1[1] * x1[1]) + (x1[2] * x1[2] + x1[3] * x1[3])); \
                const f32x4 h0 = x0 * av[bj][0], h1 = x1 * av[bj][1]; const u32x4 w = {cvt_pk_bf16(h0[0], h0[1]), cvt_pk_bf16(h0[2], h0[3]), cvt_pk_bf16(h1[0], h1[1]), cvt_pk_bf16(h1[2], h1[3])}; \
                *(PG8_GAS u32x4*)((char*)hs + tl_off(rw_, col0 + bj * HALF, 1024)) = w; zero4(acc[ai_][bj][m_][0]); zero4(acc[ai_][bj][m_][1]); } \
            sqv[(rg)] = xsum32(xsum16(sq_)); } while (0)
        EPR_LOAD(xa, 0); EPR_LOAD(xb, 1);
        EPR_LOAD(xc, 2); EPR_ROW(xa, 0);
        EPR_LOAD(xa, 3); EPR_ROW(xb, 1);
        EPR_LOAD(xb, 4); EPR_ROW(xc, 2);
        EPR_LOAD(xc, 5); EPR_ROW(xa, 3);
        EPR_LOAD(xa, 6); EPR_ROW(xb, 4);
        EPR_LOAD(xb, 7); EPR_ROW(xc, 5);
        EPR_ROW(xa, 6);
        EPR_ROW(xb, 7);
        { PG8_LAS float* S = (PG8_LAS float*)(xl + 14336);
          if (fq == 0) {
#pragma unroll
              for (int rg = 0; rg < 8; ++rg) S[wc * 256 + (rg >> 2) * HALF + wr * 64 + (rg & 3) * 16 + fr] = sqv[rg]; }
          asm volatile("s_waitcnt lgkmcnt(0)" ::: "memory"); __builtin_amdgcn_s_barrier(); asm volatile("" ::: "memory");
          const int wid_ = wr * 4 + wc;
          if (wid_ < 4) { const int r = wid_ * 64 + fq * 16 + fr; const float s = (S[r] + S[256 + r]) + (S[512 + r] + S[768 + r]);
              *(PG8_GAS float*)(rowsq + (size_t)u.pn * (128 * 256) + (size_t)u.pm * BM + r) = s; } }
#undef EPR_LOAD
#undef EPR_ROW
    }
};


struct EpiResidMix : EpiResid {
    static constexpr bool MIDSCALE = true; static constexpr int MID_T = 8; static constexpr bool KSERP = false;
    const float* asq;
    __device__ __forceinline__ void prefetch(const Unit& u, PG8_LAS unsigned char* xl, int a_, int b_) const {
        EpiResid::prefetch(u, xl, a_, b_);
        int t_ = threadIdx.x; asm volatile("" : "+v"(t_)); const int lane = t_ & 63, wid = __builtin_amdgcn_readfirstlane(t_ >> 6);
        __builtin_amdgcn_global_load_lds((const unsigned*)(asq + ((size_t)u.pm * 256 + 32 * wid) * 8 + 4 * lane), (PG8_LAS unsigned*)(xl + 4096 + wid * 1024), 16, 0, 0);
    }
    __device__ __forceinline__ void midscale(f32x4 (&acc)[2][2][4][2], int wr, int fr, int fq, PG8_LAS unsigned char* xl) const {
        const unsigned la = (unsigned)(size_t)xl + 4096u + (unsigned)((wr * 64 + fr) * 32 + fq * 8);
        f32x2 p[2][4];
        asm volatile("ds_read_b64 %0, %8\n\tds_read_b64 %1, %8 offset:512\n\tds_read_b64 %2, %8 offset:1024\n\tds_read_b64 %3, %8 offset:1536\n\t"
                     "ds_read_b64 %4, %8 offset:4096\n\tds_read_b64 %5, %8 offset:4608\n\tds_read_b64 %6, %8 offset:5120\n\tds_read_b64 %7, %8 offset:5632\n\t"
                     "s_waitcnt lgkmcnt(0)"
                     : "=&v"(p[0][0]), "=&v"(p[0][1]), "=&v"(p[0][2]), "=&v"(p[0][3]), "=&v"(p[1][0]), "=&v"(p[1][1]), "=&v"(p[1][2]), "=&v"(p[1][3])
                     : "v"(la) : "memory");
#pragma unroll
        for (int ai = 0; ai < 2; ++ai)
#pragma unroll
            for (int m = 0; m < 4; ++m) { float sq = p[ai][m][0] + p[ai][m][1]; sq = xsum32(xsum16(sq)); const float r = __builtin_amdgcn_rsqf(sq * (1.0f / 512.0f) + 1e-6f);
#pragma unroll
                for (int bj = 0; bj < 2; ++bj)
#pragma unroll
                    for (int n = 0; n < 2; ++n) acc[ai][bj][m][n] *= r; }
    }
};
template <class Epi, class Sched, bool ALIGN_EPI = false, bool SP2 = false>
__device__ __forceinline__ void gemm_phase(PG8_LAS unsigned char* lds, const Gemm g, const Sched& S, const Epi& E) {
    int tid_ = threadIdx.x; asm volatile("" : "+v"(tid_)); const int tid = tid_, wid = __builtin_amdgcn_readfirstlane(tid >> 6), lane = tid & 63, wr = wid >> 2, wc = wid & 3, fr = lane & 15, fq = lane >> 4;
    const int K = g.K, nt = K / BK;
    unsigned voffA[2], voffB[2];
#pragma unroll
    for (int i = 0; i < 2; ++i) { int R, C; stage_rc(tid * 16 + i * 8192, R, C); const int Rb = Epi::PERM ? ((R & ~31) + perm32(R & 31)) : R;
        voffA[i] = (unsigned)tl_off(R, C, K); voffB[i] = (unsigned)tl_off(Rb, C, K); }
    const size_t kstep = (size_t)2048;
    const size_t hstep = (size_t)HALF * K * 2;
    const size_t tstep = 2 * hstep;
    const unsigned ldsw = (unsigned)wid * 1024u;
    const int aoff = lds_byte(wr * 64 + fr, fq * 8), boff = lds_byte(wc * 32 + fr, fq * 8);
#define PG8_SA(b, h) (((b) * 2 + (h)) * HTB)
#define PG8_SB(b, h) ((4 + (b) * 2 + (h)) * HTB)
#define PG8_STAGE(bufoff, gbase, voff) do { _Pragma("unroll") for (int _i = 0; _i < 2; ++_i) \
        __builtin_amdgcn_global_load_lds((const unsigned*)((const char*)(gbase) + (voff)[_i]), (PG8_LAS unsigned*)(lds + (bufoff) + ldsw + _i * 8192), 16, 0, 0); } while (0)
#define PG8_LDA(dst, b, h) do { _Pragma("unroll") for (int m = 0; m < 4; ++m) _Pragma("unroll") for (int k = 0; k < 2; ++k) dst[m][k] = *(const PG8_LAS bf16x8*)(lds + PG8_SA(b, h) + aoff + m * 2048 + k * 1024); } while (0)
#define PG8_LDB(dst, b, h) do { _Pragma("unroll") for (int n = 0; n < 2; ++n) _Pragma("unroll") for (int k = 0; k < 2; ++k) dst[n][k] = *(const PG8_LAS bf16x8*)(lds + PG8_SB(b, h) + boff + n * 2048 + k * 1024); } while (0)
#define PG8_MMA(ai, bj, At, Bt) do { __builtin_amdgcn_s_setprio(1); _Pragma("unroll") for (int m = 0; m < 4; ++m) _Pragma("unroll") for (int n = 0; n < 2; ++n) _Pragma("unroll") for (int k = 0; k < 2; ++k) \
        acc[ai][bj][m][n] = __builtin_amdgcn_mfma_f32_16x16x32_bf16(Bt[n][k], At[m][k], acc[ai][bj][m][n], 0, 0, 0); __builtin_amdgcn_s_setprio(0); } while (0)
#define PG8_WAIT_V(n) asm volatile("s_waitcnt vmcnt(" #n ")" ::: "memory")
#define PG8_WAIT_L(n) asm volatile("s_waitcnt lgkmcnt(" #n ")" ::: "memory")
#define PG8_BAR __builtin_amdgcn_s_barrier()
#define PG8_SCHED __builtin_amdgcn_sched_barrier(0)
    Unit cur, nxt; int ui = 0;
    if (!S.next(0, cur)) return;
    f32x4 acc[2][2][4][2];
#pragma unroll
    for (int a = 0; a < 2; ++a)
#pragma unroll
        for (int b = 0; b < 2; ++b)
#pragma unroll
            for (int m = 0; m < 4; ++m)
#pragma unroll
                for (int n = 0; n < 2; ++n) acc[a][b][m][n] = (f32x4){0.f, 0.f, 0.f, 0.f};
    bf16x8 At[4][2], B0[2][2], B1[2][2];
    const char* cA = (const char*)g.A + (size_t)cur.pm * tstep; const char* cB = (const char*)g.Bt + (size_t)cur.pn * tstep;
    S.a_ready(cur);
    if constexpr (Epi::PREFETCH) E.prefetch(cur, lds + STAGE_BYTES, wid, lane);
    if constexpr (SP2) {
        PG8_STAGE(PG8_SB(0, 0), cB, voffB); PG8_STAGE(PG8_SB(0, 1), cB + hstep, voffB); PG8_STAGE(PG8_SA(0, 0), cA, voffA); PG8_STAGE(PG8_SA(0, 1), cA + hstep, voffA);
        if (wr == 1) PG8_BAR;
        PG8_WAIT_V(2); PG8_BAR;
        PG8_STAGE(PG8_SB(1, 0), cB + kstep, voffB); PG8_STAGE(PG8_SA(1, 0), cA + kstep, voffA); PG8_STAGE(PG8_SB(1, 1), cB + hstep + kstep, voffB);
        PG8_WAIT_V(6); PG8_BAR;
    } else {
        PG8_STAGE(PG8_SB(0, 0), cB, voffB); PG8_STAGE(PG8_SA(0, 0), cA, voffA); PG8_STAGE(PG8_SB(0, 1), cB + hstep, voffB); PG8_STAGE(PG8_SA(0, 1), cA + hstep, voffA);
        if (wr == 1) PG8_BAR;
        PG8_WAIT_V(4); PG8_BAR;
        PG8_STAGE(PG8_SB(1, 0), cB + kstep, voffB); PG8_STAGE(PG8_SA(1, 0), cA + kstep, voffA); PG8_STAGE(PG8_SB(1, 1), cB + hstep + kstep, voffB);
        PG8_WAIT_V(6); PG8_BAR;
    }
    long ksc = (long)kstep;
    for (;;) {
        const bool has_next = S.next(ui + 1, nxt);
        const bool nrev = Epi::KSERP && has_next && (((ui + 1) & 1) != 0);
        const long ksn = has_next ? (nrev ? -(long)kstep : (long)kstep) : ksc;
        const size_t nofs = nrev ? (size_t)(nt - 1) * kstep : (size_t)0;
        const char* nA = has_next ? (const char*)g.A + (size_t)nxt.pm * tstep + nofs : cA; const char* nB = has_next ? (const char*)g.Bt + (size_t)nxt.pn * tstep + nofs : cB;
        for (int t = 0; t < nt; t += 2) {
            if constexpr (Epi::PREFETCH) { if (t == 2 && ui > 0) E.prefetch(cur, lds + STAGE_BYTES, wid, lane); }
            if constexpr (Epi::MIDSCALE) { if (t == Epi::MID_T) E.midscale(acc, wr, fr, fq, lds + STAGE_BYTES); }
            const bool last = (t == nt - 2);
            const char* a1 = cA + (long)(t + 1) * ksc;
            const char* a2 = last ? nA : cA + (long)(t + 2) * ksc; const char* b2 = last ? nB : cB + (long)(t + 2) * ksc;
            const long ks3 = last ? ksn : ksc;
            const char* a3 = a2 + ks3; const char* b3 = b2 + ks3;
            if (last && has_next) S.a_ready(nxt);
            if constexpr (SP2) {
            PG8_LDB(B0, 0, 0); PG8_LDB(B1, 0, 1); PG8_SCHED; PG8_LDA(At, 0, 0); PG8_STAGE(PG8_SA(1, 1), a1 + hstep, voffA);
            PG8_WAIT_V(8); PG8_WAIT_L(0); PG8_BAR; PG8_MMA(0, 0, At, B0); PG8_MMA(0, 1, At, B1); PG8_BAR; PG8_SCHED;
            PG8_LDA(At, 0, 1); PG8_STAGE(PG8_SB(0, 0), b2, voffB); PG8_STAGE(PG8_SB(0, 1), b2 + hstep, voffB); PG8_STAGE(PG8_SA(0, 0), a2, voffA);
            PG8_WAIT_V(8); PG8_WAIT_L(0); PG8_BAR; PG8_MMA(1, 0, At, B0); PG8_MMA(1, 1, At, B1); PG8_BAR; PG8_SCHED;
            PG8_LDB(B0, 1, 0); PG8_LDB(B1, 1, 1); PG8_SCHED; PG8_LDA(At, 1, 0); PG8_STAGE(PG8_SA(0, 1), a2 + hstep, voffA);
            PG8_WAIT_V(8); PG8_WAIT_L(0); PG8_BAR; PG8_MMA(0, 0, At, B0); PG8_MMA(0, 1, At, B1); PG8_BAR; PG8_SCHED;
            PG8_LDA(At, 1, 1); PG8_STAGE(PG8_SB(1, 0), b3, voffB); PG8_STAGE(PG8_SB(1, 1), b3 + hstep, voffB); PG8_STAGE(PG8_SA(1, 0), a3, voffA);
            PG8_WAIT_V(8); PG8_WAIT_L(0); PG8_BAR; PG8_MMA(1, 0, At, B0); PG8_MMA(1, 1, At, B1); PG8_BAR; PG8_SCHED;
            } else {
            PG8_LDB(B0, 0, 0); PG8_SCHED; PG8_LDA(At, 0, 0); PG8_STAGE(PG8_SA(1, 1), a1 + hstep, voffA);
            PG8_WAIT_L(8); PG8_BAR; PG8_WAIT_L(0); PG8_MMA(0, 0, At, B0); PG8_BAR; PG8_SCHED;
            PG8_LDB(B1, 0, 1); PG8_STAGE(PG8_SB(0, 0), b2, voffB);
            PG8_BAR; PG8_WAIT_L(0); PG8_MMA(0, 1, At, B1); PG8_BAR;
            PG8_LDA(At, 0, 1); PG8_STAGE(PG8_SA(0, 0), a2, voffA);
            PG8_BAR; PG8_WAIT_L(0); PG8_MMA(1, 0, At, B0); PG8_BAR; PG8_SCHED;
            PG8_STAGE(PG8_SB(0, 1), b2 + hstep, voffB);
            PG8_WAIT_V(6); PG8_BAR; PG8_MMA(1, 1, At, B1); PG8_BAR;
            PG8_LDB(B0, 1, 0); PG8_SCHED; PG8_LDA(At, 1, 0); PG8_STAGE(PG8_SA(0, 1), a2 + hstep, voffA);
            PG8_WAIT_L(8); PG8_BAR; PG8_WAIT_L(0); PG8_MMA(0, 0, At, B0); PG8_BAR; PG8_SCHED;
            PG8_LDB(B1, 1, 1); PG8_STAGE(PG8_SB(1, 0), b3, voffB);
            PG8_BAR; PG8_WAIT_L(0); PG8_MMA(0, 1, At, B1); PG8_BAR;
            PG8_LDA(At, 1, 1); PG8_STAGE(PG8_SA(1, 0), a3, voffA);
            PG8_BAR; PG8_WAIT_L(0); PG8_MMA(1, 0, At, B0); PG8_BAR; PG8_SCHED;
            PG8_STAGE(PG8_SB(1, 1), b3 + hstep, voffB);
            PG8_WAIT_V(6); PG8_BAR; PG8_MMA(1, 1, At, B1); PG8_BAR;
            }
        }
        if constexpr (ALIGN_EPI) { if (wr == 0) PG8_BAR; }
        if constexpr (!Epi::AFTER_DRAIN) { E(acc, cur, wr, wc, fr, fq, lds + STAGE_BYTES); S.done(cur); }
        if (!has_next) break;
        cur = nxt; cA = nA; cB = nB; ksc = ksn; ++ui;
        if constexpr (ALIGN_EPI) { if (wr == 1) PG8_BAR; }
    }
    PG8_WAIT_V(0);
    if constexpr (!ALIGN_EPI) { if (wr == 0) PG8_BAR; }
    PG8_BAR;
    if constexpr (Epi::AFTER_DRAIN) { E.fused(acc, cur, wr, wc, fr, fq, lds, wid, lane); S.done(cur); }
#undef PG8_SA
#undef PG8_SB
#undef PG8_STAGE
#undef PG8_LDA
#undef PG8_LDB
#undef PG8_MMA
#undef PG8_WAIT_V
#undef PG8_WAIT_L
#undef PG8_BAR
#undef PG8_SCHED
}
}
constexpr int NB = 16, SEQ = 2048, M = NB * SEQ, D = 1024, FF = 2816, NFI = 2 * FF, ZW = 3072, NIN = 2840, DEPTH = 4, MODW = 9216;
constexpr int ZKC = 512, ZVC = 640, ZKS = 768, ZVS = 896, ZKW = 1024, ZVW = 1152, ZHC = 1280, ZBG = 1792, ZCG = 2304, ZGT = 2816;
constexpr float EPS = 1e-6f;
constexpr float NEGB = -1e30f;
constexpr float C2 = 0.125f * 1.4426950408889634f;
constexpr float LOG2E = 1.4426950408889634f;

constexpr size_t MiB = 1u << 20;
constexpr size_t WS_CTL = 0, CTL_ZERO_BYTES = 64 * 1024;
constexpr size_t WS_MOD = 1 * MiB;
constexpr size_t WS_CB1 = 4 * MiB;
constexpr size_t WS_KCMP = 5 * MiB;
constexpr size_t WS_VCMP = 5 * MiB + 512 * 1024;
constexpr size_t WS_WC1T = 6 * MiB;
constexpr size_t WS_WMO = 8 * MiB;
constexpr size_t WS_WMI = 16 * MiB;
constexpr size_t WS_WFO = 40 * MiB;
constexpr size_t WS_WFI = 84 * MiB;
constexpr size_t WS_H = 172 * MiB;
constexpr size_t WS_ZB = 236 * MiB;
constexpr size_t WS_OATT = 428 * MiB;
constexpr size_t WS_SBW = 492 * MiB;
constexpr size_t WS_RSQ = 498 * MiB;
constexpr size_t WS_OMIX = 500 * MiB;
constexpr size_t WS_X = 564 * MiB;
constexpr size_t WS_ASQ = 628 * MiB;
constexpr size_t WS_END = 629 * MiB;
constexpr int CW_BAR = 4096;

constexpr int RING_BYTES = 131072;
constexpr int LDS_BYTES = 163840;
constexpr int CTRL_OFF = LDS_BYTES - 1024;
constexpr int MISC_OFF = CTRL_OFF + 320;

#define GAS __attribute__((address_space(1)))
#define LAS __attribute__((address_space(3)))
typedef unsigned short bf16;
typedef float f32x4 __attribute__((ext_vector_type(4)));
typedef float f32x16 __attribute__((ext_vector_type(16)));
typedef short bf16x8 __attribute__((ext_vector_type(8)));
typedef short s16x4 __attribute__((ext_vector_type(4)));
typedef unsigned u32x4 __attribute__((ext_vector_type(4)));
using pg8::u32x2;
typedef GAS unsigned gu32;
#define LBAR() do { asm volatile("s_waitcnt lgkmcnt(0)" ::: "memory"); __builtin_amdgcn_s_barrier(); asm volatile("" ::: "memory"); } while (0)
#define MFMA32(a, b, c) __builtin_amdgcn_mfma_f32_32x32x16_bf16((a), (b), (c), 0, 0, 0)
using pg8::cvt_pk_bf16;
using pg8::silu_f;

#define XB_TMO      128
#define XB_XCNT(j)  (256  + 64 * (j))
#define XB_XSUB(j)  (1280 + 64 * (j))
#define XB_XGEN(j)  (2304 + 64 * (j))
#define XB_TOP      3328
#define XB_TOPGEN   3392
#define XCD_BAR_WORDS 3456
#define XB_SPIN_CAP (1u << 18)

__device__ __forceinline__ unsigned xb_ld(unsigned* p)              { return __hip_atomic_load(p, __ATOMIC_RELAXED, __HIP_MEMORY_SCOPE_AGENT); }
__device__ __forceinline__ unsigned xb_add(unsigned* p, unsigned v) { return __hip_atomic_fetch_add(p, v, __ATOMIC_RELAXED, __HIP_MEMORY_SCOPE_AGENT); }
__device__ __forceinline__ unsigned xb_xcc_id() { return (unsigned)__builtin_amdgcn_s_getreg((3 << 11) | 20) & 0xFu; }
#define XB_SPIN(cond, bar) do { unsigned _sp = 0; while (cond) { __builtin_amdgcn_s_sleep(1); \
    if ((++_sp & 255u) == 0u) { if (xb_ld(&(bar)[XB_TMO])) break; if (_sp > XB_SPIN_CAP) { atomicAdd(&(bar)[XB_TMO], 1u); break; } } } } while (0)

struct XcdBarrier {
    unsigned* bar; unsigned x;
    volatile LAS unsigned* st;
};

__device__ __forceinline__ XcdBarrier xcd_barrier_post(unsigned* bar, volatile LAS unsigned* st) {
    XcdBarrier b; b.bar = bar; b.x = (unsigned)__builtin_amdgcn_readfirstlane((int)xb_xcc_id()); b.st = st;
    if (threadIdx.x == 0) (void)xb_add(&bar[XB_XCNT(b.x)], 1u);
    return b;
}
__device__ __forceinline__ void xcd_barrier_complete(unsigned* bar, unsigned x, unsigned& nloc, unsigned& nx) {
    const unsigned G = gridDim.x * gridDim.y * gridDim.z;
    unsigned sum, cnt, mine, sp = 0u;
    for (;;) {
        sum = 0u; cnt = 0u; mine = 0u;
#pragma unroll
        for (unsigned j = 0; j < 16; ++j) { const unsigned c = xb_ld(&bar[XB_XCNT(j)]); sum += c; cnt += (c > 0u) ? 1u : 0u; mine = (j == x) ? c : mine; }
        if (sum == G) break;
        __builtin_amdgcn_s_sleep(1);
        if ((++sp & 255u) == 0u) { if (xb_ld(&bar[XB_TMO])) break; if (sp > XB_SPIN_CAP) { atomicAdd(&bar[XB_TMO], 1u); break; } }
    }
    nloc = mine > 0u ? mine : 1u; nx = cnt > 0u ? cnt : 1u;
}

__device__ __forceinline__ void xcd_barrier(const XcdBarrier& b) {
    asm volatile("s_waitcnt vmcnt(0)" ::: "memory");
    __syncthreads();
    if (threadIdx.x == 0) {
        unsigned* bar = b.bar;
        __builtin_amdgcn_s_waitcnt(0);
        unsigned nloc = b.st[0], nx = b.st[1];
        if (nloc == 0u) { xcd_barrier_complete(bar, b.x, nloc, nx); b.st[0] = nloc; b.st[1] = nx; }
        const unsigned old = xb_add(&bar[XB_XSUB(b.x)], 1u);
        const unsigned gen = old / nloc;
        if (old + 1u == (gen + 1u) * nloc) {
            __builtin_amdgcn_fence(__ATOMIC_RELEASE, "agent");
            asm volatile("s_waitcnt vmcnt(0)" ::: "memory");
            const unsigned og = xb_add(&bar[XB_TOP], 1u);
            const unsigned tg = og / nx;
            if (og + 1u == (tg + 1u) * nx) xb_add(&bar[XB_TOPGEN], 1u);
            else XB_SPIN(xb_ld(&bar[XB_TOPGEN]) == tg, bar);
            __builtin_amdgcn_fence(__ATOMIC_ACQUIRE, "agent");
            xb_add(&bar[XB_XGEN(b.x)], 1u);
            asm volatile("s_waitcnt vmcnt(0)" ::: "memory");
        } else {
            XB_SPIN(xb_ld(&bar[XB_XGEN(b.x)]) == gen, bar);
            __builtin_amdgcn_fence(__ATOMIC_ACQUIRE, "agent");
            asm volatile("s_waitcnt vmcnt(0)" ::: "memory");
        }
    }
    __syncthreads();
}

__device__ __forceinline__ float shx(float v, int mask, int lane) { return __builtin_bit_cast(float, __builtin_amdgcn_ds_bpermute((lane ^ mask) << 2, __builtin_bit_cast(int, v))); }
__device__ __forceinline__ float max32x(float v) { const auto r = __builtin_amdgcn_permlane32_swap(__float_as_uint(v), __float_as_uint(v), false, false); return fmaxf(__uint_as_float(r[0]), __uint_as_float(r[1])); }
__device__ __forceinline__ float sum32x(float v) { const auto r = __builtin_amdgcn_permlane32_swap(__float_as_uint(v), __float_as_uint(v), false, false); return __uint_as_float(r[0]) + __uint_as_float(r[1]); }
template <int CTRL> __device__ __forceinline__ float dpp_f(float v) { return __builtin_bit_cast(float, __builtin_amdgcn_update_dpp(0, __builtin_bit_cast(int, v), CTRL, 0xf, 0xf, true)); }
__device__ __forceinline__ float sum8_dpp(float s) { s += dpp_f<0xB1>(s); s += dpp_f<0x4E>(s); s += dpp_f<0x141>(s); return s; }
__device__ __forceinline__ float sum16x(float v) { const auto r = __builtin_amdgcn_permlane16_swap(__float_as_uint(v), __float_as_uint(v), false, false); return __uint_as_float(r[0]) + __uint_as_float(r[1]); }
__device__ __forceinline__ float sum64_dpp(float s) { s = sum8_dpp(s); s += dpp_f<0x140>(s); s = sum16x(s); return sum32x(s); }
__device__ __forceinline__ float wave_sum(float v, int lane) { (void)lane; return sum64_dpp(v); }
__device__ __forceinline__ const bf16* zt(const bf16* zb, int row, int col) { return (const bf16*)((const char*)zb + pg8::tl_off(row, col, ZW)); }
__device__ __forceinline__ float bf2f(unsigned short h) { return __uint_as_float((unsigned)h << 16); }
__device__ __forceinline__ float bflo(unsigned w) { return __uint_as_float(w << 16); }
__device__ __forceinline__ float bfhi(unsigned w) { return __uint_as_float(w & 0xffff0000u); }
__device__ __forceinline__ float sigmoid_f(float x) { return __builtin_amdgcn_rcpf(1.0f + __builtin_amdgcn_exp2f(-LOG2E * x)); }
__device__ __forceinline__ int crow(int r, int hi) { return (r & 3) + 8 * (r >> 2) + 4 * hi; }

__device__ __forceinline__ int dst_row(int mode, int n) {
    if (mode == 1) { return n < FF ? (n >> 7) * 256 + (n & 127) : ((n - FF) >> 7) * 256 + 128 + ((n - FF) & 127); }
    if (mode == 2) { return n < 1280 ? n : (n < 1304 ? ZGT + (n - 1280) : n - 24); }
    return n;
}
__device__ __forceinline__ void transpose_item(const float* W, int K, int N, bf16* WT, LAS float* scr, int item, int lane, int mode, bool tiled = true) {
    const int nblk = (N + 63) >> 6, kb = item / nblk, nb = item - kb * nblk, k0 = 64 * kb, n0 = 64 * nb;
    const int kr = lane >> 4, c4 = (lane & 15) * 4; const bool inb = (n0 + c4) < N;
    const float* src = W + (size_t)(k0 + kr) * N + n0 + c4;
    f32x4 v[16];
#pragma unroll
    for (int i = 0; i < 16; ++i) v[i] = inb ? __builtin_nontemporal_load((const f32x4*)(src + (size_t)(4 * i) * N)) : (f32x4){0.f, 0.f, 0.f, 0.f};
#pragma unroll
    for (int i = 0; i < 16; ++i) { LAS float* d = scr + (4 * i + kr) * 65 + c4; d[0] = v[i].x; d[1] = v[i].y; d[2] = v[i].z; d[3] = v[i].w; }
    asm volatile("s_waitcnt lgkmcnt(0)" ::: "memory");
    const int c = lane & 7, r8 = lane >> 3;
#pragma unroll
    for (int j = 0; j < 8; ++j) { const int nl = r8 + 8 * j; const int n = n0 + nl; const LAS float* q = scr + (8 * c) * 65 + nl;
        u32x4 o; o.x = cvt_pk_bf16(q[0 * 65], q[1 * 65]); o.y = cvt_pk_bf16(q[2 * 65], q[3 * 65]); o.z = cvt_pk_bf16(q[4 * 65], q[5 * 65]); o.w = cvt_pk_bf16(q[6 * 65], q[7 * 65]);
        if (n < N) { if (tiled) *(u32x4*)((char*)WT + pg8::tl_off(dst_row(mode, n), k0 + 8 * c, K)) = o; else *(u32x4*)(WT + (size_t)dst_row(mode, n) * K + k0 + 8 * c) = o; } }
    asm volatile("s_waitcnt lgkmcnt(0)" ::: "memory");
}

struct Args { const float* in[16]; float* out; unsigned char* ws; };
typedef __attribute__((address_space(4))) const Args* ArgsP;
__device__ __forceinline__ ArgsP get_args() { unsigned long long p = (unsigned long long)__builtin_amdgcn_kernarg_segment_ptr(); asm volatile("" : "+s"(p)); return (ArgsP)p; }
struct Ctx { LAS unsigned char* L; int vcu, G, bx; };
__device__ __forceinline__ Ctx launder(const Ctx& c) { Ctx r; unsigned lb = (unsigned)(size_t)c.L; int v = c.vcu, g = c.G, bx = c.bx; asm volatile("" : "+s"(lb), "+s"(v), "+s"(g), "+s"(bx)); r.L = (LAS unsigned char*)(size_t)lb; r.vcu = v; r.G = g; r.bx = bx; return r; }
#define PHASE_IDS() int tid_ = threadIdx.x; asm volatile("" : "+v"(tid_)); const int tid = tid_; const int lane = tid & 63; const int wave = __builtin_amdgcn_readfirstlane(tid >> 6); (void)lane; (void)wave

__device__ __forceinline__ void prologue(const Ctx& C0) {
    PHASE_IDS(); const ArgsP A = get_args(); const Ctx C = launder(C0);
    {
        LAS float* scr = (LAS float*)(C.L + wave * 16640);
        const int gw = C.vcu * 8 + wave, NGW = C.G * 8;
        constexpr int I_FI = 16 * 88, I_FO = 44 * 16, I_MI = 16 * 45, I_MO = 16 * 16, I_C1 = 32 * 1;
        constexpr int N_FI = 8 * I_FI, N_FO = 8 * I_FO, N_MI = 4 * I_MI, N_MO = 4 * I_MO, N_C1 = 8 * I_C1;
        constexpr int NITEMS = N_FI + N_FO + N_MI + N_MO + N_C1;
        for (int it = gw; it < NITEMS; it += NGW) {
            int r = it;
            if (r < N_FI) { const int q = r / I_FI; transpose_item(A->in[5] + (size_t)q * D * NFI, D, NFI, (bf16*)(A->ws + WS_WFI) + (size_t)q * NFI * D, scr, r - q * I_FI, lane, 1); continue; } r -= N_FI;
            if (r < N_FO) { const int q = r / I_FO; transpose_item(A->in[6] + (size_t)q * FF * D, FF, D, (bf16*)(A->ws + WS_WFO) + (size_t)q * D * FF, scr, r - q * I_FO, lane, 0); continue; } r -= N_FO;
            if (r < N_MI) { const int q = r / I_MI; transpose_item(A->in[7] + (size_t)q * D * NIN, D, NIN, (bf16*)(A->ws + WS_WMI) + (size_t)q * ZW * D, scr, r - q * I_MI, lane, 2); continue; } r -= N_MI;
            if (r < N_MO) { const int q = r / I_MO; transpose_item(A->in[14] + (size_t)q * D * D, D, D, (bf16*)(A->ws + WS_WMO) + (size_t)q * D * D, scr, r - q * I_MO, lane, 0); continue; } r -= N_MO;
            { const int q = r / I_C1; transpose_item(A->in[9] + (size_t)q * 2048 * 64, 2048, 64, (bf16*)(A->ws + WS_WC1T) + (size_t)q * 64 * 2048, scr, r - q * I_C1, lane, 0, false); }
        }
        const int gt = C.vcu * 512 + tid, NGT = C.G * 512;
        for (int i = gt; i < 4 * 232 * 128; i += NGT) { const int l = i / (232 * 128), rr = i - l * (232 * 128); const int row = NIN + rr / 128, ch = rr & 127;
            *(u32x4*)((char*)((bf16*)(A->ws + WS_WMI) + (size_t)l * ZW * D) + pg8::tl_off(row, ch * 8, D)) = (u32x4){0u, 0u, 0u, 0u}; }
    }
    __syncthreads();
    {
        LAS float* cact = (LAS float*)C.L;
        LAS float* red = (LAS float*)(C.L + 65536);
        for (int i = tid; i < NB * D; i += 512) cact[i] = silu_f(A->in[1][i]);
        __syncthreads();
        const int cj = tid & 63, ks = tid >> 6;
        float* mod = (float*)(A->ws + WS_MOD);
        {
            const int c4 = (lane & 7) * 4, kk = lane >> 3;
            for (int item = C.vcu; item < DEPTH * (MODW / 32); item += C.G) {
                const int l = item / (MODW / 32), jb = item - l * (MODW / 32);
                const float* w = A->in[2] + (size_t)l * D * MODW + (size_t)(ks * 128 + kk) * MODW + jb * 32 + c4;
                f32x4 wv[16];
#pragma unroll
                for (int i = 0; i < 16; ++i) wv[i] = __builtin_nontemporal_load((const f32x4*)(w + (size_t)(8 * i) * MODW));
                f32x4 acc[16];
#pragma unroll
                for (int b = 0; b < 16; ++b) acc[b] = (f32x4){0.f, 0.f, 0.f, 0.f};
#pragma unroll
                for (int i = 0; i < 16; ++i) { const LAS float* cp = cact + ks * 128 + 8 * i + kk;
#pragma unroll
                    for (int b = 0; b < 16; ++b) acc[b] += wv[i] * cp[b * D]; }
#pragma unroll
                for (int b = 0; b < 16; ++b)
#pragma unroll
                    for (int e = 0; e < 4; ++e) { float s = acc[b][e]; s += dpp_f<0x128>(s); s = sum16x(s); acc[b][e] = sum32x(s); }
                if (kk == 0) {
#pragma unroll
                    for (int b = 0; b < 16; ++b) *(LAS f32x4*)(red + (ks * 16 + b) * 32 + c4) = acc[b]; }
                __syncthreads();
                { const int b = tid >> 5, c = tid & 31; float s = A->in[3][l * MODW + jb * 32 + c];
#pragma unroll
                  for (int q = 0; q < 8; ++q) s += red[(q * 16 + b) * 32 + c];
                  mod[((size_t)l * NB + b) * MODW + jb * 32 + c] = s; }
                __syncthreads();
            }
        }
        for (int item = C.vcu; item < 8; item += C.G) {
            const float* pos = A->in[8] + (size_t)item * 2048; const float* w1 = A->in[9] + (size_t)item * 2048 * 64;
            float s = 0.f;
            for (int k = ks * 256; k < ks * 256 + 256; ++k) s += pos[k] * w1[(size_t)k * 64 + cj];
            red[ks * 64 + cj] = s;
            __syncthreads();
            if (tid < 64) { float t = 0.f;
#pragma unroll
                for (int q = 0; q < 8; ++q) t += red[q * 64 + tid];
                ((float*)(A->ws + WS_CB1))[item * 64 + tid] = t; }
            __syncthreads();
        }
    }
}

typedef float f32x4v __attribute__((ext_vector_type(4)));
__device__ __forceinline__ void prologue2(const Ctx& C0) {
    PHASE_IDS(); const ArgsP A = get_args(); const Ctx C = launder(C0);
    const int gw = C.vcu * 8 + wave, NGW = C.G * 8;
    {
        const float* mod = (const float*)(A->ws + WS_MOD); float* sbw = (float*)(A->ws + WS_SBW);
        constexpr int T_FF = NFI / 16, T_MI = ZW / 16, T_L = 2 * T_FF + T_MI;
        const int bi = lane & 15, kq = lane >> 4;
        for (int it = gw; it < DEPTH * T_L; it += NGW) {
            const int l = it / T_L; int r = it - l * T_L; int sub, t; const bf16* Bt;
            if (r < T_FF) { sub = 0; t = r; Bt = (const bf16*)(A->ws + WS_WFI) + (size_t)(l * 2) * NFI * D; }
            else if (r < T_FF + T_MI) { sub = 1; t = r - T_FF; Bt = (const bf16*)(A->ws + WS_WMI) + (size_t)l * ZW * D; }
            else { sub = 2; t = r - T_FF - T_MI; Bt = (const bf16*)(A->ws + WS_WFI) + (size_t)(l * 2 + 1) * NFI * D; }
            const float* sh = mod + ((size_t)l * NB + bi) * MODW + sub * 3072 + 8 * kq;
            const char* bp = (const char*)Bt + pg8::tl_off(16 * t + bi, 8 * kq, D);
            f32x4v acc = {0.f, 0.f, 0.f, 0.f};
#pragma unroll 8
            for (int s = 0; s < 32; ++s) { const f32x4 a0 = *(const f32x4*)(sh + 32 * s), a1 = *(const f32x4*)(sh + 32 * s + 4);
                const u32x4 aw = {cvt_pk_bf16(a0.x, a0.y), cvt_pk_bf16(a0.z, a0.w), cvt_pk_bf16(a1.x, a1.y), cvt_pk_bf16(a1.z, a1.w)};
                const bf16x8 bv = *(const bf16x8*)(bp + 1024 * s);
                acc = __builtin_amdgcn_mfma_f32_16x16x32_bf16(__builtin_bit_cast(bf16x8, aw), bv, acc, 0, 0, 0); }
            float* op = sbw + ((size_t)(3 * l + sub) * NB + 4 * kq) * NFI + 16 * t + bi;
#pragma unroll
            for (int e = 0; e < 4; ++e) op[(size_t)e * NFI] = acc[e];
        }
    }
    {
        const float* xin = A->in[0]; bf16* hs = (bf16*)(A->ws + WS_H); float* rowsq = (float*)(A->ws + WS_RSQ); unsigned* x16 = (unsigned*)(A->ws + WS_X);
        const float* g = A->in[4]; const float* mod = (const float*)(A->ws + WS_MOD);
        const int rr = lane >> 2, ch = lane & 3;
        for (int rb = gw; rb < M / 16; rb += NGW) {
            const int row = 16 * rb + rr, b = row >> 11;
            const float* sc = mod + (size_t)b * MODW + D; const float* xr = xin + (size_t)row * D;
            float s = 0.f;
#pragma unroll 4
            for (int cb = 0; cb < 32; ++cb) { const int c = 32 * cb + 8 * ch;
                const f32x4 v0 = __builtin_nontemporal_load((const f32x4*)(xr + c)), v1 = __builtin_nontemporal_load((const f32x4*)(xr + c + 4));
                s += ((v0.x * v0.x + v0.y * v0.y) + (v0.z * v0.z + v0.w * v0.w)) + ((v1.x * v1.x + v1.y * v1.y) + (v1.z * v1.z + v1.w * v1.w));
                const f32x4 y0 = v0 * *(const f32x4*)(g + c) * (*(const f32x4*)(sc + c) + 1.0f), y1 = v1 * *(const f32x4*)(g + c + 4) * (*(const f32x4*)(sc + c + 4) + 1.0f);
                const u32x4 o = {cvt_pk_bf16(y0.x, y0.y), cvt_pk_bf16(y0.z, y0.w), cvt_pk_bf16(y1.x, y1.y), cvt_pk_bf16(y1.z, y1.w)};
                *(u32x4*)((char*)hs + pg8::tl_off(row, c, D)) = o;
                const u32x4 xw = {pg8::cvt_pk_f16(v0.x, v0.y), pg8::cvt_pk_f16(v0.z, v0.w), pg8::cvt_pk_f16(v1.x, v1.y), pg8::cvt_pk_f16(v1.z, v1.w)};
                *(u32x4*)((char*)x16 + pg8::tl_off(row, c, D)) = xw; }
            s += dpp_f<0xB1>(s); s += dpp_f<0x4E>(s);
            rowsq[(size_t)ch * M + row] = ch == 0 ? s : 0.f;
        }
    }
}
__device__ __forceinline__ void finalnorm_phase(const Ctx& C0) {
    PHASE_IDS(); const ArgsP A = get_args(); const Ctx C = launder(C0);
    const unsigned char* x16 = A->ws + WS_X; float* out = A->out; const float* g = A->in[15]; const float* rowsq = (const float*)(A->ws + WS_RSQ);
    const int gw = C.vcu * 8 + wave, NGW = C.G * 8;
    const int rr = lane >> 2, ch = lane & 3;
    for (int rb = gw; rb < M / 16; rb += NGW) {
        const int row = 16 * rb + rr;
        float s = rowsq[(size_t)ch * M + row];
        s += dpp_f<0xB1>(s); s += dpp_f<0x4E>(s);
        const float rstd = __builtin_amdgcn_rsqf(s * (1.0f / D) + EPS);
        float* orow = out + (size_t)row * D;
#pragma unroll 8
        for (int cb = 0; cb < 32; ++cb) { const int c = 32 * cb + 8 * ch;
            const u32x4 p = *(const u32x4*)(x16 + pg8::tl_off(row, c, D));
            const f32x4 v0 = pg8::unpack_f16x4((u32x2){p.x, p.y}), v1 = pg8::unpack_f16x4((u32x2){p.z, p.w});
            *(f32x4*)(orow + c) = v0 * rstd * *(const f32x4*)(g + c); *(f32x4*)(orow + c + 4) = v1 * rstd * *(const f32x4*)(g + c + 4); }
    }
}
__device__ __forceinline__ void unpack8(const u32x4 w, float (&f)[8]) {
    f[0] = bflo(w.x); f[1] = bfhi(w.x); f[2] = bflo(w.y); f[3] = bfhi(w.y); f[4] = bflo(w.z); f[5] = bfhi(w.z); f[6] = bflo(w.w); f[7] = bfhi(w.w);
}
__device__ __forceinline__ void postmix_phase(const Ctx& C0, int l) {
    PHASE_IDS(); const ArgsP A = get_args(); const Ctx C = launder(C0);
    const float* oatt = (const float*)(A->ws + WS_OATT); const bf16* z = (const bf16*)(A->ws + WS_ZB); bf16* omix = (bf16*)(A->ws + WS_OMIX);
    const float* conv_w = A->in[11] + (size_t)l * 3 * 512; const float* conv_b = A->in[12] + (size_t)l * 512; const float* gout = A->in[13] + (size_t)l * D;
    const int gw = C.vcu * 8 + wave, NGW = C.G * 8; const int c8 = lane * 8;
    float w0[8], w1[8], w2[8], cb[8], ga[8], gc[8];
#pragma unroll
    for (int e = 0; e < 8; ++e) { w0[e] = conv_w[c8 + e]; w1[e] = conv_w[512 + c8 + e]; w2[e] = conv_w[1024 + c8 + e]; cb[e] = conv_b[c8 + e]; ga[e] = gout[c8 + e]; gc[e] = gout[512 + c8 + e]; }
    for (int ch = gw; ch < M / 16; ch += NGW) {
        const int row0 = ch * 16; const int s0 = row0 & (SEQ - 1);
        float um2[8], um1[8];
        if (s0 == 0) {
#pragma unroll
            for (int e = 0; e < 8; ++e) { um2[e] = 0.f; um1[e] = 0.f; }
        } else {
            float a[8], b[8];
            unpack8(*(const u32x4*)(z + (size_t)(row0 - 2) * ZW + ZHC + c8), a); unpack8(*(const u32x4*)(z + (size_t)(row0 - 2) * ZW + ZCG + c8), b);
#pragma unroll
            for (int e = 0; e < 8; ++e) um2[e] = a[e] * b[e];
            unpack8(*(const u32x4*)(z + (size_t)(row0 - 1) * ZW + ZHC + c8), a); unpack8(*(const u32x4*)(z + (size_t)(row0 - 1) * ZW + ZCG + c8), b);
#pragma unroll
            for (int e = 0; e < 8; ++e) um1[e] = a[e] * b[e];
        }
        f32x4 na0 = *(const f32x4*)(oatt + (size_t)row0 * 512 + c8), na1 = *(const f32x4*)(oatt + (size_t)row0 * 512 + c8 + 4);
        u32x4 nhc = *(const u32x4*)(z + (size_t)row0 * ZW + ZHC + c8), nbg = *(const u32x4*)(z + (size_t)row0 * ZW + ZBG + c8), ncg = *(const u32x4*)(z + (size_t)row0 * ZW + ZCG + c8);
        for (int i = 0; i < 16; ++i) {
            const size_t row = (size_t)(row0 + i);
            const f32x4 a0 = na0, a1 = na1; const u32x4 whc = nhc, wbg = nbg, wcg = ncg;
            { const size_t rn = (size_t)(row0 + (i < 15 ? i + 1 : 15));
              na0 = *(const f32x4*)(oatt + rn * 512 + c8); na1 = *(const f32x4*)(oatt + rn * 512 + c8 + 4);
              nhc = *(const u32x4*)(z + rn * ZW + ZHC + c8); nbg = *(const u32x4*)(z + rn * ZW + ZBG + c8); ncg = *(const u32x4*)(z + rn * ZW + ZCG + c8); }
            float ss = (a0.x * a0.x + a0.y * a0.y) + (a0.z * a0.z + a0.w * a0.w) + (a1.x * a1.x + a1.y * a1.y) + (a1.z * a1.z + a1.w * a1.w);
            float hc[8], bg[8], cg[8], oc[8];
            unpack8(whc, hc); unpack8(wbg, bg); unpack8(wcg, cg);
            float s2 = 0.f;
#pragma unroll
            for (int e = 0; e < 8; ++e) { const float u = cg[e] * hc[e]; const float v = cb[e] + um2[e] * w0[e] + um1[e] * w1[e] + u * w2[e]; oc[e] = bg[e] * v; s2 += oc[e] * oc[e]; um2[e] = um1[e]; um1[e] = u; }
#pragma unroll
            for (int o = 1; o < 64; o <<= 1) { ss += shx(ss, o, lane); s2 += shx(s2, o, lane); }
            const float rs = __builtin_amdgcn_rsqf(ss * (1.0f / 512.0f) + EPS), rc = __builtin_amdgcn_rsqf(s2 * (1.0f / 512.0f) + EPS);
            u32x4 o;
            o.x = cvt_pk_bf16(a0.x * rs * ga[0], a0.y * rs * ga[1]); o.y = cvt_pk_bf16(a0.z * rs * ga[2], a0.w * rs * ga[3]);
            o.z = cvt_pk_bf16(a1.x * rs * ga[4], a1.y * rs * ga[5]); o.w = cvt_pk_bf16(a1.z * rs * ga[6], a1.w * rs * ga[7]);
            *(u32x4*)(omix + row * D + c8) = o;
            o.x = cvt_pk_bf16(oc[0] * rc * gc[0], oc[1] * rc * gc[1]); o.y = cvt_pk_bf16(oc[2] * rc * gc[2], oc[3] * rc * gc[3]);
            o.z = cvt_pk_bf16(oc[4] * rc * gc[4], oc[5] * rc * gc[5]); o.w = cvt_pk_bf16(oc[6] * rc * gc[6], oc[7] * rc * gc[7]);
            *(u32x4*)(omix + row * D + 512 + c8) = o;
        }
    }
}

__device__ __forceinline__ void compress_phase(const Ctx& C0, int l) {
    PHASE_IDS(); const ArgsP A = get_args(); const Ctx C = launder(C0);
    const bf16* z = (const bf16*)(A->ws + WS_ZB); const bf16* w1T = (const bf16*)(A->ws + WS_WC1T) + (size_t)l * 2 * 64 * 2048; const float* cb1 = (const float*)(A->ws + WS_CB1) + l * 128;
    const float* w2 = A->in[10] + (size_t)l * 2 * 4096; bf16* kcmp = (bf16*)(A->ws + WS_KCMP); bf16* vcmp = (bf16*)(A->ws + WS_VCMP);
    const int wid = wave, r = lane & 31, h = lane >> 5;
    LAS float* part = (LAS float*)C.L;
    LAS float* y1 = (LAS float*)(C.L + 65536);
    for (int task = C.vcu; task < 256; task += C.G) {
        const int nt = task & 3, kv = (task >> 2) & 1, g = (task >> 3) & 1, b = task >> 4;
        const int colb = ZKC + kv * 128 + 64 * g;
        const int tokbase = 16 * (nt * 32 + r);
        const bf16* zb = z + (size_t)b * SEQ * ZW;
        const bf16* wT = w1T + (size_t)kv * 64 * 2048 + (size_t)r * 2048 + 8 * h;
        f32x16 acc0, acc1;
#pragma unroll
        for (int i = 0; i < 16; ++i) { acc0[i] = 0.f; acc1[i] = 0.f; }
#pragma unroll
        for (int ii = 0; ii < 4; ++ii) { const int i = wid * 4 + ii; int tok = tokbase + i; tok = tok > SEQ - 1 ? SEQ - 1 : tok;
            const bf16* b0p = wT + i * 64; const bf16* b1p = b0p + 32 * 2048;
#pragma unroll
            for (int dd = 0; dd < 4; ++dd) { const bf16x8 av = *(const bf16x8*)zt(zb, tok, colb + 8 * h + 16 * dd), b0 = *(const bf16x8*)(b0p + 16 * dd), b1 = *(const bf16x8*)(b1p + 16 * dd);
                acc0 = MFMA32(av, b0, acc0); acc1 = MFMA32(av, b1, acc1); } }
#pragma unroll
        for (int i = 0; i < 16; ++i) { const int nl = crow(i, h); part[(wid * 32 + nl) * 64 + r] = acc0[i]; part[(wid * 32 + nl) * 64 + 32 + r] = acc1[i]; }
        __syncthreads();
        const int nl = tid >> 4, oq = (tid & 15) * 4;
        { f32x4 s = *(const f32x4*)(cb1 + kv * 64 + oq);
#pragma unroll
          for (int w = 0; w < 8; ++w) s += *(const LAS f32x4*)(part + (w * 32 + nl) * 64 + oq);
          f32x4 y; y.x = silu_f(s.x); y.y = silu_f(s.y); y.z = silu_f(s.z); y.w = silu_f(s.w);
          *(LAS f32x4*)(y1 + nl * 64 + oq) = y; }
        __syncthreads();
        { f32x4 acc = {0.f, 0.f, 0.f, 0.f}; const float* w2p = w2 + kv * 4096 + oq;
          for (int o = 0; o < 64; ++o) { const float yv = y1[nl * 64 + o]; acc += *(const f32x4*)(w2p + o * 64) * yv; }
          const int n = nt * 32 + nl; if (n == 127) acc = (f32x4){0.f, 0.f, 0.f, 0.f};
          u32x2 ov; ov.x = cvt_pk_bf16(acc.x, acc.y); ov.y = cvt_pk_bf16(acc.z, acc.w);
          *(u32x2*)((kv ? vcmp : kcmp) + ((size_t)(b * 2 + g) * 128 + n) * 64 + oq) = ov; }
        __syncthreads();
    }
}

constexpr float MFLOOR = -1e20f;
constexpr int AK = 0, AV = 24576, AWS = 57344, AIMP = 59392, ASEL = 93184, AOT = 93440;
static_assert(AOT + 65536 <= CTRL_OFF, "attention LDS map");
typedef short v4i16_t __attribute__((ext_vector_type(4)));
__device__ __forceinline__ s16x4 vtr(const LAS unsigned char* p) { return __builtin_bit_cast(s16x4, __builtin_amdgcn_ds_read_tr16_b64_v4i16((LAS v4i16_t*)p)); }
#define PACKF(X, S) __builtin_bit_cast(bf16x8, (u32x4){cvt_pk_bf16(X[8 * (S)], X[8 * (S) + 1]), cvt_pk_bf16(X[8 * (S) + 2], X[8 * (S) + 3]), cvt_pk_bf16(X[8 * (S) + 4], X[8 * (S) + 5]), cvt_pk_bf16(X[8 * (S) + 6], X[8 * (S) + 7])})
#define PV_STEP(PF, KS) do { const bf16x8 pf_ = (PF); const int vo_ = ((KS) >> 2) * 8192 + ((KS) & 3) * 1024; \
    { const s16x4 lo_ = vtr(vp + vo_), hi_ = vtr(vp + vo_ + 512); const bf16x8 vf_ = {lo_[0], lo_[1], lo_[2], lo_[3], hi_[0], hi_[1], hi_[2], hi_[3]}; o0 = MFMA32(pf_, vf_, o0); } \
    { const s16x4 lo_ = vtr(vp + vo_ + 4096), hi_ = vtr(vp + vo_ + 4608); const bf16x8 vf_ = {lo_[0], lo_[1], lo_[2], lo_[3], hi_[0], hi_[1], hi_[2], hi_[3]}; o1 = MFMA32(pf_, vf_, o1); } } while (0)

constexpr int SLOTB = 8192, RK = 0, RV = 3 * SLOTB;
constexpr float MFL = -1000.0f;
typedef const LAS unsigned char* lcp;
__device__ __forceinline__ void glds16(const void* gsrc, unsigned lds_dst) { unsigned keep;
    asm volatile("s_mov_b32 %0, m0\n\ts_mov_b32 m0, %2\n\ts_nop 0\n\tglobal_load_lds_dwordx4 %1, off\n\ts_mov_b32 m0, %0" : "=&s"(keep) : "v"(gsrc), "s"(lds_dst) : "memory"); }
__device__ __forceinline__ void kload8(bf16x8* kf, lcp kp) {
    kf[0] = *(const LAS bf16x8*)(kp);        kf[1] = *(const LAS bf16x8*)(kp + 512);
    kf[2] = *(const LAS bf16x8*)(kp + 2048); kf[3] = *(const LAS bf16x8*)(kp + 2560);
    kf[4] = *(const LAS bf16x8*)(kp + 4096); kf[5] = *(const LAS bf16x8*)(kp + 4608);
    kf[6] = *(const LAS bf16x8*)(kp + 6144); kf[7] = *(const LAS bf16x8*)(kp + 6656); }
__device__ __forceinline__ void kload2(bf16x8* kf, lcp kp, int j) { kf[2 * j] = *(const LAS bf16x8*)(kp + j * 2048); kf[2 * j + 1] = *(const LAS bf16x8*)(kp + j * 2048 + 512); }
#define SBAR() __builtin_amdgcn_sched_barrier(0)
#define WAIT_BAR(N) asm volatile("s_waitcnt vmcnt(" #N ") lgkmcnt(0)\n\ts_barrier" ::: "memory")
#define MX3(a, b, c) __builtin_fmaxf(__builtin_fmaxf((a), (b)), (c))
__device__ __forceinline__ float rowmax32(const f32x16& C0, const f32x16& C1) {
    float a = MX3(C0[0], C0[1], C1[0]), b = MX3(C0[2], C0[3], C1[1]); a = MX3(a, C1[2], C1[3]);
#pragma unroll
    for (int r = 4; r < 16; r += 4) { a = MX3(a, C0[r], C0[r + 1]); b = MX3(b, C0[r + 2], C0[r + 3]); a = MX3(a, C1[r], C1[r + 1]); b = MX3(b, C1[r + 2], C1[r + 3]); }
    return max32x(__builtin_fmaxf(a, b)); }
__device__ __forceinline__ void attn_issue(LAS unsigned char* L, const bf16* zb, int kcol, int vcol, int jlo, int n, int tid_in, int wid) {
    int tid = tid_in; asm volatile("" : "+v"(tid)); const int lane = tid & 63;
    const unsigned lds0 = (unsigned)(size_t)L;
    const bf16* ksrc = zt(zb, 64 * jlo + lane, kcol + wid * 8);
    const bf16* vsrc = zt(zb, 64 * jlo + 16 * (wid & 3) + (lane >> 2), vcol + (wid >> 2) * 32 + (lane & 3) * 8);
    const unsigned kdst = lds0 + RK + wid * 1024, vdst = lds0 + RV + wid * 1024;
    glds16(ksrc, (unsigned)__builtin_amdgcn_readfirstlane(kdst)); glds16(vsrc, (unsigned)__builtin_amdgcn_readfirstlane(vdst));
    if (n > 1) glds16(ksrc + (size_t)64 * ZW, (unsigned)__builtin_amdgcn_readfirstlane(kdst + SLOTB));
    if (n > 2) glds16(ksrc + (size_t)128 * ZW, (unsigned)__builtin_amdgcn_readfirstlane(kdst + 2 * SLOTB));
    if (n > 1) glds16(vsrc + (size_t)64 * ZW, (unsigned)__builtin_amdgcn_readfirstlane(vdst + SLOTB));
}
template <int MODE, bool PRE = false, int THRL = 8>
__device__ __forceinline__ void attn_branch(LAS unsigned char* L, const bf16* zb, int kcol, int vcol, int jlo, int jhi, int qt, int qrel, unsigned selbits,
                                            const bf16x8 (&qr)[4], f32x16& o0, f32x16& o1, float& lout, int tid_in, int wid) {
    int tid = tid_in; asm volatile("" : "+v"(tid)); const int lane = tid & 63;
    const int r32 = lane & 31, hi = lane >> 5;
    const unsigned lds0 = (unsigned)(size_t)L;
    LAS float* wsf = (LAS float*)(L + AWS) + wid * 64;
    const int n = jhi - jlo + 1;
    const bf16* ksrc = zt(zb, 64 * jlo + lane, kcol + wid * 8);
    const bf16* vsrc = zt(zb, 64 * jlo + 16 * (wid & 3) + (lane >> 2), vcol + (wid >> 2) * 32 + (lane & 3) * 8);
    const unsigned kdst = lds0 + RK + wid * 1024, vdst = lds0 + RV + wid * 1024;
#define DMA_K(t, slot) glds16(ksrc + (size_t)(t) * 64 * ZW, (unsigned)__builtin_amdgcn_readfirstlane(kdst + (slot)))
#define DMA_V(t, slot) glds16(vsrc + (size_t)(t) * 64 * ZW, (unsigned)__builtin_amdgcn_readfirstlane(vdst + (slot)))
    const lcp kp0 = L + RK + hi * 1024 + r32 * 16;
    const lcp vp0 = L + RV + ((lane >> 4) & 1) * 32 + (lane & 3) * 8 + (4 * hi + ((lane & 15) >> 2)) * 64;
    const int clim = qrel - 4 * hi;
    if (!PRE) {
        LBAR();
        DMA_K(0, 0); DMA_V(0, 0); if (n > 1) DMA_K(1, SLOTB); if (n > 2) DMA_K(2, 2 * SLOTB); if (n > 1) DMA_V(1, SLOTB);
    }
    float mhat = 0.f, l_reg = 0.f; f32x16 o[2];
#pragma unroll
    for (int i = 0; i < 16; ++i) { o[0][i] = 0.f; o[1][i] = 0.f; }
    f32x16 negm;
#pragma unroll
    for (int i = 0; i < 16; ++i) negm[i] = 0.f;
    asm volatile("" : "+v"(negm));
    if (n > 2) WAIT_BAR(4); else if (n > 1) WAIT_BAR(3); else WAIT_BAR(1);
    f32x16 pA0, pA1, pB0, pB1;
    bool resc = false;
#define CAUSAL(P0, P1) do { _Pragma("unroll") for (int r = 0; r < 16; ++r) { const int c0 = (r & 3) + 8 * (r >> 2); P0[r] = (c0 <= clim) ? P0[r] : NEGB; P1[r] = (c0 + 32 <= clim) ? P1[r] : NEGB; } } while (0)
    {
        const lcp kb = L + RK + hi * 1024 + r32 * 16;
#pragma unroll
        for (int d0 = 0; d0 < 4; ++d0) { const bf16x8 b0 = *(const LAS bf16x8*)(kb + d0 * 2048), b1 = *(const LAS bf16x8*)(kb + d0 * 2048 + 512);
            if (d0 == 0) { pA0 = MFMA32(b0, qr[0], negm); pA1 = MFMA32(b1, qr[0], negm); } else { pA0 = MFMA32(b0, qr[d0], pA0); pA1 = MFMA32(b1, qr[d0], pA1); } }
        if (MODE == 1 && qt >= 8) {
#pragma unroll
            for (int r = 0; r < 16; ++r) { const int c0 = (r & 3) + 8 * (r >> 2); pA0[r] = (c0 > clim) ? pA0[r] : NEGB; pA1[r] = (c0 + 32 > clim) ? pA1[r] : NEGB; }
        }
        if (n == 1) CAUSAL(pA0, pA1);
        const float rm = rowmax32(pA0, pA1);
        const float dl = __builtin_fmaxf(rm, MFL); mhat = dl;
#pragma unroll
        for (int r = 0; r < 16; ++r) { pA0[r] -= dl; pA1[r] -= dl; }
#pragma unroll
        for (int r = 0; r < 16; ++r) negm[r] = -mhat;
        asm volatile("" : "+v"(negm));
#pragma unroll
        for (int r = 0; r < 16; ++r) { pA0[r] = __builtin_amdgcn_exp2f(pA0[r]); pA1[r] = __builtin_amdgcn_exp2f(pA1[r]); }
    }
    WAIT_BAR(0);
    if (n > 3) DMA_K(3, 0);
    if (n > 2) DMA_V(2, 2 * SLOTB);
    int sl_prev = 0, sl_cur = SLOTB, sl_next = 2 * SLOTB;
#define ROT() do { sl_prev = sl_cur; sl_cur = sl_next; sl_next = (sl_next == 2 * SLOTB) ? 0 : sl_next + SLOTB; } while (0)
    bf16x8 kf[8];
    kload8(kf, kp0 + sl_cur);
    WAIT_BAR(2);
#define RESC() do { if (resc) { asm volatile("s_waitcnt lgkmcnt(0)" ::: "memory"); \
        _Pragma("unroll") for (int d_ = 0; d_ < 2; ++d_) _Pragma("unroll") for (int r = 0; r < 16; ++r) o[d_][r] *= wsf[crow(r, hi)]; } } while (0)
    s16x4 vlo[8], vhi[8]; u32x4 pw0, pw1, pw2, pw3;
#define PKW(P, B) cvt_pk_bf16(P[B], P[B + 1])
#define PAF(k) __builtin_bit_cast(bf16x8, pw##k)
#define VFR(i) (bf16x8){vlo[i][0], vlo[i][1], vlo[i][2], vlo[i][3], vhi[i][0], vhi[i][1], vhi[i][2], vhi[i][3]}
#define PIN(x) asm volatile("" : "+v"(x))
#define GAPA(MF, A0, A1, A2, A3, W0, W1, PW) do { MF; sacc += A0; sacc += A1; sacc += A2; sacc += A3; PIN(sacc); W0; W1; PIN(PW); SBAR(); } while (0)
#define EX(v) __builtin_amdgcn_exp2f(v)
#define GAPB(MF, X, B) do { MF; X[B] = EX(X[B]); X[B + 1] = EX(X[B + 1]); X[B + 2] = EX(X[B + 2]); X[B + 3] = EX(X[B + 3]); PIN(X); SBAR(); } while (0)
#define VRD(i) do { vlo[i] = vtr(vp_ + (((i) >> 2) * 4096 + ((i) & 3) * 1024)); vhi[i] = vtr(vp_ + (((i) >> 2) * 4096 + ((i) & 3) * 1024 + 512)); } while (0)
#define KRD(G, j) do { if (G) { kload2(kf, kp0 + sl_next, j); SBAR(); } } while (0)
#define STEP(C0, C1, P0, P1, t, GK, GV, GL) do { \
    if (MODE == 0) { const float nv_ = ((selbits >> (t)) & 1u) ? -mhat : NEGB; _Pragma("unroll") for (int r = 0; r < 16; ++r) negm[r] = nv_; PIN(negm); } \
    SBAR(); \
    const lcp vp_ = vp0 + ((((t) - 1) & 3) * SLOTB); \
    VRD(0); SBAR(); float sacc = (P0[0] + P0[1]); \
    GAPA(C0 = MFMA32(kf[0], qr[0], negm), P0[2], P0[3], P0[4], P0[5],     pw0[0] = PKW(P0, 0), pw0[1] = PKW(P0, 2), pw0); \
    VRD(4); SBAR(); GAPA(C1 = MFMA32(kf[1], qr[0], negm), P0[6], P0[7], P0[8], P0[9],     pw0[2] = PKW(P0, 4), pw0[3] = PKW(P0, 6), pw0); \
    VRD(1); SBAR(); GAPA(C0 = MFMA32(kf[2], qr[1], C0),   P0[10], P0[11], P0[12], P0[13], pw1[0] = PKW(P0, 8), pw1[1] = PKW(P0, 10), pw1); \
    VRD(5); SBAR(); GAPA(C1 = MFMA32(kf[3], qr[1], C1),   P0[14], P0[15], P1[0], P1[1],   pw1[2] = PKW(P0, 12), pw1[3] = PKW(P0, 14), pw1); \
    VRD(2); SBAR(); GAPA(C0 = MFMA32(kf[4], qr[2], C0),   P1[2], P1[3], P1[4], P1[5],     pw2[0] = PKW(P1, 0), pw2[1] = PKW(P1, 2), pw2); \
    VRD(6); SBAR(); GAPA(C1 = MFMA32(kf[5], qr[2], C1),   P1[6], P1[7], P1[8], P1[9],     pw2[2] = PKW(P1, 4), pw2[3] = PKW(P1, 6), pw2); \
    VRD(3); SBAR(); GAPA(C0 = MFMA32(kf[6], qr[3], C0),   P1[10], P1[11], P1[12], P1[13], pw3[0] = PKW(P1, 8), pw3[1] = PKW(P1, 10), pw3); \
    VRD(7); SBAR(); GAPA(C1 = MFMA32(kf[7], qr[3], C1),   P1[14], P1[15], 0.f, 0.f,       pw3[2] = PKW(P1, 12), pw3[3] = PKW(P1, 14), pw3); \
    l_reg += sacc; \
    if (GK) { DMA_K((t) + 3, sl_cur); } if (GV) { DMA_V((t) + 2, (((t) + 2) & 3) * SLOTB); } \
    if ((t) == n - 1) CAUSAL(C0, C1); \
    { float rm = rowmax32(C0, C1); \
      resc = false; \
      if (__builtin_expect(__any(rm > (float)THRL), 0)) { const float dl = __builtin_fmaxf(rm, 0.f); mhat += dl; \
        _Pragma("unroll") for (int r = 0; r < 16; ++r) { C0[r] -= dl; C1[r] -= dl; } \
        _Pragma("unroll") for (int r = 0; r < 16; ++r) negm[r] = -mhat; asm volatile("" : "+v"(negm)); \
        const float f = __builtin_amdgcn_exp2f(-dl); l_reg *= f; if (hi == 0) wsf[r32] = f; resc = true; } } \
    SBAR(); \
    GAPB(o[0] = MFMA32(PAF(0), VFR(0), o[0]), C0, 0); \
    GAPB(o[1] = MFMA32(PAF(0), VFR(4), o[1]), C0, 4); \
    KRD(GL, 0); GAPB(o[0] = MFMA32(PAF(1), VFR(1), o[0]), C0, 8); \
    KRD(GL, 1); GAPB(o[1] = MFMA32(PAF(1), VFR(5), o[1]), C0, 12); \
    KRD(GL, 2); GAPB(o[0] = MFMA32(PAF(2), VFR(2), o[0]), C1, 0); \
    KRD(GL, 3); GAPB(o[1] = MFMA32(PAF(2), VFR(6), o[1]), C1, 4); \
    GAPB(o[0] = MFMA32(PAF(3), VFR(3), o[0]), C1, 8); \
    GAPB(o[1] = MFMA32(PAF(3), VFR(7), o[1]), C1, 12); \
    } while (0)
#define ENDW(tt) do { if ((tt) + 3 < n) { WAIT_BAR(3); } else if ((tt) + 2 < n) { WAIT_BAR(2); } else if ((tt) + 1 < n) { WAIT_BAR(1); } else { WAIT_BAR(0); } } while (0)
    int t = 1;
    for (; t + 1 < n; t += 2) {
        STEP(pB0, pB1, pA0, pA1, t, (t + 3 < n), (t + 2 < n), (t + 1 < n));         ENDW(t);     RESC(); ROT();
        STEP(pA0, pA1, pB0, pB1, t + 1, (t + 4 < n), (t + 3 < n), (t + 2 < n));     ENDW(t + 1); RESC(); ROT();
    }
    if (t < n) {
        STEP(pB0, pB1, pA0, pA1, t, false, false, false); WAIT_BAR(0); RESC(); ROT();
        pA0 = pB0; pA1 = pB1;
    }
    { float sacc = pA0[0] + pA0[1];
#pragma unroll
      for (int r = 2; r < 16; ++r) sacc += pA0[r];
#pragma unroll
      for (int r = 0; r < 16; ++r) sacc += pA1[r];
      l_reg += sacc;
      pw0 = (u32x4){PKW(pA0, 0), PKW(pA0, 2), PKW(pA0, 4), PKW(pA0, 6)}; pw1 = (u32x4){PKW(pA0, 8), PKW(pA0, 10), PKW(pA0, 12), PKW(pA0, 14)};
      pw2 = (u32x4){PKW(pA1, 0), PKW(pA1, 2), PKW(pA1, 4), PKW(pA1, 6)}; pw3 = (u32x4){PKW(pA1, 8), PKW(pA1, 10), PKW(pA1, 12), PKW(pA1, 14)};
      const lcp vp_ = vp0 + (((n - 1) & 3) * SLOTB);
#pragma unroll
      for (int i = 0; i < 8; ++i) VRD(i);
      o[0] = MFMA32(PAF(0), VFR(0), o[0]); o[1] = MFMA32(PAF(0), VFR(4), o[1]);
      o[0] = MFMA32(PAF(1), VFR(1), o[0]); o[1] = MFMA32(PAF(1), VFR(5), o[1]);
      o[0] = MFMA32(PAF(2), VFR(2), o[0]); o[1] = MFMA32(PAF(2), VFR(6), o[1]);
      o[0] = MFMA32(PAF(3), VFR(3), o[0]); o[1] = MFMA32(PAF(3), VFR(7), o[1]); }
#undef PKW
#undef PAF
#undef VFR
#undef PIN
#undef GAPA
#undef GAPB
#undef EX
#undef VRD
#undef KRD
#undef STEP
#undef ENDW
#undef RESC
#undef ROT
#undef CAUSAL
#undef DMA_K
#undef DMA_V
    o0 = o[0]; o1 = o[1];
    lout = sum32x(l_reg);
}

__device__ __forceinline__ void unit_geom(int U, int& b, int& g, int& qt) { const int v = U & 255, ii = U >> 8, s = v & 7, bgp = v >> 3; b = bgp >> 1; g = bgp & 1; const unsigned w = (s == 0 ? 0x080a0c1cu : s == 1 ? 0x07090b1fu : s == 2 ? 0x030f1617u : s == 3 ? 0x01131419u : s == 4 ? 0x050d1218u : s == 5 ? 0x04061a1bu : s == 6 ? 0x000e151eu : 0x0210111du); qt = (int)((w >> (8 * ii)) & 255u); }
__device__ __forceinline__ void cmp_issue(LAS unsigned char* L, const bf16* kc, const bf16* vc, int tid_in, int wid) {
    int tid = tid_in; asm volatile("" : "+v"(tid)); const int lane = tid & 63;
    const unsigned lds0 = (unsigned)(size_t)L;
    const bf16* ksrc = kc + (size_t)lane * 64 + wid * 8;
    const bf16* vsrc = vc + (size_t)(16 * (wid & 3) + (lane >> 2)) * 64 + (wid >> 2) * 32 + (lane & 3) * 8;
    const unsigned kdst = lds0 + RK + wid * 1024, vdst = lds0 + RV + wid * 1024;
    glds16(ksrc, (unsigned)__builtin_amdgcn_readfirstlane(kdst)); glds16(ksrc + 64 * 64, (unsigned)__builtin_amdgcn_readfirstlane(kdst + SLOTB));
    glds16(vsrc, (unsigned)__builtin_amdgcn_readfirstlane(vdst)); glds16(vsrc + 64 * 64, (unsigned)__builtin_amdgcn_readfirstlane(vdst + SLOTB));
}
__device__ __forceinline__ void attn_phase(const Ctx& C0, int l) {
    PHASE_IDS(); const ArgsP A = get_args(); const Ctx C = launder(C0);
    const bf16* z = (const bf16*)(A->ws + WS_ZB); const bf16* kcmp = (const bf16*)(A->ws + WS_KCMP); const bf16* vcmp = (const bf16*)(A->ws + WS_VCMP); bf16* omix = (bf16*)(A->ws + WS_OMIX); float* asq = (float*)(A->ws + WS_ASQ);
    const float* conv_w = A->in[11] + (size_t)l * 3 * 512; const float* conv_b = A->in[12] + (size_t)l * 512; const float* gout = A->in[13] + (size_t)l * D;
    LAS unsigned char* L = C.L;
    const int wid = wave, hh = wid & 3, th = wid >> 2;
    if (wid >= 4) __builtin_amdgcn_s_setprio(1);
    bf16x8 qn[4]; unsigned short gn0, gn1, gn2;
#define UNIT_FETCH(UU) do { int b_, g_, qt_; unit_geom((UU), b_, g_, qt_); int tf_ = tid_; asm volatile("" : "+v"(tf_)); const int lf_ = tf_ & 63; \
        const bf16* zbq_ = z + (size_t)b_ * SEQ * ZW; const int rq_ = 64 * qt_ + 32 * th + (lf_ & 31); \
        _Pragma("unroll") for (int d0 = 0; d0 < 4; ++d0) qn[d0] = *(const bf16x8*)zt(zbq_, rq_, 64 * (4 * g_ + hh) + 16 * d0 + 8 * (lf_ >> 5)); \
        { const int gc_ = ZGT + 3 * (4 * g_ + hh); gn0 = *zt(zbq_, rq_, gc_); gn1 = *zt(zbq_, rq_, gc_ + 1); gn2 = *zt(zbq_, rq_, gc_ + 2); } \
        cmp_issue(L, kcmp + (size_t)(b_ * 2 + g_) * 128 * 64, vcmp + (size_t)(b_ * 2 + g_) * 128 * 64, tid_, wid); } while (0)
    if (C.vcu < 1024) UNIT_FETCH(C.vcu);
    for (int U = C.vcu; U < 1024; U += C.G) {
        int tid = tid_; asm volatile("" : "+v"(tid)); const int lane = tid & 63, r32 = lane & 31, hi = lane >> 5;
        LAS float* wsf = (LAS float*)(L + AWS) + wid * 64;
        LAS float* imp = (LAS float*)(L + AIMP); LAS unsigned* sel = (LAS unsigned*)(L + ASEL);
        int b, g, qt; unit_geom(U, b, g, qt);
        const int head = 4 * g + hh, qrel = 32 * th + r32, tq = 64 * qt + qrel;
        const bf16* zb = z + (size_t)b * SEQ * ZW;
        bf16x8 qr[4];
#pragma unroll
        for (int d0 = 0; d0 < 4; ++d0) qr[d0] = qn[d0];
        const float sg0 = sigmoid_f(bf2f(gn0)), sg1 = sigmoid_f(bf2f(gn1)), sg2 = sigmoid_f(bf2f(gn2));
        f32x16 o0, o1;
#pragma unroll
        for (int i = 0; i < 16; ++i) { o0[i] = 0.f; o1[i] = 0.f; }
        LAS float* otl = (LAS float*)(L + AOT) + wid * 2048 + lane;
        const lcp kp = L + RK + hi * 1024 + r32 * 16;
        const lcp vp = L + RV + ((lane >> 4) & 1) * 32 + (lane & 3) * 8 + (4 * hi + ((lane & 15) >> 2)) * 64;
        {
            WAIT_BAR(0);
            const int nlim = ((tq - 31) >> 4) - 4 * hi;
            f32x16 pu[4];
#pragma unroll
            for (int u = 0; u < 4; ++u) {
#pragma unroll
                for (int i = 0; i < 16; ++i) pu[u][i] = 0.f;
#pragma unroll
                for (int d0 = 0; d0 < 4; ++d0) { const bf16x8 a = *(const LAS bf16x8*)(kp + (u >> 1) * SLOTB + (u & 1) * 512 + d0 * 2048); pu[u] = MFMA32(a, qr[d0], pu[u]); } }
            float mx = MFLOOR;
#pragma unroll
            for (int u = 0; u < 4; ++u)
#pragma unroll
                for (int r = 0; r < 16; ++r) { pu[u][r] = (32 * u + (r & 3) + 8 * (r >> 2) <= nlim) ? pu[u][r] : NEGB; mx = fmaxf(mx, pu[u][r]); }
            mx = max32x(mx);
            float ls = 0.f;
#pragma unroll
            for (int u = 0; u < 4; ++u)
#pragma unroll
                for (int r = 0; r < 16; ++r) { pu[u][r] = __builtin_amdgcn_exp2f(pu[u][r] - mx); ls += pu[u][r]; }
            ls = sum32x(ls);
            const float inv = ls > 0.f ? __builtin_amdgcn_rcpf(ls) : 0.f;
            {
                LAS float* ip = imp + ((size_t)hh * 64 + qrel) * 33;
                float prevrecv = 0.f;
#pragma unroll
                for (int u = 0; u < 4; ++u) {
#pragma unroll
                    for (int q4 = 0; q4 < 4; ++q4) { const int k = 4 * u + q4;
                        const float gs = ((pu[u][4 * q4] + pu[u][4 * q4 + 1]) + (pu[u][4 * q4 + 2] + pu[u][4 * q4 + 3])) * inv; const float le = pu[u][4 * q4 + 3] * inv;
                        const auto rr = __builtin_amdgcn_permlane32_swap(__float_as_uint(le), __float_as_uint(le), false, false);
                        const float recv = __uint_as_float(hi ? rr[0] : rr[1]);
                        const float prev = hi ? recv : prevrecv;
                        ip[2 * k + hi] = gs + prev; prevrecv = recv; }
                    PV_STEP(PACKF(pu[u], 0), 2 * u); PV_STEP(PACKF(pu[u], 1), 2 * u + 1); }
            }
            if (hi == 0) wsf[r32] = sg0 * inv;
            asm volatile("s_waitcnt lgkmcnt(0)" ::: "memory");
#pragma unroll
            for (int r = 0; r < 16; ++r) { const float w = wsf[crow(r, hi)]; otl[r * 64] = o0[r] * w; otl[(16 + r) * 64] = o1[r] * w; }
        }
        LBAR();
        attn_issue(L, zb, ZKS + 64 * g, ZVS + 64 * g, 0, qt + 1, tid, wid);
        {
            const int tok = tid >> 3, part = tid & 7;
            const LAS float* i0 = imp + (size_t)tok * 33;
            unsigned long long key[4];
#pragma unroll
            for (int q = 0; q < 4; ++q) { const int j = part + 8 * q; const float vj = ((i0[j] + i0[64 * 33 + j]) + i0[2 * 64 * 33 + j]) + i0[3 * 64 * 33 + j];
                key[q] = (j >= 1 && j <= qt - 2) ? (((unsigned long long)__float_as_uint(vj) << 32) | (unsigned)(32 - j)) : 0ull; }
            unsigned bits = 0u;
            if (qt > 7) {
#pragma unroll
                for (int round = 0; round < 5; ++round) {
                    unsigned long long m = key[0] > key[1] ? key[0] : key[1]; { const unsigned long long m2 = key[2] > key[3] ? key[2] : key[3]; m = m > m2 ? m : m2; }
                    { const unsigned long long o_ = ((unsigned long long)(unsigned)__builtin_amdgcn_update_dpp(0, (int)(m >> 32), 0xB1, 0xf, 0xf, true) << 32) | (unsigned)__builtin_amdgcn_update_dpp(0, (int)m, 0xB1, 0xf, 0xf, true); m = m > o_ ? m : o_; }
                    { const unsigned long long o_ = ((unsigned long long)(unsigned)__builtin_amdgcn_update_dpp(0, (int)(m >> 32), 0x4E, 0xf, 0xf, true) << 32) | (unsigned)__builtin_amdgcn_update_dpp(0, (int)m, 0x4E, 0xf, 0xf, true); m = m > o_ ? m : o_; }
                    { const unsigned long long o_ = ((unsigned long long)(unsigned)__builtin_amdgcn_update_dpp(0, (int)(m >> 32), 0x141, 0xf, 0xf, true) << 32) | (unsigned)__builtin_amdgcn_update_dpp(0, (int)m, 0x141, 0xf, 0xf, true); m = m > o_ ? m : o_; }
#pragma unroll
                    for (int q = 0; q < 4; ++q) { const bool hit = key[q] == m; bits |= hit ? (1u << (part + 8 * q)) : 0u; key[q] = hit ? 0ull : key[q]; }
                }
                bits |= (unsigned)__builtin_amdgcn_update_dpp(0, (int)bits, 0xB1, 0xf, 0xf, true);
                bits |= (unsigned)__builtin_amdgcn_update_dpp(0, (int)bits, 0x4E, 0xf, 0xf, true);
                bits |= (unsigned)__builtin_amdgcn_update_dpp(0, (int)bits, 0x141, 0xf, 0xf, true);
            }
            if (part == 0) sel[tok] = bits | ((qt <= 7) ? ((2u << qt) - 1u) : (1u | (1u << qt) | (1u << (qt - 1))));
        }
        LBAR();
        const unsigned selbits = sel[qrel];
        { float lsum;
          attn_branch<0, true>(L, zb, ZKS + 64 * g, ZVS + 64 * g, 0, qt, qt, qrel, selbits, qr, o0, o1, lsum, tid, wid);
          if (hi == 0) wsf[r32] = sg1 * __builtin_amdgcn_rcpf(lsum);
          asm volatile("s_waitcnt lgkmcnt(0)" ::: "memory");
#pragma unroll
          for (int r = 0; r < 16; ++r) { const float w = wsf[crow(r, hi)]; otl[r * 64] += o0[r] * w; otl[(16 + r) * 64] += o1[r] * w; } }
        { float lsum;
          attn_branch<1>(L, zb, ZKW + 64 * g, ZVW + 64 * g, qt >= 8 ? qt - 8 : 0, qt, qt, qrel, 0u, qr, o0, o1, lsum, tid, wid);
          if (hi == 0) wsf[r32] = sg2 * __builtin_amdgcn_rcpf(lsum);
          asm volatile("s_waitcnt lgkmcnt(0)" ::: "memory");
#pragma unroll
          for (int r = 0; r < 16; ++r) { const float w = wsf[crow(r, hi)]; otl[r * 64] += o0[r] * w; otl[(16 + r) * 64] += o1[r] * w; }
          asm volatile("s_waitcnt lgkmcnt(0)" ::: "memory"); }
        LBAR();
        if (U + C.G < 1024) UNIT_FETCH(U + C.G);
        const int c8 = lane * 8; const int tk0 = 64 * qt + 32 * g + 4 * wid;
        u32x4 whc[4], wbg[4], wcg[4], wpa[2], wpb[2];
        { const int tp = tk0 >= 2 ? tk0 - 2 : 0;
#pragma unroll
          for (int i = 0; i < 2; ++i) { wpa[i] = *(const u32x4*)zt(zb, tp + i, ZHC + c8); wpb[i] = *(const u32x4*)zt(zb, tp + i, ZCG + c8); }
#pragma unroll
          for (int i = 0; i < 4; ++i) { whc[i] = *(const u32x4*)zt(zb, tk0 + i, ZHC + c8); wbg[i] = *(const u32x4*)zt(zb, tk0 + i, ZBG + c8); wcg[i] = *(const u32x4*)zt(zb, tk0 + i, ZCG + c8); } }
        { const LAS float* ow = (const LAS float*)(L + AOT) + wid * 2048; const size_t rowb = (size_t)b * SEQ + 64 * qt + 32 * th;
          const int d = 8 * (lane & 7);
          const f32x4 g0 = *(const f32x4*)(gout + 64 * head + d), g1 = *(const f32x4*)(gout + 64 * head + d + 4);
#pragma unroll
          for (int i = 0; i < 4; ++i) { const int q = i * 8 + (lane >> 3);
              const LAS float* src = ow + (16 * (d >> 5) + (q & 3) + 4 * (q >> 3)) * 64 + (d & 31) + 32 * ((q >> 2) & 1);
              const f32x4 v0 = *(const LAS f32x4*)src, v1 = *(const LAS f32x4*)(src + 4);
              float ss = (v0.x * v0.x + v0.y * v0.y) + (v0.z * v0.z + v0.w * v0.w) + (v1.x * v1.x + v1.y * v1.y) + (v1.z * v1.z + v1.w * v1.w);
              ss = sum8_dpp(ss);
              const u32x4 w4 = {cvt_pk_bf16(v0.x * g0.x, v0.y * g0.y), cvt_pk_bf16(v0.z * g0.z, v0.w * g0.w), cvt_pk_bf16(v1.x * g1.x, v1.y * g1.y), cvt_pk_bf16(v1.z * g1.z, v1.w * g1.w)};
              *(u32x4*)((char*)omix + pg8::tl_off((int)(rowb + q), 64 * head + d, D)) = w4;
              if ((lane & 7) == 0) asq[(rowb + q) * 8 + head] = ss; } }
        { float w0[8], w1[8], w2[8], cb[8], gc[8];
#pragma unroll
          for (int e = 0; e < 8; ++e) { w0[e] = conv_w[c8 + e]; w1[e] = conv_w[512 + c8 + e]; w2[e] = conv_w[1024 + c8 + e]; cb[e] = conv_b[c8 + e]; gc[e] = gout[512 + c8 + e]; }
          float um2[8], um1[8];
          { float ta[8], tb[8]; const float zf = tk0 == 0 ? 0.f : 1.f;
            unpack8(wpa[0], ta); unpack8(wpb[0], tb);
#pragma unroll
            for (int e = 0; e < 8; ++e) um2[e] = ta[e] * tb[e] * zf;
            unpack8(wpa[1], ta); unpack8(wpb[1], tb);
#pragma unroll
            for (int e = 0; e < 8; ++e) um1[e] = ta[e] * tb[e] * zf; }
          float oc[4][8], s2[4];
#pragma unroll
          for (int i = 0; i < 4; ++i) {
              float hc[8], bg[8], cg[8];
              unpack8(whc[i], hc); unpack8(wbg[i], bg); unpack8(wcg[i], cg);
              s2[i] = 0.f;
#pragma unroll
              for (int e = 0; e < 8; ++e) { const float u = cg[e] * hc[e]; const float v = cb[e] + um2[e] * w0[e] + um1[e] * w1[e] + u * w2[e]; oc[i][e] = bg[e] * v; s2[i] += oc[i][e] * oc[i][e]; um2[e] = um1[e]; um1[e] = u; } }
#pragma unroll
          for (int i = 0; i < 4; ++i) s2[i] = sum64_dpp(s2[i]);
#pragma unroll
          for (int i = 0; i < 4; ++i) { const float rc = __builtin_amdgcn_rsqf(s2[i] * (1.0f / 512.0f) + EPS);
              u32x4 o;
              o.x = cvt_pk_bf16(oc[i][0] * rc * gc[0], oc[i][1] * rc * gc[1]); o.y = cvt_pk_bf16(oc[i][2] * rc * gc[2], oc[i][3] * rc * gc[3]);
              o.z = cvt_pk_bf16(oc[i][4] * rc * gc[4], oc[i][5] * rc * gc[5]); o.w = cvt_pk_bf16(oc[i][6] * rc * gc[6], oc[i][7] * rc * gc[7]);
              *(u32x4*)((char*)omix + pg8::tl_off(b * SEQ + tk0 + i, 512 + c8, D)) = o; } }
    }
#undef UNIT_FETCH
    asm volatile("s_waitcnt lgkmcnt(0)" ::: "memory"); __builtin_amdgcn_s_barrier();
    __builtin_amdgcn_s_setprio(0);
}

__global__ void __launch_bounds__(512, 2) nsa_fwd(Args args) {
    extern __shared__ __attribute__((aligned(16))) unsigned char lds[];
    Ctx C;
    C.L = (LAS unsigned char*)lds;
    C.G = gridDim.x; C.bx = blockIdx.x; { const int bx = blockIdx.x; C.vcu = (C.G % 8 == 0) ? (bx % 8) * (C.G / 8) + bx / 8 : bx; }
    for (int u = threadIdx.x; u < (LDS_BYTES - CTRL_OFF) / 4; u += 512) ((LAS unsigned*)(C.L + CTRL_OFF))[u] = 0u;
    __syncthreads();
    XcdBarrier bar = xcd_barrier_post((unsigned*)(args.ws + WS_CTL) + CW_BAR, (volatile LAS unsigned*)(C.L + MISC_OFF + 32));

#define GRID_SYNC() do { XcdBarrier b_ = bar; unsigned long long bp_ = (unsigned long long)b_.bar; unsigned bx_ = b_.x; asm volatile("" : "+s"(bp_), "+s"(bx_)); b_.bar = (unsigned*)bp_; b_.x = bx_; xcd_barrier(b_); } while (0)
    prologue(C);
    GRID_SYNC();
    prologue2(C);
    GRID_SYNC();

    for (int l = 0; l < DEPTH; ++l) {
        for (int half = 0; half < 2; ++half) {
            const int sub = half ? 2 : 0;
            { const ArgsP A = get_args(); const Ctx Cl = launder(C);
              pg8::Gemm g{(const bf16*)(A->ws + WS_H), (const bf16*)(A->ws + WS_WFI) + (size_t)(l * 2 + half) * NFI * D, M, NFI, D}; pg8::StaticOrder S; S.init(M, NFI, Cl.G, Cl.bx);
              pg8::EpiSwiGLU E{(bf16*)(A->ws + WS_ZB), FF, (const float*)(A->ws + WS_RSQ), (const float*)(A->ws + WS_SBW) + (size_t)(3 * l + sub) * NB * NFI, NFI};
              pg8::gemm_phase<pg8::EpiSwiGLU, pg8::StaticOrder, true, true>(Cl.L, g, S, E); }
            GRID_SYNC();
            { const ArgsP A = get_args(); const Ctx Cl = launder(C);
              const int nl = half ? (l < DEPTH - 1 ? l + 1 : l) : l, nsub = half ? 0 : 1;
              const float* modn = (const float*)(A->ws + WS_MOD) + (size_t)nl * NB * MODW + nsub * 3072;
              pg8::Gemm g{(const bf16*)(A->ws + WS_ZB), (const bf16*)(A->ws + WS_WFO) + (size_t)(l * 2 + half) * D * FF, M, D, FF}; pg8::StaticOrder S; S.init(M, D, Cl.G, Cl.bx);
              pg8::EpiResid E{(unsigned*)(A->ws + WS_X), (const float*)(A->ws + WS_MOD) + (size_t)l * NB * MODW + sub * 3072 + 2048,
                              (bf16*)(A->ws + WS_H), A->in[4] + (size_t)(nl * 3 + nsub) * D, modn + 1024, (float*)(A->ws + WS_RSQ), MODW, 0.5f};
              pg8::gemm_phase<pg8::EpiResid, pg8::StaticOrder, true, true>(Cl.L, g, S, E); }
            GRID_SYNC();
            if (half == 0) {
                { const ArgsP A = get_args(); const Ctx Cl = launder(C);
                  pg8::Gemm g{(const bf16*)(A->ws + WS_H), (const bf16*)(A->ws + WS_WMI) + (size_t)l * ZW * D, M, ZW, D}; pg8::StaticOrder S; S.init(M, ZW, Cl.G, Cl.bx);
                  pg8::EpiBf16Plain E{(bf16*)(A->ws + WS_ZB), ZW, (const float*)(A->ws + WS_RSQ), (const float*)(A->ws + WS_SBW) + (size_t)(3 * l + 1) * NB * NFI, NFI, 2};
                  pg8::gemm_phase<pg8::EpiBf16Plain, pg8::StaticOrder, true, true>(Cl.L, g, S, E); }
                GRID_SYNC();
                compress_phase(C, l);
                GRID_SYNC();
                attn_phase(C, l);
                GRID_SYNC();
                { const ArgsP A = get_args(); const Ctx Cl = launder(C);
                  const float* modn = (const float*)(A->ws + WS_MOD) + (size_t)l * NB * MODW + 2 * 3072;
                  pg8::Gemm g{(const bf16*)(A->ws + WS_OMIX), (const bf16*)(A->ws + WS_WMO) + (size_t)l * D * D, M, D, D}; pg8::StaticOrder S; S.init(M, D, Cl.G, Cl.bx);
                  pg8::EpiResidMix E; E.x16 = (unsigned*)(A->ws + WS_X); E.gate = (const float*)(A->ws + WS_MOD) + (size_t)l * NB * MODW + 3072 + 2048; E.hs = (bf16*)(A->ws + WS_H);
                  E.gn = A->in[4] + (size_t)(l * 3 + 2) * D; E.scale = modn + 1024; E.rowsq = (float*)(A->ws + WS_RSQ); E.mod_stride = MODW; E.coef = 1.0f; E.asq = (const float*)(A->ws + WS_ASQ);
                  pg8::gemm_phase<pg8::EpiResidMix, pg8::StaticOrder, true, true>(Cl.L, g, S, E); }
                GRID_SYNC();
            }
        }
    }
    finalnorm_phase(C);
}

extern "C" void kernel_launch(void* const* d_in, const int* in_sizes, int n_in, void* d_out, int out_size, void* d_ws, size_t ws_size, hipStream_t stream) {
    static int grid = 0;
    if (grid == 0) {
        if (n_in != 16 || in_sizes[0] != M * D || out_size != M * D || ws_size < WS_END) { fprintf(stderr, "kernel_launch: unexpected shapes (n_in %d, in0 %d, out %d, ws %zu); nothing launched\n", n_in, n_in > 0 ? in_sizes[0] : -1, out_size, ws_size); grid = -1; return; }
        int dev = 0, cus = 0;
        if (hipGetDevice(&dev) != hipSuccess || hipDeviceGetAttribute(&cus, hipDeviceAttributeMultiprocessorCount, dev) != hipSuccess) { grid = -1; return; }
        if (hipFuncSetAttribute((const void*)nsa_fwd, hipFuncAttributeMaxDynamicSharedMemorySize, LDS_BYTES) != hipSuccess) { fprintf(stderr, "kernel_launch: hipFuncSetAttribute failed\n"); grid = -1; return; }
        int per_cu = 0;
        if (hipOccupancyMaxActiveBlocksPerMultiprocessor(&per_cu, (const void*)nsa_fwd, 512, LDS_BYTES) != hipSuccess || per_cu < 1) fprintf(stderr, "kernel_launch: occupancy query reports %d\n", per_cu);
        (void)hipGetLastError();
        grid = cus;
    }
    if (grid < 0) return;
    if (hipMemsetAsync((char*)d_ws + WS_CTL, 0, CTL_ZERO_BYTES, stream) != hipSuccess) return;
    Args a{};
    for (int i = 0; i < 16; ++i) a.in[i] = (const float*)d_in[i];
    a.out = (float*)d_out; a.ws = (unsigned char*)d_ws;
    hipLaunchKernelGGL(nsa_fwd, dim3(grid), dim3(512), LDS_BYTES, stream, a);
}
```

```cpp
#include <hip/hip_runtime.h>
#include <cstdio>
#include <cstdint>
namespace pg8 {
#define PG8_LAS __attribute__((address_space(3)))
typedef unsigned short bf16_t;
typedef short bf16x8 __attribute__((ext_vector_type(8)));
typedef float f32x4 __attribute__((ext_vector_type(4)));
typedef unsigned u32x4 __attribute__((ext_vector_type(4)));
constexpr int BM = 256, BK = 64, HALF = 128, HTB = HALF * BK * 2  , STAGE_BYTES = 8 * HTB, NXCD = 8, WGM = 8;

__host__ __device__ __forceinline__ int lds_byte(int r, int c) { const int st = (r >> 4) * 2 + (c >> 5), rr = r & 15, cc = c & 31, ob = rr * 64 + cc * 2; return st * 1024 + (ob ^ (((ob >> 9) & 1) << 5)); }
__host__ __device__ __forceinline__ void stage_rc(int b, int& R, int& C) { const int st = b / 1024, sb = b % 1024, swz = sb ^ (((sb >> 9) & 1) << 5); R = (st >> 1) * 16 + swz / 64; C = (st & 1) * 32 + (swz % 64) / 2; }
__host__ __device__ __forceinline__ int perm32(int rho) { const int n = rho >> 4, i = rho & 15; return 8 * (i >> 2) + 4 * n + (i & 3); }

__host__ __device__ __forceinline__ size_t tl_off(int row, int col, int K) { return ((size_t)((row >> 4) * (K >> 5) + (col >> 5)) << 10) + (size_t)(((row & 15) << 6) + ((col & 31) << 1)); }
struct Unit { int pm, pn; };
struct Gemm { const bf16_t* A; const bf16_t* Bt; int M, N, K; };

struct StaticOrder {
    int nM, nN, nwg, G, c;
    __host__ __device__ void init(int M, int N, int G_, int c_) { nM = M / BM; nN = N / BM; nwg = nM * nN; G = G_; c = c_; }
    __host__ __device__ bool next(int i, Unit& u) const {
        const long L = (long)i * G + c; if (L >= nwg) return false;
        int wgid = (int)L; { const int q = nwg / NXCD, r = nwg % NXCD, xcd = wgid % NXCD, off = wgid / NXCD; wgid = (xcd < r ? xcd * (q + 1) : r * (q + 1) + (xcd - r) * q) + off; }
        const int nig = WGM * nN, gid = wgid / nig, fm = gid * WGM, gsz = (nM - fm) < WGM ? (nM - fm) : WGM;
        u.pm = fm + ((wgid % nig) % gsz); u.pn = (wgid % nig) / gsz; return true;
    }
    __device__ __forceinline__ void a_ready(const Unit&) const {}
    __device__ __forceinline__ void done(const Unit&) const {}
};

#define PG8_GAS __attribute__((address_space(1)))
typedef float f32x2 __attribute__((ext_vector_type(2)));
typedef unsigned u32x2 __attribute__((ext_vector_type(2)));
typedef _Float16 f16x2_t __attribute__((ext_vector_type(2)));
__device__ __forceinline__ unsigned cvt_pk_f16(float lo, float hi) { f32x2 v = {lo, hi}; f16x2_t h = __builtin_convertvector(v, f16x2_t); return __builtin_bit_cast(unsigned, h); }
typedef _Float16 f16x4_t __attribute__((ext_vector_type(4)));
__device__ __forceinline__ f32x4 unpack_f16x4(u32x2 w) { const f16x4_t h = __builtin_bit_cast(f16x4_t, w); return __builtin_convertvector(h, f32x4); }
typedef __bf16 bf16x2_t __attribute__((ext_vector_type(2)));
__device__ __forceinline__ unsigned cvt_pk_bf16(float lo, float hi) { f32x2 v = {lo, hi}; bf16x2_t b = __builtin_convertvector(v, bf16x2_t); return __builtin_bit_cast(unsigned, b); }
__device__ __forceinline__ float silu_f(float x) { return x * __builtin_amdgcn_rcpf(1.0f + __builtin_amdgcn_exp2f(-1.4426950408889634f * x)); }

__device__ __forceinline__ float xsum16(float s) { return s + __shfl_xor(s, 16); }
__device__ __forceinline__ float xsum32(float s) { const auto r = __builtin_amdgcn_permlane32_swap(__float_as_uint(s), __float_as_uint(s), false, false); return __uint_as_float(r[0]) + __uint_as_float(r[1]); }
__device__ __forceinline__ void xl_prefetch_consumer(const float* rowsq, const float* biasrow, int pm, PG8_LAS unsigned char* xl, int, int) {
    int t_ = threadIdx.x; asm volatile("" : "+v"(t_)); const int lane = t_ & 63, wid = __builtin_amdgcn_readfirstlane(t_ >> 6);
    if (wid < 4) __builtin_amdgcn_global_load_lds((const unsigned*)(rowsq + (size_t)wid * (128 * 256) + (size_t)pm * 256 + 4 * lane), (PG8_LAS unsigned*)(xl + wid * 1024), 16, 0, 0);
    if (wid == 4) __builtin_amdgcn_global_load_lds((const unsigned*)(biasrow + 4 * lane), (PG8_LAS unsigned*)(xl + 16384), 16, 0, 0);
}
__device__ __forceinline__ void epi_loads(float (&rs)[2][4], f32x4 (&bv)[4], PG8_LAS unsigned char* xl, int wr, int wc, int fr, int fq) {
    const unsigned ra = (unsigned)(size_t)xl + (unsigned)(fq * 1024 + (wr * 64 + fr) * 4);
    const unsigned ba = (unsigned)(size_t)xl + 16384u + (unsigned)((wc * 32 + 8 * fq) * 4);
    float p[2][4];
    asm volatile("ds_read_b32 %0, %12\n\tds_read_b32 %1, %12 offset:64\n\tds_read_b32 %2, %12 offset:128\n\tds_read_b32 %3, %12 offset:192\n\t"
                 "ds_read_b32 %4, %12 offset:512\n\tds_read_b32 %5, %12 offset:576\n\tds_read_b32 %6, %12 offset:640\n\tds_read_b32 %7, %12 offset:704\n\t"
                 "ds_read_b128 %8, %13\n\tds_read_b128 %9, %13 offset:16\n\tds_read_b128 %10, %13 offset:512\n\tds_read_b128 %11, %13 offset:528\n\t"
                 "s_waitcnt lgkmcnt(0)"
                 : "=&v"(p[0][0]), "=&v"(p[0][1]), "=&v"(p[0][2]), "=&v"(p[0][3]), "=&v"(p[1][0]), "=&v"(p[1][1]), "=&v"(p[1][2]), "=&v"(p[1][3]), "=&v"(bv[0]), "=&v"(bv[1]), "=&v"(bv[2]), "=&v"(bv[3])
                 : "v"(ra), "v"(ba) : "memory");
#pragma unroll
    for (int ai = 0; ai < 2; ++ai)
#pragma unroll
        for (int m = 0; m < 4; ++m) { float s = xsum32(xsum16(p[ai][m])); rs[ai][m] = __builtin_amdgcn_rsqf(s * (1.0f / 1024.0f) + 1e-6f); }
}
__device__ __forceinline__ bf16x8 zero_frag() { bf16x8 z = {0, 0, 0, 0, 0, 0, 0, 0}; asm volatile("" : "+v"(z)); return z; }
__device__ __forceinline__ void zero4(f32x4& v, const bf16x8& zf) { v = __builtin_amdgcn_mfma_f32_16x16x32_bf16(zf, zf, (f32x4){0.f, 0.f, 0.f, 0.f}, 0, 0, 0); }
struct EpiBf16Plain {
    static constexpr bool PERM = true, AFTER_DRAIN = false, PREFETCH = true, MIDSCALE = false; static constexpr bool KSERP = true;
    __device__ __forceinline__ void prefetch(const Unit& u, PG8_LAS unsigned char* xl, int wid, int lane) const { xl_prefetch_consumer(rowsq, bias + (size_t)(u.pm >> 3) * bias_stride + u.pn * BM, u.pm, xl, wid, lane); }
    bf16_t* O; int ldc; const float* rowsq; const float* bias; int bias_stride; int qtiles;
    static constexpr float QSCALE = 0.125f * 1.4426950408889634f;
    __device__ __forceinline__ void operator()(f32x4 (&acc)[2][2][4][2], const Unit& u, int wr, int wc, int fr, int fq, PG8_LAS unsigned char* xl) const {
        const bf16x8 zf_ = zero_frag();
        const int row0 = u.pm * BM + wr * 64 + fr; const int col0 = u.pn * BM + wc * 32 + 8 * fq;
        const float* bp = bias + (size_t)(u.pm >> 3) * bias_stride + col0;
        f32x4 bvl[4]; float rsv[2][4]; epi_loads(rsv, bvl, xl, wr, wc, fr, fq);
        if (u.pn < qtiles) {
#pragma unroll
            for (int i = 0; i < 4; ++i) bvl[i] *= QSCALE;
#pragma unroll
            for (int ai = 0; ai < 2; ++ai)
#pragma unroll
                for (int m = 0; m < 4; ++m) rsv[ai][m] *= QSCALE; }
#pragma unroll
        for (int ai = 0; ai < 2; ++ai)
#pragma unroll
            for (int m = 0; m < 4; ++m) { const int row = row0 + ai * HALF + m * 16; const float rs = rsv[ai][m];
#pragma unroll
                for (int bj = 0; bj < 2; ++bj) { const f32x4 v0 = acc[ai][bj][m][0] * rs + bvl[2 * bj], v1 = acc[ai][bj][m][1] * rs + bvl[2 * bj + 1];
                    zero4(acc[ai][bj][m][0], zf_); zero4(acc[ai][bj][m][1], zf_);
                    u32x4 w; w.x = cvt_pk_bf16(v0[0], v0[1]); w.y = cvt_pk_bf16(v0[2], v0[3]); w.z = cvt_pk_bf16(v1[0], v1[1]); w.w = cvt_pk_bf16(v1[2], v1[3]);
                    *(PG8_GAS u32x4*)((char*)O + tl_off(row, col0 + bj * HALF, ldc)) = w; } }
    }
};
struct EpiSwiGLU {
    static constexpr bool PERM = true, AFTER_DRAIN = false, PREFETCH = true, MIDSCALE = false; static constexpr bool KSERP = true;
    __device__ __forceinline__ void prefetch(const Unit& u, PG8_LAS unsigned char* xl, int wid, int lane) const { xl_prefetch_consumer(rowsq, bias + (size_t)(u.pm >> 3) * bias_stride + u.pn * BM, u.pm, xl, wid, lane); }
    bf16_t* O; int ldo; const float* rowsq; const float* bias; int bias_stride;
    __device__ __forceinline__ void operator()(f32x4 (&acc)[2][2][4][2], const Unit& u, int wr, int wc, int fr, int fq, PG8_LAS unsigned char* xl) const {
        const bf16x8 zf_ = zero_frag();
        const int row0 = u.pm * BM + wr * 64 + fr; const int col0 = u.pn * HALF + wc * 32 + 8 * fq;
        const float* bp = bias + (size_t)(u.pm >> 3) * bias_stride + u.pn * BM + wc * 32 + 8 * fq;
        f32x4 bvl[4]; float rsv[2][4]; epi_loads(rsv, bvl, xl, wr, wc, fr, fq);
        const f32x4 bg0 = bvl[0], bg1 = bvl[1], bu0 = bvl[2], bu1 = bvl[3];
#pragma unroll
        for (int ai = 0; ai < 2; ++ai)
#pragma unroll
            for (int m = 0; m < 4; ++m) { const int row = row0 + ai * HALF + m * 16; const float rs = rsv[ai][m]; bf16_t* rowp = (bf16_t*)((char*)O + tl_off(row, col0, ldo));
                const f32x4 g0 = acc[ai][0][m][0] * rs + bg0, g1 = acc[ai][0][m][1] * rs + bg1, u0 = acc[ai][1][m][0] * rs + bu0, u1 = acc[ai][1][m][1] * rs + bu1;
                zero4(acc[ai][0][m][0], zf_); zero4(acc[ai][0][m][1], zf_); zero4(acc[ai][1][m][0], zf_); zero4(acc[ai][1][m][1], zf_);
                u32x4 w;
                w.x = cvt_pk_bf16(silu_f(g0[0]) * u0[0], silu_f(g0[1]) * u0[1]); w.y = cvt_pk_bf16(silu_f(g0[2]) * u0[2], silu_f(g0[3]) * u0[3]);
                w.z = cvt_pk_bf16(silu_f(g1[0]) * u1[0], silu_f(g1[1]) * u1[1]); w.w = cvt_pk_bf16(silu_f(g1[2]) * u1[2], silu_f(g1[3]) * u1[3]);
                *(PG8_GAS u32x4*)rowp = w; }
    }
};
struct EpiResid {
    static constexpr bool PERM = true, AFTER_DRAIN = false, PREFETCH = true, MIDSCALE = false; static constexpr bool KSERP = true;
    __device__ __forceinline__ void prefetch(const Unit& u, PG8_LAS unsigned char* xl, int, int) const {
        int t_ = threadIdx.x; asm volatile("" : "+v"(t_)); const int lane = t_ & 63, wid = __builtin_amdgcn_readfirstlane(t_ >> 6);
        if (wid == 0) __builtin_amdgcn_global_load_lds((const unsigned*)(gate + (size_t)(u.pm >> 3) * mod_stride + u.pn * BM + 4 * lane), (PG8_LAS unsigned*)(xl), 16, 0, 0);
        if (wid == 1) __builtin_amdgcn_global_load_lds((const unsigned*)(gn + u.pn * BM + 4 * lane), (PG8_LAS unsigned*)(xl + 1024), 16, 0, 0);
        if (wid == 2) __builtin_amdgcn_global_load_lds((const unsigned*)(scale + (size_t)(u.pm >> 3) * mod_stride + u.pn * BM + 4 * lane), (PG8_LAS unsigned*)(xl + 2048), 16, 0, 0);
    }
    unsigned* x16;   const float* gate; bf16_t* hs; const float* gn; const float* scale; float* rowsq; int mod_stride; float coef;
    __device__ __forceinline__ void operator()(f32x4 (&acc)[2][2][4][2], const Unit& u, int wr, int wc, int fr, int fq, PG8_LAS unsigned char* xl) const {
        const bf16x8 zf_ = zero_frag();
        const int row0 = u.pm * BM + wr * 64 + fr; const int col0 = u.pn * BM + wc * 32 + 8 * fq;
        f32x4 gv[2][2], av[2][2];
        { f32x4 sv[2][2]; const unsigned la = (unsigned)(size_t)xl + (unsigned)((wc * 32 + 8 * fq) * 4);
          asm volatile("ds_read_b128 %0, %12\n\tds_read_b128 %1, %12 offset:16\n\tds_read_b128 %2, %12 offset:512\n\tds_read_b128 %3, %12 offset:528\n\t"
                       "ds_read_b128 %4, %12 offset:1024\n\tds_read_b128 %5, %12 offset:1040\n\tds_read_b128 %6, %12 offset:1536\n\tds_read_b128 %7, %12 offset:1552\n\t"
                       "ds_read_b128 %8, %12 offset:2048\n\tds_read_b128 %9, %12 offset:2064\n\tds_read_b128 %10, %12 offset:2560\n\tds_read_b128 %11, %12 offset:2576\n\t"
                       "s_waitcnt lgkmcnt(0)"
                       : "=&v"(gv[0][0]), "=&v"(gv[0][1]), "=&v"(gv[1][0]), "=&v"(gv[1][1]), "=&v"(av[0][0]), "=&v"(av[0][1]), "=&v"(av[1][0]), "=&v"(av[1][1]), "=&v"(sv[0][0]), "=&v"(sv[0][1]), "=&v"(sv[1][0]), "=&v"(sv[1][1])
                       : "v"(la) : "memory");
#pragma unroll
          for (int bj = 0; bj < 2; ++bj)
#pragma unroll
              for (int n = 0; n < 2; ++n) { gv[bj][n] = gv[bj][n] * coef; av[bj][n] = av[bj][n] * (sv[bj][n] + 1.0f); } }
        u32x4 xa[2], xb[2], xc[2]; float sqv[8];
#define EPR_LOAD(dst, rg) do { const int rw_ = row0 + ((rg) >> 2) * HALF + ((rg) & 3) * 16; _Pragma("unroll") for (int bj = 0; bj < 2; ++bj) \
            dst[bj] = *(const PG8_GAS u32x4*)((const char*)x16 + tl_off(rw_, col0 + bj * HALF, 1024)); } while (0)
#define EPR_ROW(src, rg) do { const int ai_ = (rg) >> 2, m_ = (rg) & 3; const int rw_ = row0 + ai_ * HALF + m_ * 16; float sq_ = 0.f; \
            _Pragma("unroll") for (int bj = 0; bj < 2; ++bj) { const f32x4 x0 = unpack_f16x4((u32x2){src[bj].x, src[bj].y}) + gv[bj][0] * acc[ai_][bj][m_][0], x1 = unpack_f16x4((u32x2){src[bj].z, src[bj].w}) + gv[bj][1] * acc[ai_][bj][m_][1]; \
                { const u32x4 xw = {cvt_pk_f16(x0[0], x0[1]), cvt_pk_f16(x0[2], x0[3]), cvt_pk_f16(x1[0], x1[1]), cvt_pk_f16(x1[2], x1[3])}; *(PG8_GAS u32x4*)((char*)x16 + tl_off(rw_, col0 + bj * HALF, 1024)) = xw; } \
                sq_ += ((x0[0] * x0[0] + x0[1] * x0[1]) + (x0[2] * x0[2] + x0[3] * x0[3])) + ((x1[0] * x1[0] + x1[1] * x1[1]) + (x1[2] * x1[2] + x1[3] * x1[3])); \
                const f32x4 h0 = x0 * av[bj][0], h1 = x1 * av[bj][1]; const u32x4 w = {cvt_pk_bf16(h0[0], h0[1]), cvt_pk_bf16(h0[2], h0[3]), cvt_pk_bf16(h1[0], h1[1]), cvt_pk_bf16(h1[2], h1[3])}; \
                *(PG8_GAS u32x4*)((char*)hs + tl_off(rw_, col0 + bj * HALF, 1024)) = w; zero4(acc[ai_][bj][m_][0], zf_); zero4(acc[ai_][bj][m_][1], zf_); } \
            sqv[(rg)] = xsum32(xsum16(sq_)); } while (0)
        EPR_LOAD(xa, 0); EPR_LOAD(xb, 1);
        EPR_LOAD(xc, 2); EPR_ROW(xa, 0);
        EPR_LOAD(xa, 3); EPR_ROW(xb, 1);
        EPR_LOAD(xb, 4); EPR_ROW(xc, 2);
        EPR_LOAD(xc, 5); EPR_ROW(xa, 3);
        EPR_LOAD(xa, 6); EPR_ROW(xb, 4);
        EPR_LOAD(xb, 7); EPR_ROW(xc, 5);
        EPR_ROW(xa, 6);
        EPR_ROW(xb, 7);
        { PG8_LAS float* S = (PG8_LAS float*)(xl + 14336);
          if (fq == 0) {
#pragma unroll
              for (int rg = 0; rg < 8; ++rg) S[wc * 256 + (rg >> 2) * HALF + wr * 64 + (rg & 3) * 16 + fr] = sqv[rg]; }
          asm volatile("s_waitcnt lgkmcnt(0)" ::: "memory"); __builtin_amdgcn_s_barrier(); asm volatile("" ::: "memory");
          const int wid_ = wr * 4 + wc;
          if (wid_ < 4) { const int r = wid_ * 64 + fq * 16 + fr; const float s = (S[r] + S[256 + r]) + (S[512 + r] + S[768 + r]);
              *(PG8_GAS float*)(rowsq + (size_t)u.pn * (128 * 256) + (size_t)u.pm * BM + r) = s; } }
#undef EPR_LOAD
#undef EPR_ROW
    }
};


struct EpiResidMix : EpiResid {
    static constexpr bool MIDSCALE = true; static constexpr int MID_T = 8; static constexpr bool KSERP = false;
    const float* asq;
    __device__ __forceinline__ void prefetch(const Unit& u, PG8_LAS unsigned char* xl, int a_, int b_) const {
        EpiResid::prefetch(u, xl, a_, b_);
        int t_ = threadIdx.x; asm volatile("" : "+v"(t_)); const int lane = t_ & 63, wid = __builtin_amdgcn_readfirstlane(t_ >> 6);
        __builtin_amdgcn_global_load_lds((const unsigned*)(asq + ((size_t)u.pm * 256 + 32 * wid) * 8 + 4 * lane), (PG8_LAS unsigned*)(xl + 4096 + wid * 1024), 16, 0, 0);
    }
    __device__ __forceinline__ void midscale(f32x4 (&acc)[2][2][4][2], int wr, int fr, int fq, PG8_LAS unsigned char* xl) const {
        const unsigned la = (unsigned)(size_t)xl + 4096u + (unsigned)((wr * 64 + fr) * 32 + fq * 8);
        f32x2 p[2][4];
        asm volatile("ds_read_b64 %0, %8\n\tds_read_b64 %1, %8 offset:512\n\tds_read_b64 %2, %8 offset:1024\n\tds_read_b64 %3, %8 offset:1536\n\t"
                     "ds_read_b64 %4, %8 offset:4096\n\tds_read_b64 %5, %8 offset:4608\n\tds_read_b64 %6, %8 offset:5120\n\tds_read_b64 %7, %8 offset:5632\n\t"
                     "s_waitcnt lgkmcnt(0)"
                     : "=&v"(p[0][0]), "=&v"(p[0][1]), "=&v"(p[0][2]), "=&v"(p[0][3]), "=&v"(p[1][0]), "=&v"(p[1][1]), "=&v"(p[1][2]), "=&v"(p[1][3])
                     : "v"(la) : "memory");
#pragma unroll
        for (int ai = 0; ai < 2; ++ai)
#pragma unroll
            for (int m = 0; m < 4; ++m) { float sq = p[ai][m][0] + p[ai][m][1]; sq = xsum32(xsum16(sq)); const float r = __builtin_amdgcn_rsqf(sq * (1.0f / 512.0f) + 1e-6f);
#pragma unroll
                for (int bj = 0; bj < 2; ++bj)
#pragma unroll
                    for (int n = 0; n < 2; ++n) acc[ai][bj][m][n] *= r; }
    }
};
template <class Epi, class Sched, bool ALIGN_EPI = false, bool SP2 = false>
__device__ __forceinline__ void gemm_phase(PG8_LAS unsigned char* lds, const Gemm g, const Sched& S, const Epi& E) {
    int tid_ = threadIdx.x; asm volatile("" : "+v"(tid_)); const int tid = tid_, wid = __builtin_amdgcn_readfirstlane(tid >> 6), lane = tid & 63, wr = wid >> 2, wc = wid & 3, fr = lane & 15, fq = lane >> 4;
    const int K = g.K, nt = K / BK;
    unsigned voffA[2], voffB[2];
#pragma unroll
    for (int i = 0; i < 2; ++i) { int R, C; stage_rc(tid * 16 + i * 8192, R, C); const int Rb = Epi::PERM ? ((R & ~31) + perm32(R & 31)) : R;
        voffA[i] = (unsigned)tl_off(R, C, K); voffB[i] = (unsigned)tl_off(Rb, C, K); }
    const size_t kstep = (size_t)2048;
    const size_t hstep = (size_t)HALF * K * 2;
    const size_t tstep = 2 * hstep;
    const unsigned ldsw = (unsigned)wid * 1024u;
    const int aoff = lds_byte(wr * 64 + fr, fq * 8), boff = lds_byte(wc * 32 + fr, fq * 8);
#define PG8_SA(b, h) (((b) * 2 + (h)) * HTB)
#define PG8_SB(b, h) ((4 + (b) * 2 + (h)) * HTB)
#define PG8_STAGE(bufoff, gbase, voff) do { _Pragma("unroll") for (int _i = 0; _i < 2; ++_i) \
        __builtin_amdgcn_global_load_lds((const unsigned*)((const char*)(gbase) + (voff)[_i]), (PG8_LAS unsigned*)(lds + (bufoff) + ldsw + _i * 8192), 16, 0, 0); } while (0)
#define PG8_LDA(dst, b, h) do { _Pragma("unroll") for (int m = 0; m < 4; ++m) _Pragma("unroll") for (int k = 0; k < 2; ++k) dst[m][k] = *(const PG8_LAS bf16x8*)(lds + PG8_SA(b, h) + aoff + m * 2048 + k * 1024); } while (0)
#define PG8_LDB(dst, b, h) do { _Pragma("unroll") for (int n = 0; n < 2; ++n) _Pragma("unroll") for (int k = 0; k < 2; ++k) dst[n][k] = *(const PG8_LAS bf16x8*)(lds + PG8_SB(b, h) + boff + n * 2048 + k * 1024); } while (0)
#define PG8_MMA(ai, bj, At, Bt) do { __builtin_amdgcn_s_setprio(1); _Pragma("unroll") for (int m = 0; m < 4; ++m) _Pragma("unroll") for (int n = 0; n < 2; ++n) _Pragma("unroll") for (int k = 0; k < 2; ++k) \
        acc[ai][bj][m][n] = __builtin_amdgcn_mfma_f32_16x16x32_bf16(Bt[n][k], At[m][k], acc[ai][bj][m][n], 0, 0, 0); __builtin_amdgcn_s_setprio(0); } while (0)
#define PG8_WAIT_V(n) asm volatile("s_waitcnt vmcnt(" #n ")" ::: "memory")
#define PG8_WAIT_L(n) asm volatile("s_waitcnt lgkmcnt(" #n ")" ::: "memory")
#define PG8_BAR __builtin_amdgcn_s_barrier()
#define PG8_SCHED __builtin_amdgcn_sched_barrier(0)
    Unit cur, nxt; int ui = 0;
    if (!S.next(0, cur)) return;
    f32x4 acc[2][2][4][2];
#pragma unroll
    for (int a = 0; a < 2; ++a)
#pragma unroll
        for (int b = 0; b < 2; ++b)
#pragma unroll
            for (int m = 0; m < 4; ++m)
#pragma unroll
                for (int n = 0; n < 2; ++n) acc[a][b][m][n] = (f32x4){0.f, 0.f, 0.f, 0.f};
    bf16x8 At[4][2], B0[2][2], B1[2][2];
    const char* cA = (const char*)g.A + (size_t)cur.pm * tstep; const char* cB = (const char*)g.Bt + (size_t)cur.pn * tstep;
    S.a_ready(cur);
    if constexpr (Epi::PREFETCH) E.prefetch(cur, lds + STAGE_BYTES, wid, lane);
    if constexpr (SP2) {
        PG8_STAGE(PG8_SB(0, 0), cB, voffB); PG8_STAGE(PG8_SB(0, 1), cB + hstep, voffB); PG8_STAGE(PG8_SA(0, 0), cA, voffA); PG8_STAGE(PG8_SA(0, 1), cA + hstep, voffA);
        if (wr == 1) PG8_BAR;
        PG8_WAIT_V(2); PG8_BAR;
        PG8_STAGE(PG8_SB(1, 0), cB + kstep, voffB); PG8_STAGE(PG8_SA(1, 0), cA + kstep, voffA); PG8_STAGE(PG8_SB(1, 1), cB + hstep + kstep, voffB);
        PG8_WAIT_V(6); PG8_BAR;
    } else {
        PG8_STAGE(PG8_SB(0, 0), cB, voffB); PG8_STAGE(PG8_SA(0, 0), cA, voffA); PG8_STAGE(PG8_SB(0, 1), cB + hstep, voffB); PG8_STAGE(PG8_SA(0, 1), cA + hstep, voffA);
        if (wr == 1) PG8_BAR;
        PG8_WAIT_V(4); PG8_BAR;
        PG8_STAGE(PG8_SB(1, 0), cB + kstep, voffB); PG8_STAGE(PG8_SA(1, 0), cA + kstep, voffA); PG8_STAGE(PG8_SB(1, 1), cB + hstep + kstep, voffB);
        PG8_WAIT_V(6); PG8_BAR;
    }
    long ksc = (long)kstep;
    for (;;) {
        const bool has_next = S.next(ui + 1, nxt);
        const bool nrev = Epi::KSERP && has_next && (((ui + 1) & 1) != 0);
        const long ksn = has_next ? (nrev ? -(long)kstep : (long)kstep) : ksc;
        const size_t nofs = nrev ? (size_t)(nt - 1) * kstep : (size_t)0;
        const char* nA = has_next ? (const char*)g.A + (size_t)nxt.pm * tstep + nofs : cA; const char* nB = has_next ? (const char*)g.Bt + (size_t)nxt.pn * tstep + nofs : cB;
        for (int t = 0; t < nt; t += 2) {
            if constexpr (Epi::PREFETCH) { if (t == 2 && ui > 0) E.prefetch(cur, lds + STAGE_BYTES, wid, lane); }
            if constexpr (Epi::MIDSCALE) { if (t == Epi::MID_T) E.midscale(acc, wr, fr, fq, lds + STAGE_BYTES); }
            const bool last = (t == nt - 2);
            const char* a1 = cA + (long)(t + 1) * ksc;
            const char* a2 = last ? nA : cA + (long)(t + 2) * ksc; const char* b2 = last ? nB : cB + (long)(t + 2) * ksc;
            const long ks3 = last ? ksn : ksc;
            const char* a3 = a2 + ks3; const char* b3 = b2 + ks3;
            if (last && has_next) S.a_ready(nxt);
            if constexpr (SP2) {
            PG8_LDB(B0, 0, 0); PG8_LDB(B1, 0, 1); PG8_SCHED; PG8_LDA(At, 0, 0); PG8_STAGE(PG8_SA(1, 1), a1 + hstep, voffA);
            PG8_WAIT_V(8); PG8_WAIT_L(0); PG8_BAR; PG8_MMA(0, 0, At, B0); PG8_MMA(0, 1, At, B1); PG8_BAR; PG8_SCHED;
            PG8_LDA(At, 0, 1); PG8_STAGE(PG8_SB(0, 0), b2, voffB); PG8_STAGE(PG8_SB(0, 1), b2 + hstep, voffB); PG8_STAGE(PG8_SA(0, 0), a2, voffA);
            PG8_WAIT_V(8); PG8_WAIT_L(0); PG8_BAR; PG8_MMA(1, 0, At, B0); PG8_MMA(1, 1, At, B1); PG8_BAR; PG8_SCHED;
            PG8_LDB(B0, 1, 0); PG8_LDB(B1, 1, 1); PG8_SCHED; PG8_LDA(At, 1, 0); PG8_STAGE(PG8_SA(0, 1), a2 + hstep, voffA);
            PG8_WAIT_V(8); PG8_WAIT_L(0); PG8_BAR; PG8_MMA(0, 0, At, B0); PG8_MMA(0, 1, At, B1); PG8_BAR; PG8_SCHED;
            PG8_LDA(At, 1, 1); PG8_STAGE(PG8_SB(1, 0), b3, voffB); PG8_STAGE(PG8_SB(1, 1), b3 + hstep, voffB); PG8_STAGE(PG8_SA(1, 0), a3, voffA);
            PG8_WAIT_V(8); PG8_WAIT_L(0); PG8_BAR; PG8_MMA(1, 0, At, B0); PG8_MMA(1, 1, At, B1); PG8_BAR; PG8_SCHED;
            } else {
            PG8_LDB(B0, 0, 0); PG8_SCHED; PG8_LDA(At, 0, 0); PG8_STAGE(PG8_SA(1, 1), a1 + hstep, voffA);
            PG8_WAIT_L(8); PG8_BAR; PG8_WAIT_L(0); PG8_MMA(0, 0, At, B0); PG8_BAR; PG8_SCHED;
            PG8_LDB(B1, 0, 1); PG8_STAGE(PG8_SB(0, 0), b2, voffB);
            PG8_BAR; PG8_WAIT_L(0); PG8_MMA(0, 1, At, B1); PG8_BAR;
            PG8_LDA(At, 0, 1); PG8_STAGE(PG8_SA(0, 0), a2, voffA);
            PG8_BAR; PG8_WAIT_L(0); PG8_MMA(1, 0, At, B0); PG8_BAR; PG8_SCHED;
            PG8_STAGE(PG8_SB(0, 1), b2 + hstep, voffB);
            PG8_WAIT_V(6); PG8_BAR; PG8_MMA(1, 1, At, B1); PG8_BAR;
            PG8_LDB(B0, 1, 0); PG8_SCHED; PG8_LDA(At, 1, 0); PG8_STAGE(PG8_SA(0, 1), a2 + hstep, voffA);
            PG8_WAIT_L(8); PG8_BAR; PG8_WAIT_L(0); PG8_MMA(0, 0, At, B0); PG8_BAR; PG8_SCHED;
            PG8_LDB(B1, 1, 1); PG8_STAGE(PG8_SB(1, 0), b3, voffB);
            PG8_BAR; PG8_WAIT_L(0); PG8_MMA(0, 1, At, B1); PG8_BAR;
            PG8_LDA(At, 1, 1); PG8_STAGE(PG8_SA(1, 0), a3, voffA);
            PG8_BAR; PG8_WAIT_L(0); PG8_MMA(1, 0, At, B0); PG8_BAR; PG8_SCHED;
            PG8_STAGE(PG8_SB(1, 1), b3 + hstep, voffB);
            PG8_WAIT_V(6); PG8_BAR; PG8_MMA(1, 1, At, B1); PG8_BAR;
            }
        }
        if constexpr (ALIGN_EPI) { if (wr == 0) PG8_BAR; }
        if constexpr (!Epi::AFTER_DRAIN) { E(acc, cur, wr, wc, fr, fq, lds + STAGE_BYTES); S.done(cur); }
        if (!has_next) break;
        cur = nxt; cA = nA; cB = nB; ksc = ksn; ++ui;
        if constexpr (ALIGN_EPI) { if (wr == 1) PG8_BAR; }
    }
    PG8_WAIT_V(0);
    if constexpr (!ALIGN_EPI) { if (wr == 0) PG8_BAR; }
    PG8_BAR;
    if constexpr (Epi::AFTER_DRAIN) { E.fused(acc, cur, wr, wc, fr, fq, lds, wid, lane); S.done(cur); }
#undef PG8_SA
#undef PG8_SB
#undef PG8_STAGE
#undef PG8_LDA
#undef PG8_LDB
#undef PG8_MMA
#undef PG8_WAIT_V
#undef PG8_WAIT_L
#undef PG8_BAR
#undef PG8_SCHED
}
}
constexpr int NB = 16, SEQ = 2048, M = NB * SEQ, D = 1024, FF = 2816, NFI = 2 * FF, ZW = 3072, NIN = 2840, DEPTH = 4, MODW = 9216;
constexpr int ZKC = 512, ZVC = 640, ZKS = 768, ZVS = 896, ZKW = 1024, ZVW = 1152, ZHC = 1280, ZBG = 1792, ZCG = 2304, ZGT = 2816;
constexpr float EPS = 1e-6f;
constexpr float NEGB = -1e30f;
constexpr float C2 = 0.125f * 1.4426950408889634f;
constexpr float LOG2E = 1.4426950408889634f;

constexpr size_t MiB = 1u << 20;
constexpr size_t WS_CTL = 0, CTL_ZERO_BYTES = 64 * 1024;
constexpr size_t WS_MOD = 1 * MiB;
constexpr size_t WS_CB1 = 4 * MiB;
constexpr size_t WS_KCMP = 5 * MiB;
constexpr size_t WS_VCMP = 5 * MiB + 512 * 1024;
constexpr size_t WS_WC1T = 6 * MiB;
constexpr size_t WS_WMO = 8 * MiB;
constexpr size_t WS_WMI = 16 * MiB;
constexpr size_t WS_WFO = 40 * MiB;
constexpr size_t WS_WFI = 84 * MiB;
constexpr size_t WS_H = 172 * MiB;
constexpr size_t WS_ZB = 236 * MiB;
constexpr size_t WS_OATT = 428 * MiB;
constexpr size_t WS_SBW = 492 * MiB;
constexpr size_t WS_RSQ = 498 * MiB;
constexpr size_t WS_OMIX = 500 * MiB;
constexpr size_t WS_X = 564 * MiB;
constexpr size_t WS_ASQ = 628 * MiB;
constexpr size_t WS_END = 629 * MiB;
constexpr int CW_BAR = 4096;

constexpr int RING_BYTES = 131072;
constexpr int LDS_BYTES = 163840;
constexpr int CTRL_OFF = LDS_BYTES - 1024;
constexpr int MISC_OFF = CTRL_OFF + 320;

#define GAS __attribute__((address_space(1)))
#define LAS __attribute__((address_space(3)))
typedef unsigned short bf16;
typedef float f32x4 __attribute__((ext_vector_type(4)));
typedef float f32x16 __attribute__((ext_vector_type(16)));
typedef short bf16x8 __attribute__((ext_vector_type(8)));
typedef short s16x4 __attribute__((ext_vector_type(4)));
typedef unsigned u32x4 __attribute__((ext_vector_type(4)));
using pg8::u32x2;
typedef GAS unsigned gu32;
#define LBAR() do { asm volatile("s_waitcnt lgkmcnt(0)" ::: "memory"); __builtin_amdgcn_s_barrier(); asm volatile("" ::: "memory"); } while (0)
#define MFMA32(a, b, c) __builtin_amdgcn_mfma_f32_32x32x16_bf16((a), (b), (c), 0, 0, 0)
using pg8::cvt_pk_bf16;
using pg8::silu_f;

#define XB_TMO      128
#define XB_XCNT(j)  (256  + 64 * (j))
#define XB_XSUB(j)  (1280 + 64 * (j))
#define XB_XGEN(j)  (2304 + 64 * (j))
#define XB_TOP      3328
#define XB_TOPGEN   3392
#define XCD_BAR_WORDS 3456
#define XB_SPIN_CAP (1u << 18)

__device__ __forceinline__ unsigned xb_ld(unsigned* p)              { return __hip_atomic_load(p, __ATOMIC_RELAXED, __HIP_MEMORY_SCOPE_AGENT); }
__device__ __forceinline__ unsigned xb_add(unsigned* p, unsigned v) { return __hip_atomic_fetch_add(p, v, __ATOMIC_RELAXED, __HIP_MEMORY_SCOPE_AGENT); }
__device__ __forceinline__ unsigned xb_xcc_id() { return (unsigned)__builtin_amdgcn_s_getreg((3 << 11) | 20) & 0xFu; }
#define XB_SPIN(cond, bar) do { unsigned _sp = 0; while (cond) { __builtin_amdgcn_s_sleep(1); \
    if ((++_sp & 255u) == 0u) { if (xb_ld(&(bar)[XB_TMO])) break; if (_sp > XB_SPIN_CAP) { atomicAdd(&(bar)[XB_TMO], 1u); break; } } } } while (0)

struct XcdBarrier {
    unsigned* bar; unsigned x;
    volatile LAS unsigned* st;
};

__device__ __forceinline__ XcdBarrier xcd_barrier_post(unsigned* bar, volatile LAS unsigned* st) {
    XcdBarrier b; b.bar = bar; b.x = (unsigned)__builtin_amdgcn_readfirstlane((int)xb_xcc_id()); b.st = st;
    if (threadIdx.x == 0) (void)xb_add(&bar[XB_XCNT(b.x)], 1u);
    return b;
}
__device__ __forceinline__ void xcd_barrier_complete(unsigned* bar, unsigned x, unsigned& nloc, unsigned& nx) {
    const unsigned G = gridDim.x * gridDim.y * gridDim.z;
    unsigned sum, cnt, mine, sp = 0u;
    for (;;) {
        sum = 0u; cnt = 0u; mine = 0u;
#pragma unroll
        for (unsigned j = 0; j < 16; ++j) { const unsigned c = xb_ld(&bar[XB_XCNT(j)]); sum += c; cnt += (c > 0u) ? 1u : 0u; mine = (j == x) ? c : mine; }
        if (sum == G) break;
        __builtin_amdgcn_s_sleep(1);
        if ((++sp & 255u) == 0u) { if (xb_ld(&bar[XB_TMO])) break; if (sp > XB_SPIN_CAP) { atomicAdd(&bar[XB_TMO], 1u); break; } }
    }
    nloc = mine > 0u ? mine : 1u; nx = cnt > 0u ? cnt : 1u;
}

__device__ __forceinline__ void xcd_barrier(const XcdBarrier& b) {
    asm volatile("s_waitcnt vmcnt(0)" ::: "memory");
    __syncthreads();
    if (threadIdx.x == 0) {
        unsigned* bar = b.bar;
        __builtin_amdgcn_s_waitcnt(0);
        unsigned nloc = b.st[0], nx = b.st[1];
        if (nloc == 0u) { xcd_barrier_complete(bar, b.x, nloc, nx); b.st[0] = nloc; b.st[1] = nx; }
        const unsigned old = xb_add(&bar[XB_XSUB(b.x)], 1u);
        const unsigned gen = old / nloc;
        if (old + 1u == (gen + 1u) * nloc) {
            __builtin_amdgcn_fence(__ATOMIC_RELEASE, "agent");
            asm volatile("s_waitcnt vmcnt(0)" ::: "memory");
            const unsigned og = xb_add(&bar[XB_TOP], 1u);
            const unsigned tg = og / nx;
            if (og + 1u == (tg + 1u) * nx) xb_add(&bar[XB_TOPGEN], 1u);
            else XB_SPIN(xb_ld(&bar[XB_TOPGEN]) == tg, bar);
            __builtin_amdgcn_fence(__ATOMIC_ACQUIRE, "agent");
            xb_add(&bar[XB_XGEN(b.x)], 1u);
            asm volatile("s_waitcnt vmcnt(0)" ::: "memory");
        } else {
            XB_SPIN(xb_ld(&bar[XB_XGEN(b.x)]) == gen, bar);
            __builtin_amdgcn_fence(__ATOMIC_ACQUIRE, "agent");
            asm volatile("s_waitcnt vmcnt(0)" ::: "memory");
        }
    }
    __syncthreads();
}

__device__ __forceinline__ float shx(float v, int mask, int lane) { return __builtin_bit_cast(float, __builtin_amdgcn_ds_bpermute((lane ^ mask) << 2, __builtin_bit_cast(int, v))); }
__device__ __forceinline__ float max32x(float v) { const auto r = __builtin_amdgcn_permlane32_swap(__float_as_uint(v), __float_as_uint(v), false, false); return fmaxf(__uint_as_float(r[0]), __uint_as_float(r[1])); }
__device__ __forceinline__ float sum32x(float v) { const auto r = __builtin_amdgcn_permlane32_swap(__float_as_uint(v), __float_as_uint(v), false, false); return __uint_as_float(r[0]) + __uint_as_float(r[1]); }
template <int CTRL> __device__ __forceinline__ float dpp_f(float v) { return __builtin_bit_cast(float, __builtin_amdgcn_update_dpp(0, __builtin_bit_cast(int, v), CTRL, 0xf, 0xf, true)); }
__device__ __forceinline__ float sum8_dpp(float s) { s += dpp_f<0xB1>(s); s += dpp_f<0x4E>(s); s += dpp_f<0x141>(s); return s; }
__device__ __forceinline__ float sum16x(float v) { const auto r = __builtin_amdgcn_permlane16_swap(__float_as_uint(v), __float_as_uint(v), false, false); return __uint_as_float(r[0]) + __uint_as_float(r[1]); }
__device__ __forceinline__ float sum64_dpp(float s) { s = sum8_dpp(s); s += dpp_f<0x140>(s); s = sum16x(s); return sum32x(s); }
__device__ __forceinline__ float wave_sum(float v, int lane) { (void)lane; return sum64_dpp(v); }
__device__ __forceinline__ const bf16* zt(const bf16* zb, int row, int col) { return (const bf16*)((const char*)zb + pg8::tl_off(row, col, ZW)); }
__device__ __forceinline__ float bf2f(unsigned short h) { return __uint_as_float((unsigned)h << 16); }
__device__ __forceinline__ float bflo(unsigned w) { return __uint_as_float(w << 16); }
__device__ __forceinline__ float bfhi(unsigned w) { return __uint_as_float(w & 0xffff0000u); }
__device__ __forceinline__ float sigmoid_f(float x) { return __builtin_amdgcn_rcpf(1.0f + __builtin_amdgcn_exp2f(-LOG2E * x)); }
__device__ __forceinline__ int crow(int r, int hi) { return (r & 3) + 8 * (r >> 2) + 4 * hi; }

__device__ __forceinline__ int dst_row(int mode, int n) {
    if (mode == 1) { return n < FF ? (n >> 7) * 256 + (n & 127) : ((n - FF) >> 7) * 256 + 128 + ((n - FF) & 127); }
    if (mode == 2) { return n < 1280 ? n : (n < 1304 ? ZGT + (n - 1280) : n - 24); }
    return n;
}
__device__ __forceinline__ void transpose_item(const float* W, int K, int N, bf16* WT, LAS float* scr, int item, int lane, int mode, bool tiled = true) {
    const int nblk = (N + 63) >> 6, kb = item / nblk, nb = item - kb * nblk, k0 = 64 * kb, n0 = 64 * nb;
    const int kr = lane >> 4, c4 = (lane & 15) * 4; const bool inb = (n0 + c4) < N;
    const float* src = W + (size_t)(k0 + kr) * N + n0 + c4;
    f32x4 v[16];
#pragma unroll
    for (int i = 0; i < 16; ++i) v[i] = inb ? __builtin_nontemporal_load((const f32x4*)(src + (size_t)(4 * i) * N)) : (f32x4){0.f, 0.f, 0.f, 0.f};
#pragma unroll
    for (int i = 0; i < 16; ++i) { LAS float* d = scr + (4 * i + kr) * 65 + c4; d[0] = v[i].x; d[1] = v[i].y; d[2] = v[i].z; d[3] = v[i].w; }
    asm volatile("s_waitcnt lgkmcnt(0)" ::: "memory");
    const int c = lane & 7, r8 = lane >> 3;
#pragma unroll
    for (int j = 0; j < 8; ++j) { const int nl = r8 + 8 * j; const int n = n0 + nl; const LAS float* q = scr + (8 * c) * 65 + nl;
        u32x4 o; o.x = cvt_pk_bf16(q[0 * 65], q[1 * 65]); o.y = cvt_pk_bf16(q[2 * 65], q[3 * 65]); o.z = cvt_pk_bf16(q[4 * 65], q[5 * 65]); o.w = cvt_pk_bf16(q[6 * 65], q[7 * 65]);
        if (n < N) { if (tiled) *(u32x4*)((char*)WT + pg8::tl_off(dst_row(mode, n), k0 + 8 * c, K)) = o; else *(u32x4*)(WT + (size_t)dst_row(mode, n) * K + k0 + 8 * c) = o; } }
    asm volatile("s_waitcnt lgkmcnt(0)" ::: "memory");
}

struct Args { const float* in[16]; float* out; unsigned char* ws; };
typedef __attribute__((address_space(4))) const Args* ArgsP;
__device__ __forceinline__ ArgsP get_args() { unsigned long long p = (unsigned long long)__builtin_amdgcn_kernarg_segment_ptr(); asm volatile("" : "+s"(p)); return (ArgsP)p; }
struct Ctx { LAS unsigned char* L; int vcu, G, bx; };
__device__ __forceinline__ Ctx launder(const Ctx& c) { Ctx r; unsigned lb = (unsigned)(size_t)c.L; int v = c.vcu, g = c.G, bx = c.bx; asm volatile("" : "+s"(lb), "+s"(v), "+s"(g), "+s"(bx)); r.L = (LAS unsigned char*)(size_t)lb; r.vcu = v; r.G = g; r.bx = bx; return r; }
#define PHASE_IDS() int tid_ = threadIdx.x; asm volatile("" : "+v"(tid_)); const int tid = tid_; const int lane = tid & 63; const int wave = __builtin_amdgcn_readfirstlane(tid >> 6); (void)lane; (void)wave

__device__ __forceinline__ void prologue(const Ctx& C0) {
    PHASE_IDS(); const ArgsP A = get_args(); const Ctx C = launder(C0);
    {
        LAS float* scr = (LAS float*)(C.L + wave * 16640);
        const int gw = C.vcu * 8 + wave, NGW = C.G * 8;
        constexpr int I_FI = 16 * 88, I_FO = 44 * 16, I_MI = 16 * 45, I_MO = 16 * 16, I_C1 = 32 * 1;
        constexpr int N_FI = 8 * I_FI, N_FO = 8 * I_FO, N_MI = 4 * I_MI, N_MO = 4 * I_MO, N_C1 = 8 * I_C1;
        constexpr int NITEMS = N_FI + N_FO + N_MI + N_MO + N_C1;
        for (int it = gw; it < NITEMS; it += NGW) {
            int r = it;
            if (r < N_FI) { const int q = r / I_FI; transpose_item(A->in[5] + (size_t)q * D * NFI, D, NFI, (bf16*)(A->ws + WS_WFI) + (size_t)q * NFI * D, scr, r - q * I_FI, lane, 1); continue; } r -= N_FI;
            if (r < N_FO) { const int q = r / I_FO; transpose_item(A->in[6] + (size_t)q * FF * D, FF, D, (bf16*)(A->ws + WS_WFO) + (size_t)q * D * FF, scr, r - q * I_FO, lane, 0); continue; } r -= N_FO;
            if (r < N_MI) { const int q = r / I_MI; transpose_item(A->in[7] + (size_t)q * D * NIN, D, NIN, (bf16*)(A->ws + WS_WMI) + (size_t)q * ZW * D, scr, r - q * I_MI, lane, 2); continue; } r -= N_MI;
            if (r < N_MO) { const int q = r / I_MO; transpose_item(A->in[14] + (size_t)q * D * D, D, D, (bf16*)(A->ws + WS_WMO) + (size_t)q * D * D, scr, r - q * I_MO, lane, 0); continue; } r -= N_MO;
            { const int q = r / I_C1; transpose_item(A->in[9] + (size_t)q * 2048 * 64, 2048, 64, (bf16*)(A->ws + WS_WC1T) + (size_t)q * 64 * 2048, scr, r - q * I_C1, lane, 0, false); }
        }
        const int gt = C.vcu * 512 + tid, NGT = C.G * 512;
        for (int i = gt; i < 4 * 232 * 128; i += NGT) { const int l = i / (232 * 128), rr = i - l * (232 * 128); const int row = NIN + rr / 128, ch = rr & 127;
            *(u32x4*)((char*)((bf16*)(A->ws + WS_WMI) + (size_t)l * ZW * D) + pg8::tl_off(row, ch * 8, D)) = (u32x4){0u, 0u, 0u, 0u}; }
    }
    __syncthreads();
    {
        LAS float* cact = (LAS float*)C.L;
        LAS float* red = (LAS float*)(C.L + 65536);
        for (int i = tid; i < NB * D; i += 512) cact[i] = silu_f(A->in[1][i]);
        __syncthreads();
        const int cj = tid & 63, ks = tid >> 6;
        float* mod = (float*)(A->ws + WS_MOD);
        {
            const int c4 = (lane & 7) * 4, kk = lane >> 3;
            for (int item = C.vcu; item < DEPTH * (MODW / 32); item += C.G) {
                const int l = item / (MODW / 32), jb = item - l * (MODW / 32);
                const float* w = A->in[2] + (size_t)l * D * MODW + (size_t)(ks * 128 + kk) * MODW + jb * 32 + c4;
                f32x4 wv[16];
#pragma unroll
                for (int i = 0; i < 16; ++i) wv[i] = __builtin_nontemporal_load((const f32x4*)(w + (size_t)(8 * i) * MODW));
                f32x4 acc[16];
#pragma unroll
                for (int b = 0; b < 16; ++b) acc[b] = (f32x4){0.f, 0.f, 0.f, 0.f};
#pragma unroll
                for (int i = 0; i < 16; ++i) { const LAS float* cp = cact + ks * 128 + 8 * i + kk;
#pragma unroll
                    for (int b = 0; b < 16; ++b) acc[b] += wv[i] * cp[b * D]; }
#pragma unroll
                for (int b = 0; b < 16; ++b)
#pragma unroll
                    for (int e = 0; e < 4; ++e) { float s = acc[b][e]; s += dpp_f<0x128>(s); s = sum16x(s); acc[b][e] = sum32x(s); }
                if (kk == 0) {
#pragma unroll
                    for (int b = 0; b < 16; ++b) *(LAS f32x4*)(red + (ks * 16 + b) * 32 + c4) = acc[b]; }
                __syncthreads();
                { const int b = tid >> 5, c = tid & 31; float s = A->in[3][l * MODW + jb * 32 + c];
#pragma unroll
                  for (int q = 0; q < 8; ++q) s += red[(q * 16 + b) * 32 + c];
                  mod[((size_t)l * NB + b) * MODW + jb * 32 + c] = s; }
                __syncthreads();
            }
        }
        for (int item = C.vcu; item < 8; item += C.G) {
            const float* pos = A->in[8] + (size_t)item * 2048; const float* w1 = A->in[9] + (size_t)item * 2048 * 64;
            float s = 0.f;
            for (int k = ks * 256; k < ks * 256 + 256; ++k) s += pos[k] * w1[(size_t)k * 64 + cj];
            red[ks * 64 + cj] = s;
            __syncthreads();
            if (tid < 64) { float t = 0.f;
#pragma unroll
                for (int q = 0; q < 8; ++q) t += red[q * 64 + tid];
                ((float*)(A->ws + WS_CB1))[item * 64 + tid] = t; }
            __syncthreads();
        }
    }
}

typedef float f32x4v __attribute__((ext_vector_type(4)));
__device__ __forceinline__ void prologue2(const Ctx& C0) {
    PHASE_IDS(); const ArgsP A = get_args(); const Ctx C = launder(C0);
    const int gw = C.vcu * 8 + wave, NGW = C.G * 8;
    {
        const float* mod = (const float*)(A->ws + WS_MOD); float* sbw = (float*)(A->ws + WS_SBW);
        constexpr int T_FF = NFI / 16, T_MI = ZW / 16, T_L = 2 * T_FF + T_MI;
        const int bi = lane & 15, kq = lane >> 4;
        for (int it = gw; it < DEPTH * T_L; it += NGW) {
            const int l = it / T_L; int r = it - l * T_L; int sub, t; const bf16* Bt;
            if (r < T_FF) { sub = 0; t = r; Bt = (const bf16*)(A->ws + WS_WFI) + (size_t)(l * 2) * NFI * D; }
            else if (r < T_FF + T_MI) { sub = 1; t = r - T_FF; Bt = (const bf16*)(A->ws + WS_WMI) + (size_t)l * ZW * D; }
            else { sub = 2; t = r - T_FF - T_MI; Bt = (const bf16*)(A->ws + WS_WFI) + (size_t)(l * 2 + 1) * NFI * D; }
            const float* sh = mod + ((size_t)l * NB + bi) * MODW + sub * 3072 + 8 * kq;
            const char* bp = (const char*)Bt + pg8::tl_off(16 * t + bi, 8 * kq, D);
            f32x4v acc = {0.f, 0.f, 0.f, 0.f};
#pragma unroll 8
            for (int s = 0; s < 32; ++s) { const f32x4 a0 = *(const f32x4*)(sh + 32 * s), a1 = *(const f32x4*)(sh + 32 * s + 4);
                const u32x4 aw = {cvt_pk_bf16(a0.x, a0.y), cvt_pk_bf16(a0.z, a0.w), cvt_pk_bf16(a1.x, a1.y), cvt_pk_bf16(a1.z, a1.w)};
                const bf16x8 bv = *(const bf16x8*)(bp + 1024 * s);
                acc = __builtin_amdgcn_mfma_f32_16x16x32_bf16(__builtin_bit_cast(bf16x8, aw), bv, acc, 0, 0, 0); }
            float* op = sbw + ((size_t)(3 * l + sub) * NB + 4 * kq) * NFI + 16 * t + bi;
#pragma unroll
            for (int e = 0; e < 4; ++e) op[(size_t)e * NFI] = acc[e];
        }
    }
    {
        const float* xin = A->in[0]; bf16* hs = (bf16*)(A->ws + WS_H); float* rowsq = (float*)(A->ws + WS_RSQ); unsigned* x16 = (unsigned*)(A->ws + WS_X);
        const float* g = A->in[4]; const float* mod = (const float*)(A->ws + WS_MOD);
        const int rr = lane >> 2, ch = lane & 3;
        for (int rb = gw; rb < M / 16; rb += NGW) {
            const int row = 16 * rb + rr, b = row >> 11;
            const float* sc = mod + (size_t)b * MODW + D; const float* xr = xin + (size_t)row * D;
            float s = 0.f;
#pragma unroll 4
            for (int cb = 0; cb < 32; ++cb) { const int c = 32 * cb + 8 * ch;
                const f32x4 v0 = __builtin_nontemporal_load((const f32x4*)(xr + c)), v1 = __builtin_nontemporal_load((const f32x4*)(xr + c + 4));
                s += ((v0.x * v0.x + v0.y * v0.y) + (v0.z * v0.z + v0.w * v0.w)) + ((v1.x * v1.x + v1.y * v1.y) + (v1.z * v1.z + v1.w * v1.w));
                const f32x4 y0 = v0 * *(const f32x4*)(g + c) * (*(const f32x4*)(sc + c) + 1.0f), y1 = v1 * *(const f32x4*)(g + c + 4) * (*(const f32x4*)(sc + c + 4) + 1.0f);
                const u32x4 o = {cvt_pk_bf16(y0.x, y0.y), cvt_pk_bf16(y0.z, y0.w), cvt_pk_bf16(y1.x, y1.y), cvt_pk_bf16(y1.z, y1.w)};
                *(u32x4*)((char*)hs + pg8::tl_off(row, c, D)) = o;
                const u32x4 xw = {pg8::cvt_pk_f16(v0.x, v0.y), pg8::cvt_pk_f16(v0.z, v0.w), pg8::cvt_pk_f16(v1.x, v1.y), pg8::cvt_pk_f16(v1.z, v1.w)};
                *(u32x4*)((char*)x16 + pg8::tl_off(row, c, D)) = xw; }
            s += dpp_f<0xB1>(s); s += dpp_f<0x4E>(s);
            rowsq[(size_t)ch * M + row] = ch == 0 ? s : 0.f;
        }
    }
}
__device__ __forceinline__ void finalnorm_phase(const Ctx& C0) {
    PHASE_IDS(); const ArgsP A = get_args(); const Ctx C = launder(C0);
    const unsigned char* x16 = A->ws + WS_X; float* out = A->out; const float* g = A->in[15]; const float* rowsq = (const float*)(A->ws + WS_RSQ);
    const int gw = C.vcu * 8 + wave, NGW = C.G * 8;
    const int rr = lane >> 2, ch = lane & 3;
    for (int rb = gw; rb < M / 16; rb += NGW) {
        const int row = 16 * rb + rr;
        float s = rowsq[(size_t)ch * M + row];
        s += dpp_f<0xB1>(s); s += dpp_f<0x4E>(s);
        const float rstd = __builtin_amdgcn_rsqf(s * (1.0f / D) + EPS);
        float* orow = out + (size_t)row * D;
#pragma unroll 8
        for (int cb = 0; cb < 32; ++cb) { const int c = 32 * cb + 8 * ch;
            const u32x4 p = *(const u32x4*)(x16 + pg8::tl_off(row, c, D));
            const f32x4 v0 = pg8::unpack_f16x4((u32x2){p.x, p.y}), v1 = pg8::unpack_f16x4((u32x2){p.z, p.w});
            *(f32x4*)(orow + c) = v0 * rstd * *(const f32x4*)(g + c); *(f32x4*)(orow + c + 4) = v1 * rstd * *(const f32x4*)(g + c + 4); }
    }
}
__device__ __forceinline__ void unpack8(const u32x4 w, float (&f)[8]) {
    f[0] = bflo(w.x); f[1] = bfhi(w.x); f[2] = bflo(w.y); f[3] = bfhi(w.y); f[4] = bflo(w.z); f[5] = bfhi(w.z); f[6] = bflo(w.w); f[7] = bfhi(w.w);
}
__device__ __forceinline__ void postmix_phase(const Ctx& C0, int l) {
    PHASE_IDS(); const ArgsP A = get_args(); const Ctx C = launder(C0);
    const float* oatt = (const float*)(A->ws + WS_OATT); const bf16* z = (const bf16*)(A->ws + WS_ZB); bf16* omix = (bf16*)(A->ws + WS_OMIX);
    const float* conv_w = A->in[11] + (size_t)l * 3 * 512; const float* conv_b = A->in[12] + (size_t)l * 512; const float* gout = A->in[13] + (size_t)l * D;
    const int gw = C.vcu * 8 + wave, NGW = C.G * 8; const int c8 = lane * 8;
    float w0[8], w1[8], w2[8], cb[8], ga[8], gc[8];
#pragma unroll
    for (int e = 0; e < 8; ++e) { w0[e] = conv_w[c8 + e]; w1[e] = conv_w[512 + c8 + e]; w2[e] = conv_w[1024 + c8 + e]; cb[e] = conv_b[c8 + e]; ga[e] = gout[c8 + e]; gc[e] = gout[512 + c8 + e]; }
    for (int ch = gw; ch < M / 16; ch += NGW) {
        const int row0 = ch * 16; const int s0 = row0 & (SEQ - 1);
        float um2[8], um1[8];
        if (s0 == 0) {
#pragma unroll
            for (int e = 0; e < 8; ++e) { um2[e] = 0.f; um1[e] = 0.f; }
        } else {
            float a[8], b[8];
            unpack8(*(const u32x4*)(z + (size_t)(row0 - 2) * ZW + ZHC + c8), a); unpack8(*(const u32x4*)(z + (size_t)(row0 - 2) * ZW + ZCG + c8), b);
#pragma unroll
            for (int e = 0; e < 8; ++e) um2[e] = a[e] * b[e];
            unpack8(*(const u32x4*)(z + (size_t)(row0 - 1) * ZW + ZHC + c8), a); unpack8(*(const u32x4*)(z + (size_t)(row0 - 1) * ZW + ZCG + c8), b);
#pragma unroll
            for (int e = 0; e < 8; ++e) um1[e] = a[e] * b[e];
        }
        f32x4 na0 = *(const f32x4*)(oatt + (size_t)row0 * 512 + c8), na1 = *(const f32x4*)(oatt + (size_t)row0 * 512 + c8 + 4);
        u32x4 nhc = *(const u32x4*)(z + (size_t)row0 * ZW + ZHC + c8), nbg = *(const u32x4*)(z + (size_t)row0 * ZW + ZBG + c8), ncg = *(const u32x4*)(z + (size_t)row0 * ZW + ZCG + c8);
        for (int i = 0; i < 16; ++i) {
            const size_t row = (size_t)(row0 + i);
            const f32x4 a0 = na0, a1 = na1; const u32x4 whc = nhc, wbg = nbg, wcg = ncg;
            { const size_t rn = (size_t)(row0 + (i < 15 ? i + 1 : 15));
              na0 = *(const f32x4*)(oatt + rn * 512 + c8); na1 = *(const f32x4*)(oatt + rn * 512 + c8 + 4);
              nhc = *(const u32x4*)(z + rn * ZW + ZHC + c8); nbg = *(const u32x4*)(z + rn * ZW + ZBG + c8); ncg = *(const u32x4*)(z + rn * ZW + ZCG + c8); }
            float ss = (a0.x * a0.x + a0.y * a0.y) + (a0.z * a0.z + a0.w * a0.w) + (a1.x * a1.x + a1.y * a1.y) + (a1.z * a1.z + a1.w * a1.w);
            float hc[8], bg[8], cg[8], oc[8];
            unpack8(whc, hc); unpack8(wbg, bg); unpack8(wcg, cg);
            float s2 = 0.f;
#pragma unroll
            for (int e = 0; e < 8; ++e) { const float u = cg[e] * hc[e]; const float v = cb[e] + um2[e] * w0[e] + um1[e] * w1[e] + u * w2[e]; oc[e] = bg[e] * v; s2 += oc[e] * oc[e]; um2[e] = um1[e]; um1[e] = u; }
#pragma unroll
            for (int o = 1; o < 64; o <<= 1) { ss += shx(ss, o, lane); s2 += shx(s2, o, lane); }
            const float rs = __builtin_amdgcn_rsqf(ss * (1.0f / 512.0f) + EPS), rc = __builtin_amdgcn_rsqf(s2 * (1.0f / 512.0f) + EPS);
            u32x4 o;
            o.x = cvt_pk_bf16(a0.x * rs * ga[0], a0.y * rs * ga[1]); o.y = cvt_pk_bf16(a0.z * rs * ga[2], a0.w * rs * ga[3]);
            o.z = cvt_pk_bf16(a1.x * rs * ga[4], a1.y * rs * ga[5]); o.w = cvt_pk_bf16(a1.z * rs * ga[6], a1.w * rs * ga[7]);
            *(u32x4*)(omix + row * D + c8) = o;
            o.x = cvt_pk_bf16(oc[0] * rc * gc[0], oc[1] * rc * gc[1]); o.y = cvt_pk_bf16(oc[2] * rc * gc[2], oc[3] * rc * gc[3]);
            o.z = cvt_pk_bf16(oc[4] * rc * gc[4], oc[5] * rc * gc[5]); o.w = cvt_pk_bf16(oc[6] * rc * gc[6], oc[7] * rc * gc[7]);
            *(u32x4*)(omix + row * D + 512 + c8) = o;
        }
    }
}

__device__ __forceinline__ void compress_phase(const Ctx& C0, int l) {
    PHASE_IDS(); const ArgsP A = get_args(); const Ctx C = launder(C0);
    const bf16* z = (const bf16*)(A->ws + WS_ZB); const bf16* w1T = (const bf16*)(A->ws + WS_WC1T) + (size_t)l * 2 * 64 * 2048; const float* cb1 = (const float*)(A->ws + WS_CB1) + l * 128;
    const float* w2 = A->in[10] + (size_t)l * 2 * 4096; bf16* kcmp = (bf16*)(A->ws + WS_KCMP); bf16* vcmp = (bf16*)(A->ws + WS_VCMP);
    const int wid = wave, r = lane & 31, h = lane >> 5;
    LAS float* part = (LAS float*)C.L;
    LAS float* y1 = (LAS float*)(C.L + 65536);
    for (int task = C.vcu; task < 256; task += C.G) {
        const int nt = task & 3, kv = (task >> 2) & 1, g = (task >> 3) & 1, b = task >> 4;
        const int colb = ZKC + kv * 128 + 64 * g;
        const int tokbase = 16 * (nt * 32 + r);
        const bf16* zb = z + (size_t)b * SEQ * ZW;
        const bf16* wT = w1T + (size_t)kv * 64 * 2048 + (size_t)r * 2048 + 8 * h;
        f32x16 acc0, acc1;
#pragma unroll
        for (int i = 0; i < 16; ++i) { acc0[i] = 0.f; acc1[i] = 0.f; }
#pragma unroll
        for (int ii = 0; ii < 4; ++ii) { const int i = wid * 4 + ii; int tok = tokbase + i; tok = tok > SEQ - 1 ? SEQ - 1 : tok;
            const bf16* b0p = wT + i * 64; const bf16* b1p = b0p + 32 * 2048;
#pragma unroll
            for (int dd = 0; dd < 4; ++dd) { const bf16x8 av = *(const bf16x8*)zt(zb, tok, colb + 8 * h + 16 * dd), b0 = *(const bf16x8*)(b0p + 16 * dd), b1 = *(const bf16x8*)(b1p + 16 * dd);
                acc0 = MFMA32(av, b0, acc0); acc1 = MFMA32(av, b1, acc1); } }
#pragma unroll
        for (int i = 0; i < 16; ++i) { const int nl = crow(i, h); part[(wid * 32 + nl) * 64 + r] = acc0[i]; part[(wid * 32 + nl) * 64 + 32 + r] = acc1[i]; }
        __syncthreads();
        const int nl = tid >> 4, oq = (tid & 15) * 4;
        { f32x4 s = *(const f32x4*)(cb1 + kv * 64 + oq);
#pragma unroll
          for (int w = 0; w < 8; ++w) s += *(const LAS f32x4*)(part + (w * 32 + nl) * 64 + oq);
          f32x4 y; y.x = silu_f(s.x); y.y = silu_f(s.y); y.z = silu_f(s.z); y.w = silu_f(s.w);
          *(LAS f32x4*)(y1 + nl * 64 + oq) = y; }
        __syncthreads();
        { f32x4 acc = {0.f, 0.f, 0.f, 0.f}; const float* w2p = w2 + kv * 4096 + oq;
          for (int o = 0; o < 64; ++o) { const float yv = y1[nl * 64 + o]; acc += *(const f32x4*)(w2p + o * 64) * yv; }
          const int n = nt * 32 + nl; if (n == 127) acc = (f32x4){0.f, 0.f, 0.f, 0.f};
          u32x2 ov; ov.x = cvt_pk_bf16(acc.x, acc.y); ov.y = cvt_pk_bf16(acc.z, acc.w);
          *(u32x2*)((kv ? vcmp : kcmp) + ((size_t)(b * 2 + g) * 128 + n) * 64 + oq) = ov; }
        __syncthreads();
    }
}

constexpr float MFLOOR = -1e20f;
constexpr int AK = 0, AV = 24576, AWS = 57344, AIMP = 59392, ASEL = 93184, AOT = 93440;
static_assert(AOT + 65536 <= CTRL_OFF, "attention LDS map");
typedef short v4i16_t __attribute__((ext_vector_type(4)));
__device__ __forceinline__ s16x4 vtr(const LAS unsigned char* p) { return __builtin_bit_cast(s16x4, __builtin_amdgcn_ds_read_tr16_b64_v4i16((LAS v4i16_t*)p)); }
#define PACKF(X, S) __builtin_bit_cast(bf16x8, (u32x4){cvt_pk_bf16(X[8 * (S)], X[8 * (S) + 1]), cvt_pk_bf16(X[8 * (S) + 2], X[8 * (S) + 3]), cvt_pk_bf16(X[8 * (S) + 4], X[8 * (S) + 5]), cvt_pk_bf16(X[8 * (S) + 6], X[8 * (S) + 7])})
#define PV_STEP(PF, KS) do { const bf16x8 pf_ = (PF); const int vo_ = ((KS) >> 2) * 8192 + ((KS) & 3) * 1024; \
    { const s16x4 lo_ = vtr(vp + vo_), hi_ = vtr(vp + vo_ + 512); const bf16x8 vf_ = {lo_[0], lo_[1], lo_[2], lo_[3], hi_[0], hi_[1], hi_[2], hi_[3]}; o0 = MFMA32(pf_, vf_, o0); } \
    { const s16x4 lo_ = vtr(vp + vo_ + 4096), hi_ = vtr(vp + vo_ + 4608); const bf16x8 vf_ = {lo_[0], lo_[1], lo_[2], lo_[3], hi_[0], hi_[1], hi_[2], hi_[3]}; o1 = MFMA32(pf_, vf_, o1); } } while (0)

constexpr int SLOTB = 8192, RK = 0, RV = 3 * SLOTB;
constexpr float MFL = -1000.0f;
typedef const LAS unsigned char* lcp;
__device__ __forceinline__ void glds16(const void* gsrc, unsigned lds_dst) { unsigned keep;
    asm volatile("s_mov_b32 %0, m0\n\ts_mov_b32 m0, %2\n\ts_nop 0\n\tglobal_load_lds_dwordx4 %1, off\n\ts_mov_b32 m0, %0" : "=&s"(keep) : "v"(gsrc), "s"(lds_dst) : "memory"); }
__device__ __forceinline__ void kload8(bf16x8* kf, lcp kp) {
    kf[0] = *(const LAS bf16x8*)(kp);        kf[1] = *(const LAS bf16x8*)(kp + 512);
    kf[2] = *(const LAS bf16x8*)(kp + 2048); kf[3] = *(const LAS bf16x8*)(kp + 2560);
    kf[4] = *(const LAS bf16x8*)(kp + 4096); kf[5] = *(const LAS bf16x8*)(kp + 4608);
    kf[6] = *(const LAS bf16x8*)(kp + 6144); kf[7] = *(const LAS bf16x8*)(kp + 6656); }
__device__ __forceinline__ void kload2(bf16x8* kf, lcp kp, int j) { kf[2 * j] = *(const LAS bf16x8*)(kp + j * 2048); kf[2 * j + 1] = *(const LAS bf16x8*)(kp + j * 2048 + 512); }
#define SBAR() __builtin_amdgcn_sched_barrier(0)
#define WAIT_BAR(N) asm volatile("s_waitcnt vmcnt(" #N ") lgkmcnt(0)\n\ts_barrier" ::: "memory")
#define MX3(a, b, c) __builtin_fmaxf(__builtin_fmaxf((a), (b)), (c))
__device__ __forceinline__ float rowmax32(const f32x16& C0, const f32x16& C1) {
    float a = MX3(C0[0], C0[1], C1[0]), b = MX3(C0[2], C0[3], C1[1]); a = MX3(a, C1[2], C1[3]);
#pragma unroll
    for (int r = 4; r < 16; r += 4) { a = MX3(a, C0[r], C0[r + 1]); b = MX3(b, C0[r + 2], C0[r + 3]); a = MX3(a, C1[r], C1[r + 1]); b = MX3(b, C1[r + 2], C1[r + 3]); }
    return max32x(__builtin_fmaxf(a, b)); }
__device__ __forceinline__ void attn_issue(LAS unsigned char* L, const bf16* zb, int kcol, int vcol, int jlo, int n, int tid_in, int wid) {
    int tid = tid_in; asm volatile("" : "+v"(tid)); const int lane = tid & 63;
    const unsigned lds0 = (unsigned)(size_t)L;
    const bf16* ksrc = zt(zb, 64 * jlo + lane, kcol + wid * 8);
    const bf16* vsrc = zt(zb, 64 * jlo + 16 * (wid & 3) + (lane >> 2), vcol + (wid >> 2) * 32 + (lane & 3) * 8);
    const unsigned kdst = lds0 + RK + wid * 1024, vdst = lds0 + RV + wid * 1024;
    glds16(ksrc, (unsigned)__builtin_amdgcn_readfirstlane(kdst)); glds16(vsrc, (unsigned)__builtin_amdgcn_readfirstlane(vdst));
    if (n > 1) glds16(ksrc + (size_t)64 * ZW, (unsigned)__builtin_amdgcn_readfirstlane(kdst + SLOTB));
    if (n > 2) glds16(ksrc + (size_t)128 * ZW, (unsigned)__builtin_amdgcn_readfirstlane(kdst + 2 * SLOTB));
    if (n > 1) glds16(vsrc + (size_t)64 * ZW, (unsigned)__builtin_amdgcn_readfirstlane(vdst + SLOTB));
}
template <int MODE, bool PRE = false, int THRL = 8>
__device__ __forceinline__ void attn_branch(LAS unsigned char* L, const bf16* zb, int kcol, int vcol, int jlo, int jhi, int qt, int qrel, unsigned selbits,
                                            const bf16x8 (&qr)[4], f32x16& o0, f32x16& o1, float& lout, int tid_in, int wid) {
    int tid = tid_in; asm volatile("" : "+v"(tid)); const int lane = tid & 63;
    const int r32 = lane & 31, hi = lane >> 5;
    const unsigned lds0 = (unsigned)(size_t)L;
    LAS float* wsf = (LAS float*)(L + AWS) + wid * 64;
    const int n = jhi - jlo + 1;
    const bf16* ksrc = zt(zb, 64 * jlo + lane, kcol + wid * 8);
    const bf16* vsrc = zt(zb, 64 * jlo + 16 * (wid & 3) + (lane >> 2), vcol + (wid >> 2) * 32 + (lane & 3) * 8);
    const unsigned kdst = lds0 + RK + wid * 1024, vdst = lds0 + RV + wid * 1024;
#define DMA_K(t, slot) glds16(ksrc + (size_t)(t) * 64 * ZW, (unsigned)__builtin_amdgcn_readfirstlane(kdst + (slot)))
#define DMA_V(t, slot) glds16(vsrc + (size_t)(t) * 64 * ZW, (unsigned)__builtin_amdgcn_readfirstlane(vdst + (slot)))
    const lcp kp0 = L + RK + hi * 1024 + r32 * 16;
    const lcp vp0 = L + RV + ((lane >> 4) & 1) * 32 + (lane & 3) * 8 + (4 * hi + ((lane & 15) >> 2)) * 64;
    const int clim = qrel - 4 * hi;
    if (!PRE) {
        LBAR();
        DMA_K(0, 0); DMA_V(0, 0); if (n > 1) DMA_K(1, SLOTB); if (n > 2) DMA_K(2, 2 * SLOTB); if (n > 1) DMA_V(1, SLOTB);
    }
    float mhat = 0.f, l_reg = 0.f; f32x16 o[2];
#pragma unroll
    for (int i = 0; i < 16; ++i) { o[0][i] = 0.f; o[1][i] = 0.f; }
    f32x16 negm;
#pragma unroll
    for (int i = 0; i < 16; ++i) negm[i] = 0.f;
    asm volatile("" : "+v"(negm));
    if (n > 2) WAIT_BAR(4); else if (n > 1) WAIT_BAR(3); else WAIT_BAR(1);
    f32x16 pA0, pA1, pB0, pB1;
    bool resc = false;
#define CAUSAL(P0, P1) do { _Pragma("unroll") for (int r = 0; r < 16; ++r) { const int c0 = (r & 3) + 8 * (r >> 2); P0[r] = (c0 <= clim) ? P0[r] : NEGB; P1[r] = (c0 + 32 <= clim) ? P1[r] : NEGB; } } while (0)
    {
        const lcp kb = L + RK + hi * 1024 + r32 * 16;
#pragma unroll
        for (int d0 = 0; d0 < 4; ++d0) { const bf16x8 b0 = *(const LAS bf16x8*)(kb + d0 * 2048), b1 = *(const LAS bf16x8*)(kb + d0 * 2048 + 512);
            if (d0 == 0) { pA0 = MFMA32(b0, qr[0], negm); pA1 = MFMA32(b1, qr[0], negm); } else { pA0 = MFMA32(b0, qr[d0], pA0); pA1 = MFMA32(b1, qr[d0], pA1); } }
        if (MODE == 1 && qt >= 8) {
#pragma unroll
            for (int r = 0; r < 16; ++r) { const int c0 = (r & 3) + 8 * (r >> 2); pA0[r] = (c0 > clim) ? pA0[r] : NEGB; pA1[r] = (c0 + 32 > clim) ? pA1[r] : NEGB; }
        }
        if (n == 1) CAUSAL(pA0, pA1);
        const float rm = rowmax32(pA0, pA1);
        const float dl = __builtin_fmaxf(rm, MFL); mhat = dl;
#pragma unroll
        for (int r = 0; r < 16; ++r) { pA0[r] -= dl; pA1[r] -= dl; }
#pragma unroll
        for (int r = 0; r < 16; ++r) negm[r] = -mhat;
        asm volatile("" : "+v"(negm));
#pragma unroll
        for (int r = 0; r < 16; ++r) { pA0[r] = __builtin_amdgcn_exp2f(pA0[r]); pA1[r] = __builtin_amdgcn_exp2f(pA1[r]); }
    }
    WAIT_BAR(0);
    if (n > 3) DMA_K(3, 0);
    if (n > 2) DMA_V(2, 2 * SLOTB);
    int sl_prev = 0, sl_cur = SLOTB, sl_next = 2 * SLOTB;
#define ROT() do { sl_prev = sl_cur; sl_cur = sl_next; sl_next = (sl_next == 2 * SLOTB) ? 0 : sl_next + SLOTB; } while (0)
    bf16x8 kf[8];
    kload8(kf, kp0 + sl_cur);
    WAIT_BAR(2);
#define RESC() do { if (resc) { asm volatile("s_waitcnt lgkmcnt(0)" ::: "memory"); \
        _Pragma("unroll") for (int d_ = 0; d_ < 2; ++d_) _Pragma("unroll") for (int r = 0; r < 16; ++r) o[d_][r] *= wsf[crow(r, hi)]; } } while (0)
    s16x4 vlo[8], vhi[8]; u32x4 pw0, pw1, pw2, pw3;
#define PKW(P, B) cvt_pk_bf16(P[B], P[B + 1])
#define PAF(k) __builtin_bit_cast(bf16x8, pw##k)
#define VFR(i) (bf16x8){vlo[i][0], vlo[i][1], vlo[i][2], vlo[i][3], vhi[i][0], vhi[i][1], vhi[i][2], vhi[i][3]}
#define PIN(x) asm volatile("" : "+v"(x))
#define GAPA(MF, A0, A1, A2, A3, W0, W1, PW) do { MF; sacc += A0; sacc += A1; sacc += A2; sacc += A3; PIN(sacc); W0; W1; PIN(PW); SBAR(); } while (0)
#define EX(v) __builtin_amdgcn_exp2f(v)
#define GAPB(MF, X, B) do { MF; X[B] = EX(X[B]); X[B + 1] = EX(X[B + 1]); X[B + 2] = EX(X[B + 2]); X[B + 3] = EX(X[B + 3]); PIN(X); SBAR(); } while (0)
#define VRD(i) do { vlo[i] = vtr(vp_ + (((i) >> 2) * 4096 + ((i) & 3) * 1024)); vhi[i] = vtr(vp_ + (((i) >> 2) * 4096 + ((i) & 3) * 1024 + 512)); } while (0)
#define KRD(G, j) do { if (G) { kload2(kf, kp0 + sl_next, j); SBAR(); } } while (0)
#define STEP(C0, C1, P0, P1, t, GK, GV, GL) do { \
    if (MODE == 0) { const float nv_ = ((selbits >> (t)) & 1u) ? -mhat : NEGB; _Pragma("unroll") for (int r = 0; r < 16; ++r) negm[r] = nv_; PIN(negm); } \
    SBAR(); \
    const lcp vp_ = vp0 + ((((t) - 1) & 3) * SLOTB); \
    VRD(0); SBAR(); float sacc = (P0[0] + P0[1]); \
    GAPA(C0 = MFMA32(kf[0], qr[0], negm), P0[2], P0[3], P0[4], P0[5],     pw0[0] = PKW(P0, 0), pw0[1] = PKW(P0, 2), pw0); \
    VRD(4); SBAR(); GAPA(C1 = MFMA32(kf[1], qr[0], negm), P0[6], P0[7], P0[8], P0[9],     pw0[2] = PKW(P0, 4), pw0[3] = PKW(P0, 6), pw0); \
    VRD(1); SBAR(); GAPA(C0 = MFMA32(kf[2], qr[1], C0),   P0[10], P0[11], P0[12], P0[13], pw1[0] = PKW(P0, 8), pw1[1] = PKW(P0, 10), pw1); \
    VRD(5); SBAR(); GAPA(C1 = MFMA32(kf[3], qr[1], C1),   P0[14], P0[15], P1[0], P1[1],   pw1[2] = PKW(P0, 12), pw1[3] = PKW(P0, 14), pw1); \
    VRD(2); SBAR(); GAPA(C0 = MFMA32(kf[4], qr[2], C0),   P1[2], P1[3], P1[4], P1[5],     pw2[0] = PKW(P1, 0), pw2[1] = PKW(P1, 2), pw2); \
    VRD(6); SBAR(); GAPA(C1 = MFMA32(kf[5], qr[2], C1),   P1[6], P1[7], P1[8], P1[9],     pw2[2] = PKW(P1, 4), pw2[3] = PKW(P1, 6), pw2); \
    VRD(3); SBAR(); GAPA(C0 = MFMA32(kf[6], qr[3], C0),   P1[10], P1[11], P1[12], P1[13], pw3[0] = PKW(P1, 8), pw3[1] = PKW(P1, 10), pw3); \
    VRD(7); SBAR(); GAPA(C1 = MFMA32(kf[7], qr[3], C1),   P1[14], P1[15], 0.f, 0.f,       pw3[2] = PKW(P1, 12), pw3[3] = PKW(P1, 14), pw3); \
    l_reg += sacc; \
    if (GK) { DMA_K((t) + 3, sl_cur); } if (GV) { DMA_V((t) + 2, (((t) + 2) & 3) * SLOTB); } \
    if ((t) == n - 1) CAUSAL(C0, C1); \
    { float rm = rowmax32(C0, C1); \
      resc = false; \
      if (__builtin_expect(__any(rm > (float)THRL), 0)) { const float dl = __builtin_fmaxf(rm, 0.f); mhat += dl; \
        _Pragma("unroll") for (int r = 0; r < 16; ++r) { C0[r] -= dl; C1[r] -= dl; } \
        _Pragma("unroll") for (int r = 0; r < 16; ++r) negm[r] = -mhat; asm volatile("" : "+v"(negm)); \
        const float f = __builtin_amdgcn_exp2f(-dl); l_reg *= f; if (hi == 0) wsf[r32] = f; resc = true; } } \
    SBAR(); \
    GAPB(o[0] = MFMA32(PAF(0), VFR(0), o[0]), C0, 0); \
    GAPB(o[1] = MFMA32(PAF(0), VFR(4), o[1]), C0, 4); \
    KRD(GL, 0); GAPB(o[0] = MFMA32(PAF(1), VFR(1), o[0]), C0, 8); \
    KRD(GL, 1); GAPB(o[1] = MFMA32(PAF(1), VFR(5), o[1]), C0, 12); \
    KRD(GL, 2); GAPB(o[0] = MFMA32(PAF(2), VFR(2), o[0]), C1, 0); \
    KRD(GL, 3); GAPB(o[1] = MFMA32(PAF(2), VFR(6), o[1]), C1, 4); \
    GAPB(o[0] = MFMA32(PAF(3), VFR(3), o[0]), C1, 8); \
    GAPB(o[1] = MFMA32(PAF(3), VFR(7), o[1]), C1, 12); \
    } while (0)
#define ENDW(tt) do { if ((tt) + 3 < n) { WAIT_BAR(3); } else if ((tt) + 2 < n) { WAIT_BAR(2); } else if ((tt) + 1 < n) { WAIT_BAR(1); } else { WAIT_BAR(0); } } while (0)
    int t = 1;
    for (; t + 1 < n; t += 2) {
        STEP(pB0, pB1, pA0, pA1, t, (t + 3 < n), (t + 2 < n), (t + 1 < n));         ENDW(t);     RESC(); ROT();
        STEP(pA0, pA1, pB0, pB1, t + 1, (t + 4 < n), (t + 3 < n), (t + 2 < n));     ENDW(t + 1); RESC(); ROT();
    }
    if (t < n) {
        STEP(pB0, pB1, pA0, pA1, t, false, false, false); WAIT_BAR(0); RESC(); ROT();
        pA0 = pB0; pA1 = pB1;
    }
    { float sacc = pA0[0] + pA0[1];
#pragma unroll
      for (int r = 2; r < 16; ++r) sacc += pA0[r];
#pragma unroll
      for (int r = 0; r < 16; ++r) sacc += pA1[r];
      l_reg += sacc;
      pw0 = (u32x4){PKW(pA0, 0), PKW(pA0, 2), PKW(pA0, 4), PKW(pA0, 6)}; pw1 = (u32x4){PKW(pA0, 8), PKW(pA0, 10), PKW(pA0, 12), PKW(pA0, 14)};
      pw2 = (u32x4){PKW(pA1, 0), PKW(pA1, 2), PKW(pA1, 4), PKW(pA1, 6)}; pw3 = (u32x4){PKW(pA1, 8), PKW(pA1, 10), PKW(pA1, 12), PKW(pA1, 14)};
      const lcp vp_ = vp0 + (((n - 1) & 3) * SLOTB);
#pragma unroll
      for (int i = 0; i < 8; ++i) VRD(i);
      o[0] = MFMA32(PAF(0), VFR(0), o[0]); o[1] = MFMA32(PAF(0), VFR(4), o[1]);
      o[0] = MFMA32(PAF(1), VFR(1), o[0]); o[1] = MFMA32(PAF(1), VFR(5), o[1]);
      o[0] = MFMA32(PAF(2), VFR(2), o[0]); o[1] = MFMA32(PAF(2), VFR(6), o[1]);
      o[0] = MFMA32(PAF(3), VFR(3), o[0]); o[1] = MFMA32(PAF(3), VFR(7), o[1]); }
#undef PKW
#undef PAF
#undef VFR
#undef PIN
#undef GAPA
#undef GAPB
#undef EX
#undef VRD
#undef KRD
#undef STEP
#undef ENDW
#undef RESC
#undef ROT
#undef CAUSAL
#undef DMA_K
#undef DMA_V
    o0 = o[0]; o1 = o[1];
    lout = sum32x(l_reg);
}

__device__ __forceinline__ void unit_geom(int U, int& b, int& g, int& qt) { const int v = U & 255, ii = U >> 8, s = v & 7, bgp = v >> 3; b = bgp >> 1; g = bgp & 1; const unsigned w = (s == 0 ? 0x080a0c1cu : s == 1 ? 0x07090b1fu : s == 2 ? 0x030f1617u : s == 3 ? 0x01131419u : s == 4 ? 0x050d1218u : s == 5 ? 0x04061a1bu : s == 6 ? 0x000e151eu : 0x0210111du); qt = (int)((w >> (8 * ii)) & 255u); }
__device__ __forceinline__ void cmp_issue(LAS unsigned char* L, const bf16* kc, const bf16* vc, int tid_in, int wid) {
    int tid = tid_in; asm volatile("" : "+v"(tid)); const int lane = tid & 63;
    const unsigned lds0 = (unsigned)(size_t)L;
    const bf16* ksrc = kc + (size_t)lane * 64 + wid * 8;
    const bf16* vsrc = vc + (size_t)(16 * (wid & 3) + (lane >> 2)) * 64 + (wid >> 2) * 32 + (lane & 3) * 8;
    const unsigned kdst = lds0 + RK + wid * 1024, vdst = lds0 + RV + wid * 1024;
    glds16(ksrc, (unsigned)__builtin_amdgcn_readfirstlane(kdst)); glds16(ksrc + 64 * 64, (unsigned)__builtin_amdgcn_readfirstlane(kdst + SLOTB));
    glds16(vsrc, (unsigned)__builtin_amdgcn_readfirstlane(vdst)); glds16(vsrc + 64 * 64, (unsigned)__builtin_amdgcn_readfirstlane(vdst + SLOTB));
}
__device__ __forceinline__ void attn_phase(const Ctx& C0, int l) {
    PHASE_IDS(); const ArgsP A = get_args(); const Ctx C = launder(C0);
    const bf16* z = (const bf16*)(A->ws + WS_ZB); const bf16* kcmp = (const bf16*)(A->ws + WS_KCMP); const bf16* vcmp = (const bf16*)(A->ws + WS_VCMP); bf16* omix = (bf16*)(A->ws + WS_OMIX); float* asq = (float*)(A->ws + WS_ASQ);
    const float* conv_w = A->in[11] + (size_t)l * 3 * 512; const float* conv_b = A->in[12] + (size_t)l * 512; const float* gout = A->in[13] + (size_t)l * D;
    LAS unsigned char* L = C.L;
    const int wid = wave, hh = wid & 3, th = wid >> 2;
    if (wid >= 4) __builtin_amdgcn_s_setprio(1);
    bf16x8 qn[4]; unsigned short gn0, gn1, gn2;
#define UNIT_FETCH(UU) do { int b_, g_, qt_; unit_geom((UU), b_, g_, qt_); int tf_ = tid_; asm volatile("" : "+v"(tf_)); const int lf_ = tf_ & 63; \
        const bf16* zbq_ = z + (size_t)b_ * SEQ * ZW; const int rq_ = 64 * qt_ + 32 * th + (lf_ & 31); \
        _Pragma("unroll") for (int d0 = 0; d0 < 4; ++d0) qn[d0] = *(const bf16x8*)zt(zbq_, rq_, 64 * (4 * g_ + hh) + 16 * d0 + 8 * (lf_ >> 5)); \
        { const int gc_ = ZGT + 3 * (4 * g_ + hh); gn0 = *zt(zbq_, rq_, gc_); gn1 = *zt(zbq_, rq_, gc_ + 1); gn2 = *zt(zbq_, rq_, gc_ + 2); } \
        cmp_issue(L, kcmp + (size_t)(b_ * 2 + g_) * 128 * 64, vcmp + (size_t)(b_ * 2 + g_) * 128 * 64, tid_, wid); } while (0)
    if (C.vcu < 1024) UNIT_FETCH(C.vcu);
    for (int U = C.vcu; U < 1024; U += C.G) {
        int tid = tid_; asm volatile("" : "+v"(tid)); const int lane = tid & 63, r32 = lane & 31, hi = lane >> 5;
        LAS float* wsf = (LAS float*)(L + AWS) + wid * 64;
        LAS float* imp = (LAS float*)(L + AIMP); LAS unsigned* sel = (LAS unsigned*)(L + ASEL);
        int b, g, qt; unit_geom(U, b, g, qt);
        const int head = 4 * g + hh, qrel = 32 * th + r32, tq = 64 * qt + qrel;
        const bf16* zb = z + (size_t)b * SEQ * ZW;
        bf16x8 qr[4];
#pragma unroll
        for (int d0 = 0; d0 < 4; ++d0) qr[d0] = qn[d0];
        const float sg0 = sigmoid_f(bf2f(gn0)), sg1 = sigmoid_f(bf2f(gn1)), sg2 = sigmoid_f(bf2f(gn2));
        f32x16 o0, o1;
#pragma unroll
        for (int i = 0; i < 16; ++i) { o0[i] = 0.f; o1[i] = 0.f; }
        LAS float* otl = (LAS float*)(L + AOT) + wid * 2048 + lane;
        const lcp kp = L + RK + hi * 1024 + r32 * 16;
        const lcp vp = L + RV + ((lane >> 4) & 1) * 32 + (lane & 3) * 8 + (4 * hi + ((lane & 15) >> 2)) * 64;
        {
            WAIT_BAR(0);
            const int nlim = ((tq - 31) >> 4) - 4 * hi;
            f32x16 pu[4];
#pragma unroll
            for (int u = 0; u < 4; ++u) {
#pragma unroll
                for (int i = 0; i < 16; ++i) pu[u][i] = 0.f;
#pragma unroll
                for (int d0 = 0; d0 < 4; ++d0) { const bf16x8 a = *(const LAS bf16x8*)(kp + (u >> 1) * SLOTB + (u & 1) * 512 + d0 * 2048); pu[u] = MFMA32(a, qr[d0], pu[u]); } }
            float mx = MFLOOR;
#pragma unroll
            for (int u = 0; u < 4; ++u)
#pragma unroll
                for (int r = 0; r < 16; ++r) { pu[u][r] = (32 * u + (r & 3) + 8 * (r >> 2) <= nlim) ? pu[u][r] : NEGB; mx = fmaxf(mx, pu[u][r]); }
            mx = max32x(mx);
            float ls = 0.f;
#pragma unroll
            for (int u = 0; u < 4; ++u)
#pragma unroll
                for (int r = 0; r < 16; ++r) { pu[u][r] = __builtin_amdgcn_exp2f(pu[u][r] - mx); ls += pu[u][r]; }
            ls = sum32x(ls);
            const float inv = ls > 0.f ? __builtin_amdgcn_rcpf(ls) : 0.f;
            {
                LAS float* ip = imp + ((size_t)hh * 64 + qrel) * 33;
                float prevrecv = 0.f;
#pragma unroll
                for (int u = 0; u < 4; ++u) {
#pragma unroll
                    for (int q4 = 0; q4 < 4; ++q4) { const int k = 4 * u + q4;
                        const float gs = ((pu[u][4 * q4] + pu[u][4 * q4 + 1]) + (pu[u][4 * q4 + 2] + pu[u][4 * q4 + 3])) * inv; const float le = pu[u][4 * q4 + 3] * inv;
                        const auto rr = __builtin_amdgcn_permlane32_swap(__float_as_uint(le), __float_as_uint(le), false, false);
                        const float recv = __uint_as_float(hi ? rr[0] : rr[1]);
                        const float prev = hi ? recv : prevrecv;
                        ip[2 * k + hi] = gs + prev; prevrecv = recv; }
                    PV_STEP(PACKF(pu[u], 0), 2 * u); PV_STEP(PACKF(pu[u], 1), 2 * u + 1); }
            }
            if (hi == 0) wsf[r32] = sg0 * inv;
            asm volatile("s_waitcnt lgkmcnt(0)" ::: "memory");
#pragma unroll
            for (int r = 0; r < 16; ++r) { const float w = wsf[crow(r, hi)]; otl[r * 64] = o0[r] * w; otl[(16 + r) * 64] = o1[r] * w; }
        }
        LBAR();
        attn_issue(L, zb, ZKS + 64 * g, ZVS + 64 * g, 0, qt + 1, tid, wid);
        {
            const int tok = tid >> 3, part = tid & 7;
            const LAS float* i0 = imp + (size_t)tok * 33;
            unsigned long long key[4];
#pragma unroll
            for (int q = 0; q < 4; ++q) { const int j = part + 8 * q; const float vj = ((i0[j] + i0[64 * 33 + j]) + i0[2 * 64 * 33 + j]) + i0[3 * 64 * 33 + j];
                key[q] = (j >= 1 && j <= qt - 2) ? (((unsigned long long)__float_as_uint(vj) << 32) | (unsigned)(32 - j)) : 0ull; }
            unsigned bits = 0u;
            if (qt > 7) {
#pragma unroll
                for (int round = 0; round < 5; ++round) {
                    unsigned long long m = key[0] > key[1] ? key[0] : key[1]; { const unsigned long long m2 = key[2] > key[3] ? key[2] : key[3]; m = m > m2 ? m : m2; }
                    { const unsigned long long o_ = ((unsigned long long)(unsigned)__builtin_amdgcn_update_dpp(0, (int)(m >> 32), 0xB1, 0xf, 0xf, true) << 32) | (unsigned)__builtin_amdgcn_update_dpp(0, (int)m, 0xB1, 0xf, 0xf, true); m = m > o_ ? m : o_; }
                    { const unsigned long long o_ = ((unsigned long long)(unsigned)__builtin_amdgcn_update_dpp(0, (int)(m >> 32), 0x4E, 0xf, 0xf, true) << 32) | (unsigned)__builtin_amdgcn_update_dpp(0, (int)m, 0x4E, 0xf, 0xf, true); m = m > o_ ? m : o_; }
                    { const unsigned long long o_ = ((unsigned long long)(unsigned)__builtin_amdgcn_update_dpp(0, (int)(m >> 32), 0x141, 0xf, 0xf, true) << 32) | (unsigned)__builtin_amdgcn_update_dpp(0, (int)m, 0x141, 0xf, 0xf, true); m = m > o_ ? m : o_; }
#pragma unroll
                    for (int q = 0; q < 4; ++q) { const bool hit = key[q] == m; bits |= hit ? (1u << (part + 8 * q)) : 0u; key[q] = hit ? 0ull : key[q]; }
                }
                bits |= (unsigned)__builtin_amdgcn_update_dpp(0, (int)bits, 0xB1, 0xf, 0xf, true);
                bits |= (unsigned)__builtin_amdgcn_update_dpp(0, (int)bits, 0x4E, 0xf, 0xf, true);
                bits |= (unsigned)__builtin_amdgcn_update_dpp(0, (int)bits, 0x141, 0xf, 0xf, true);
            }
            if (part == 0) sel[tok] = bits | ((qt <= 7) ? ((2u << qt) - 1u) : (1u | (1u << qt) | (1u << (qt - 1))));
        }
        LBAR();
        const unsigned selbits = sel[qrel];
        { float lsum;
          attn_branch<0, true>(L, zb, ZKS + 64 * g, ZVS + 64 * g, 0, qt, qt, qrel, selbits, qr, o0, o1, lsum, tid, wid);
          if (hi == 0) wsf[r32] = sg1 * __builtin_amdgcn_rcpf(lsum);
          asm volatile("s_waitcnt lgkmcnt(0)" ::: "memory");
#pragma unroll
          for (int r = 0; r < 16; ++r) { const float w = wsf[crow(r, hi)]; otl[r * 64] += o0[r] * w; otl[(16 + r) * 64] += o1[r] * w; } }
        { float lsum;
          attn_branch<1>(L, zb, ZKW + 64 * g, ZVW + 64 * g, qt >= 8 ? qt - 8 : 0, qt, qt, qrel, 0u, qr, o0, o1, lsum, tid, wid);
          if (hi == 0) wsf[r32] = sg2 * __builtin_amdgcn_rcpf(lsum);
          asm volatile("s_waitcnt lgkmcnt(0)" ::: "memory");
#pragma unroll
          for (int r = 0; r < 16; ++r) { const float w = wsf[crow(r, hi)]; otl[r * 64] += o0[r] * w; otl[(16 + r) * 64] += o1[r] * w; }
          asm volatile("s_waitcnt lgkmcnt(0)" ::: "memory"); }
        LBAR();
        if (U + C.G < 1024) UNIT_FETCH(U + C.G);
        const int c8 = lane * 8; const int tk0 = 64 * qt + 32 * g + 4 * wid;
        u32x4 whc[4], wbg[4], wcg[4], wpa[2], wpb[2];
        { const int tp = tk0 >= 2 ? tk0 - 2 : 0;
#pragma unroll
          for (int i = 0; i < 2; ++i) { wpa[i] = *(const u32x4*)zt(zb, tp + i, ZHC + c8); wpb[i] = *(const u32x4*)zt(zb, tp + i, ZCG + c8); }
#pragma unroll
          for (int i = 0; i < 4; ++i) { whc[i] = *(const u32x4*)zt(zb, tk0 + i, ZHC + c8); wbg[i] = *(const u32x4*)zt(zb, tk0 + i, ZBG + c8); wcg[i] = *(const u32x4*)zt(zb, tk0 + i, ZCG + c8); } }
        { const LAS float* ow = (const LAS float*)(L + AOT) + wid * 2048; const size_t rowb = (size_t)b * SEQ + 64 * qt + 32 * th;
          const int d = 8 * (lane & 7);
          const f32x4 g0 = *(const f32x4*)(gout + 64 * head + d), g1 = *(const f32x4*)(gout + 64 * head + d + 4);
#pragma unroll
          for (int i = 0; i < 4; ++i) { const int q = i * 8 + (lane >> 3);
              const LAS float* src = ow + (16 * (d >> 5) + (q & 3) + 4 * (q >> 3)) * 64 + (d & 31) + 32 * ((q >> 2) & 1);
              const f32x4 v0 = *(const LAS f32x4*)src, v1 = *(const LAS f32x4*)(src + 4);
              float ss = (v0.x * v0.x + v0.y * v0.y) + (v0.z * v0.z + v0.w * v0.w) + (v1.x * v1.x + v1.y * v1.y) + (v1.z * v1.z + v1.w * v1.w);
              ss = sum8_dpp(ss);
              const u32x4 w4 = {cvt_pk_bf16(v0.x * g0.x, v0.y * g0.y), cvt_pk_bf16(v0.z * g0.z, v0.w * g0.w), cvt_pk_bf16(v1.x * g1.x, v1.y * g1.y), cvt_pk_bf16(v1.z * g1.z, v1.w * g1.w)};
              *(u32x4*)((char*)omix + pg8::tl_off((int)(rowb + q), 64 * head + d, D)) = w4;
              if ((lane & 7) == 0) asq[(rowb + q) * 8 + head] = ss; } }
        { float w0[8], w1[8], w2[8], cb[8], gc[8];
#pragma unroll
          for (int e = 0; e < 8; ++e) { w0[e] = conv_w[c8 + e]; w1[e] = conv_w[512 + c8 + e]; w2[e] = conv_w[1024 + c8 + e]; cb[e] = conv_b[c8 + e]; gc[e] = gout[512 + c8 + e]; }
          float um2[8], um1[8];
          { float ta[8], tb[8]; const float zf = tk0 == 0 ? 0.f : 1.f;
            unpack8(wpa[0], ta); unpack8(wpb[0], tb);
#pragma unroll
            for (int e = 0; e < 8; ++e) um2[e] = ta[e] * tb[e] * zf;
            unpack8(wpa[1], ta); unpack8(wpb[1], tb);
#pragma unroll
            for (int e = 0; e < 8; ++e) um1[e] = ta[e] * tb[e] * zf; }
          float oc[4][8], s2[4];
#pragma unroll
          for (int i = 0; i < 4; ++i) {
              float hc[8], bg[8], cg[8];
              unpack8(whc[i], hc); unpack8(wbg[i], bg); unpack8(wcg[i], cg);
              s2[i] = 0.f;
#pragma unroll
              for (int e = 0; e < 8; ++e) { const float u = cg[e] * hc[e]; const float v = cb[e] + um2[e] * w0[e] + um1[e] * w1[e] + u * w2[e]; oc[i][e] = bg[e] * v; s2[i] += oc[i][e] * oc[i][e]; um2[e] = um1[e]; um1[e] = u; } }
#pragma unroll
          for (int i = 0; i < 4; ++i) s2[i] = sum64_dpp(s2[i]);
#pragma unroll
          for (int i = 0; i < 4; ++i) { const float rc = __builtin_amdgcn_rsqf(s2[i] * (1.0f / 512.0f) + EPS);
              u32x4 o;
              o.x = cvt_pk_bf16(oc[i][0] * rc * gc[0], oc[i][1] * rc * gc[1]); o.y = cvt_pk_bf16(oc[i][2] * rc * gc[2], oc[i][3] * rc * gc[3]);
              o.z = cvt_pk_bf16(oc[i][4] * rc * gc[4], oc[i][5] * rc * gc[5]); o.w = cvt_pk_bf16(oc[i][6] * rc * gc[6], oc[i][7] * rc * gc[7]);
              *(u32x4*)((char*)omix + pg8::tl_off(b * SEQ + tk0 + i, 512 + c8, D)) = o; } }
    }
#undef UNIT_FETCH
    asm volatile("s_waitcnt lgkmcnt(0)" ::: "memory"); __builtin_amdgcn_s_barrier();
    __builtin_amdgcn_s_setprio(0);
}

__global__ void __launch_bounds__(512, 2) nsa_fwd(Args args) {
    extern __shared__ __attribute__((aligned(16))) unsigned char lds[];
    Ctx C;
    C.L = (LAS unsigned char*)lds;
    C.G = gridDim.x; C.bx = blockIdx.x; { const int bx = blockIdx.x; C.vcu = (C.G % 8 == 0) ? (bx % 8) * (C.G / 8) + bx / 8 : bx; }
    for (int u = threadIdx.x; u < (LDS_BYTES - CTRL_OFF) / 4; u += 512) ((LAS unsigned*)(C.L + CTRL_OFF))[u] = 0u;
    __syncthreads();
    XcdBarrier bar = xcd_barrier_post((unsigned*)(args.ws + WS_CTL) + CW_BAR, (volatile LAS unsigned*)(C.L + MISC_OFF + 32));

#define GRID_SYNC() do { XcdBarrier b_ = bar; unsigned long long bp_ = (unsigned long long)b_.bar; unsigned bx_ = b_.x; asm volatile("" : "+s"(bp_), "+s"(bx_)); b_.bar = (unsigned*)bp_; b_.x = bx_; xcd_barrier(b_); } while (0)
    prologue(C);
    GRID_SYNC();
    prologue2(C);
    GRID_SYNC();

    for (int l = 0; l < DEPTH; ++l) {
        for (int half = 0; half < 2; ++half) {
            const int sub = half ? 2 : 0;
            { const ArgsP A = get_args(); const Ctx Cl = launder(C);
              pg8::Gemm g{(const bf16*)(A->ws + WS_H), (const bf16*)(A->ws + WS_WFI) + (size_t)(l * 2 + half) * NFI * D, M, NFI, D}; pg8::StaticOrder S; S.init(M, NFI, Cl.G, Cl.bx);
              pg8::EpiSwiGLU E{(bf16*)(A->ws + WS_ZB), FF, (const float*)(A->ws + WS_RSQ), (const float*)(A->ws + WS_SBW) + (size_t)(3 * l + sub) * NB * NFI, NFI};
              pg8::gemm_phase<pg8::EpiSwiGLU, pg8::StaticOrder, true, true>(Cl.L, g, S, E); }
            GRID_SYNC();
            { const ArgsP A = get_args(); const Ctx Cl = launder(C);
              const int nl = half ? (l < DEPTH - 1 ? l + 1 : l) : l, nsub = half ? 0 : 1;
              const float* modn = (const float*)(A->ws + WS_MOD) + (size_t)nl * NB * MODW + nsub * 3072;
              pg8::Gemm g{(const bf16*)(A->ws + WS_ZB), (const bf16*)(A->ws + WS_WFO) + (size_t)(l * 2 + half) * D * FF, M, D, FF}; pg8::StaticOrder S; S.init(M, D, Cl.G, Cl.bx);
              pg8::EpiResid E{(unsigned*)(A->ws + WS_X), (const float*)(A->ws + WS_MOD) + (size_t)l * NB * MODW + sub * 3072 + 2048,
                              (bf16*)(A->ws + WS_H), A->in[4] + (size_t)(nl * 3 + nsub) * D, modn + 1024, (float*)(A->ws + WS_RSQ), MODW, 0.5f};
              pg8::gemm_phase<pg8::EpiResid, pg8::StaticOrder, true, true>(Cl.L, g, S, E); }
            GRID_SYNC();
            if (half == 0) {
                { const ArgsP A = get_args(); const Ctx Cl = launder(C);
                  pg8::Gemm g{(const bf16*)(A->ws + WS_H), (const bf16*)(A->ws + WS_WMI) + (size_t)l * ZW * D, M, ZW, D}; pg8::StaticOrder S; S.init(M, ZW, Cl.G, Cl.bx);
                  pg8::EpiBf16Plain E{(bf16*)(A->ws + WS_ZB), ZW, (const float*)(A->ws + WS_RSQ), (const float*)(A->ws + WS_SBW) + (size_t)(3 * l + 1) * NB * NFI, NFI, 2};
                  pg8::gemm_phase<pg8::EpiBf16Plain, pg8::StaticOrder, true, true>(Cl.L, g, S, E); }
                GRID_SYNC();
                compress_phase(C, l);
                GRID_SYNC();
                attn_phase(C, l);
                GRID_SYNC();
                { const ArgsP A = get_args(); const Ctx Cl = launder(C);
                  const float* modn = (const float*)(A->ws + WS_MOD) + (size_t)l * NB * MODW + 2 * 3072;
                  pg8::Gemm g{(const bf16*)(A->ws + WS_OMIX), (const bf16*)(A->ws + WS_WMO) + (size_t)l * D * D, M, D, D}; pg8::StaticOrder S; S.init(M, D, Cl.G, Cl.bx);
                  pg8::EpiResidMix E; E.x16 = (unsigned*)(A->ws + WS_X); E.gate = (const float*)(A->ws + WS_MOD) + (size_t)l * NB * MODW + 3072 + 2048; E.hs = (bf16*)(A->ws + WS_H);
                  E.gn = A->in[4] + (size_t)(l * 3 + 2) * D; E.scale = modn + 1024; E.rowsq = (float*)(A->ws + WS_RSQ); E.mod_stride = MODW; E.coef = 1.0f; E.asq = (const float*)(A->ws + WS_ASQ);
                  pg8::gemm_phase<pg8::EpiResidMix, pg8::StaticOrder, true, true>(Cl.L, g, S, E); }
                GRID_SYNC();
            }
        }
    }
    finalnorm_phase(C);
}

extern "C" void kernel_launch(void* const* d_in, const int* in_sizes, int n_in, void* d_out, int out_size, void* d_ws, size_t ws_size, hipStream_t stream) {
    static int grid = 0;
    if (grid == 0) {
        if (n_in != 16 || in_sizes[0] != M * D || out_size != M * D || ws_size < WS_END) { fprintf(stderr, "kernel_launch: unexpected shapes (n_in %d, in0 %d, out %d, ws %zu); nothing launched\n", n_in, n_in > 0 ? in_sizes[0] : -1, out_size, ws_size); grid = -1; return; }
        int dev = 0, cus = 0;
        if (hipGetDevice(&dev) != hipSuccess || hipDeviceGetAttribute(&cus, hipDeviceAttributeMultiprocessorCount, dev) != hipSuccess) { grid = -1; return; }
        if (hipFuncSetAttribute((const void*)nsa_fwd, hipFuncAttributeMaxDynamicSharedMemorySize, LDS_BYTES) != hipSuccess) { fprintf(stderr, "kernel_launch: hipFuncSetAttribute failed\n"); grid = -1; return; }
        int per_cu = 0;
        if (hipOccupancyMaxActiveBlocksPerMultiprocessor(&per_cu, (const void*)nsa_fwd, 512, LDS_BYTES) != hipSuccess || per_cu < 1) fprintf(stderr, "kernel_launch: occupancy query reports %d\n", per_cu);
        (void)hipGetLastError();
        grid = cus;
    }
    if (grid < 0) return;
    if (hipMemsetAsync((char*)d_ws + WS_CTL, 0, CTL_ZERO_BYTES, stream) != hipSuccess) return;
    Args a{};
    for (int i = 0; i < 16; ++i) a.in[i] = (const float*)d_in[i];
    a.out = (float*)d_out; a.ws = (unsigned char*)d_ws;
    hipLaunchKernelGGL(nsa_fwd, dim3(grid), dim3(512), LDS_BYTES, stream, a);
}
```

```cpp
#include <hip/hip_runtime.h>
#include <cstdio>
#include <cstdint>
namespace pg8 {
#define PG8_LAS __attribute__((address_space(3)))
typedef unsigned short bf16_t;
typedef short bf16x8 __attribute__((ext_vector_type(8)));
typedef float f32x4 __attribute__((ext_vector_type(4)));
typedef unsigned u32x4 __attribute__((ext_vector_type(4)));
constexpr int BM = 256, BK = 64, HALF = 128, HTB = HALF * BK * 2  , STAGE_BYTES = 8 * HTB, NXCD = 8, WGM = 8;

__host__ __device__ __forceinline__ int lds_byte(int r, int c) { const int st = (r >> 4) * 2 + (c >> 5), rr = r & 15, cc = c & 31, ob = rr * 64 + cc * 2; return st * 1024 + (ob ^ (((ob >> 9) & 1) << 5)); }
__host__ __device__ __forceinline__ void stage_rc(int b, int& R, int& C) { const int st = b / 1024, sb = b % 1024, swz = sb ^ (((sb >> 9) & 1) << 5); R = (st >> 1) * 16 + swz / 64; C = (st & 1) * 32 + (swz % 64) / 2; }
__host__ __device__ __forceinline__ int perm32(int rho) { const int n = rho >> 4, i = rho & 15; return 8 * (i >> 2) + 4 * n + (i & 3); }

__host__ __device__ __forceinline__ size_t tl_off(int row, int col, int K) { return ((size_t)((row >> 4) * (K >> 5) + (col >> 5)) << 10) + (size_t)(((row & 15) << 6) + ((col & 31) << 1)); }
struct Unit { int pm, pn; };
struct Gemm { const bf16_t* A; const bf16_t* Bt; int M, N, K; };

struct StaticOrder {
    int nM, nN, nwg, G, c;
    __host__ __device__ void init(int M, int N, int G_, int c_) { nM = M / BM; nN = N / BM; nwg = nM * nN; G = G_; c = c_; }
    __host__ __device__ bool next(int i, Unit& u) const {
        if (G == 256 && nM == 128 && WGM == 8) { const int off = i * 32 + (c >> 3), nig = 8 * nN; if (off >= 2 * nig) return false;
            const int hi = off >= nig ? 1 : 0, rem = off - hi * nig; u.pm = (2 * (c & 7) + hi) * 8 + (rem & 7); u.pn = rem >> 3; return true; }
        const long L = (long)i * G + c; if (L >= nwg) return false;
        int wgid = (int)L; { const int q = nwg / NXCD, r = nwg % NXCD, xcd = wgid % NXCD, off = wgid / NXCD; wgid = (xcd < r ? xcd * (q + 1) : r * (q + 1) + (xcd - r) * q) + off; }
        const int nig = WGM * nN, gid = wgid / nig, fm = gid * WGM, gsz = (nM - fm) < WGM ? (nM - fm) : WGM;
        u.pm = fm + ((wgid % nig) % gsz); u.pn = (wgid % nig) / gsz; return true;
    }
    __device__ __forceinline__ void a_ready(const Unit&) const {}
    __device__ __forceinline__ void done(const Unit&) const {}
};

#define PG8_GAS __attribute__((address_space(1)))
typedef float f32x2 __attribute__((ext_vector_type(2)));
typedef unsigned u32x2 __attribute__((ext_vector_type(2)));
typedef _Float16 f16x2_t __attribute__((ext_vector_type(2)));
__device__ __forceinline__ unsigned cvt_pk_f16(float lo, float hi) { f32x2 v = {lo, hi}; f16x2_t h = __builtin_convertvector(v, f16x2_t); return __builtin_bit_cast(unsigned, h); }
typedef _Float16 f16x4_t __attribute__((ext_vector_type(4)));
__device__ __forceinline__ f32x4 unpack_f16x4(u32x2 w) { const f16x4_t h = __builtin_bit_cast(f16x4_t, w); return __builtin_convertvector(h, f32x4); }
typedef __bf16 bf16x2_t __attribute__((ext_vector_type(2)));
__device__ __forceinline__ unsigned cvt_pk_bf16(float lo, float hi) { f32x2 v = {lo, hi}; bf16x2_t b = __builtin_convertvector(v, bf16x2_t); return __builtin_bit_cast(unsigned, b); }
__device__ __forceinline__ float silu_f(float x) { return x * __builtin_amdgcn_rcpf(1.0f + __builtin_amdgcn_exp2f(-1.4426950408889634f * x)); }

__device__ __forceinline__ float xsum16(float s) { return s + __shfl_xor(s, 16); }
__device__ __forceinline__ float xsum32(float s) { const auto r = __builtin_amdgcn_permlane32_swap(__float_as_uint(s), __float_as_uint(s), false, false); return __uint_as_float(r[0]) + __uint_as_float(r[1]); }
__device__ __forceinline__ void xl_prefetch_consumer(const float* rowsq, const float* biasrow, int pm, PG8_LAS unsigned char* xl, int, int) {
    int t_ = threadIdx.x; asm volatile("" : "+v"(t_)); const int lane = t_ & 63, wid = __builtin_amdgcn_readfirstlane(t_ >> 6);
    if (wid < 4) __builtin_amdgcn_global_load_lds((const unsigned*)(rowsq + (size_t)wid * (128 * 256) + (size_t)pm * 256 + 4 * lane), (PG8_LAS unsigned*)(xl + wid * 1024), 16, 0, 0);
    if (wid == 4) __builtin_amdgcn_global_load_lds((const unsigned*)(biasrow + 4 * lane), (PG8_LAS unsigned*)(xl + 16384), 16, 0, 0);
}
__device__ __forceinline__ void epi_loads(float (&rs)[2][4], f32x4 (&bv)[4], PG8_LAS unsigned char* xl, int wr, int wc, int fr, int fq) {
    const unsigned ra = (unsigned)(size_t)xl + (unsigned)(fq * 1024 + (wr * 64 + fr) * 4);
    const unsigned ba = (unsigned)(size_t)xl + 16384u + (unsigned)((wc * 32 + 8 * fq) * 4);
    float p[2][4];
    asm volatile("ds_read_b32 %0, %12\n\tds_read_b32 %1, %12 offset:64\n\tds_read_b32 %2, %12 offset:128\n\tds_read_b32 %3, %12 offset:192\n\t"
                 "ds_read_b32 %4, %12 offset:512\n\tds_read_b32 %5, %12 offset:576\n\tds_read_b32 %6, %12 offset:640\n\tds_read_b32 %7, %12 offset:704\n\t"
                 "ds_read_b128 %8, %13\n\tds_read_b128 %9, %13 offset:16\n\tds_read_b128 %10, %13 offset:512\n\tds_read_b128 %11, %13 offset:528\n\t"
                 "s_waitcnt lgkmcnt(0)"
                 : "=&v"(p[0][0]), "=&v"(p[0][1]), "=&v"(p[0][2]), "=&v"(p[0][3]), "=&v"(p[1][0]), "=&v"(p[1][1]), "=&v"(p[1][2]), "=&v"(p[1][3]), "=&v"(bv[0]), "=&v"(bv[1]), "=&v"(bv[2]), "=&v"(bv[3])
                 : "v"(ra), "v"(ba) : "memory");
#pragma unroll
    for (int ai = 0; ai < 2; ++ai)
#pragma unroll
        for (int m = 0; m < 4; ++m) { float s = xsum32(xsum16(p[ai][m])); rs[ai][m] = __builtin_amdgcn_rsqf(s * (1.0f / 1024.0f) + 1e-6f); }
}
__device__ __forceinline__ bf16x8 zero_frag() { bf16x8 z = {0, 0, 0, 0, 0, 0, 0, 0}; asm volatile("" : "+v"(z)); return z; }
__device__ __forceinline__ void zero4(f32x4& v, const bf16x8& zf) { v = __builtin_amdgcn_mfma_f32_16x16x32_bf16(zf, zf, (f32x4){0.f, 0.f, 0.f, 0.f}, 0, 0, 0); }
struct EpiBf16Plain {
    static constexpr bool PERM = true, AFTER_DRAIN = false, PREFETCH = true, MIDSCALE = false; static constexpr bool KSERP = true;
    __device__ __forceinline__ void prefetch(const Unit& u, PG8_LAS unsigned char* xl, int wid, int lane) const { xl_prefetch_consumer(rowsq, bias + (size_t)(u.pm >> 3) * bias_stride + u.pn * BM, u.pm, xl, wid, lane); }
    bf16_t* O; int ldc; const float* rowsq; const float* bias; int bias_stride; int qtiles;
    static constexpr float QSCALE = 0.125f * 1.4426950408889634f;
    __device__ __forceinline__ void operator()(f32x4 (&acc)[2][2][4][2], const Unit& u, int wr, int wc, int fr, int fq, PG8_LAS unsigned char* xl) const {
        const bf16x8 zf_ = zero_frag();
        const int row0 = u.pm * BM + wr * 64 + fr; const int col0 = u.pn * BM + wc * 32 + 8 * fq;
        const float* bp = bias + (size_t)(u.pm >> 3) * bias_stride + col0;
        f32x4 bvl[4]; float rsv[2][4]; epi_loads(rsv, bvl, xl, wr, wc, fr, fq);
        if (u.pn < qtiles) {
#pragma unroll
            for (int i = 0; i < 4; ++i) bvl[i] *= QSCALE;
#pragma unroll
            for (int ai = 0; ai < 2; ++ai)
#pragma unroll
                for (int m = 0; m < 4; ++m) rsv[ai][m] *= QSCALE; }
#pragma unroll
        for (int ai = 0; ai < 2; ++ai)
#pragma unroll
            for (int m = 0; m < 4; ++m) { const int row = row0 + ai * HALF + m * 16; const float rs = rsv[ai][m];
#pragma unroll
                for (int bj = 0; bj < 2; ++bj) { const f32x4 v0 = acc[ai][bj][m][0] * rs + bvl[2 * bj], v1 = acc[ai][bj][m][1] * rs + bvl[2 * bj + 1];
                    zero4(acc[ai][bj][m][0], zf_); zero4(acc[ai][bj][m][1], zf_);
                    u32x4 w; w.x = cvt_pk_bf16(v0[0], v0[1]); w.y = cvt_pk_bf16(v0[2], v0[3]); w.z = cvt_pk_bf16(v1[0], v1[1]); w.w = cvt_pk_bf16(v1[2], v1[3]);
                    *(PG8_GAS u32x4*)((char*)O + tl_off(row, col0 + bj * HALF, ldc)) = w; } }
    }
};
struct EpiSwiGLU {
    static constexpr bool PERM = true, AFTER_DRAIN = false, PREFETCH = true, MIDSCALE = false; static constexpr bool KSERP = true;
    __device__ __forceinline__ void prefetch(const Unit& u, PG8_LAS unsigned char* xl, int wid, int lane) const { xl_prefetch_consumer(rowsq, bias + (size_t)(u.pm >> 3) * bias_stride + u.pn * BM, u.pm, xl, wid, lane); }
    bf16_t* O; int ldo; const float* rowsq; const float* bias; int bias_stride;
    __device__ __forceinline__ void operator()(f32x4 (&acc)[2][2][4][2], const Unit& u, int wr, int wc, int fr, int fq, PG8_LAS unsigned char* xl) const {
        const bf16x8 zf_ = zero_frag();
        const int row0 = u.pm * BM + wr * 64 + fr; const int col0 = u.pn * HALF + wc * 32 + 8 * fq;
        const float* bp = bias + (size_t)(u.pm >> 3) * bias_stride + u.pn * BM + wc * 32 + 8 * fq;
        f32x4 bvl[4]; float rsv[2][4]; epi_loads(rsv, bvl, xl, wr, wc, fr, fq);
        const f32x4 bg0 = bvl[0], bg1 = bvl[1], bu0 = bvl[2], bu1 = bvl[3];
#pragma unroll
        for (int ai = 0; ai < 2; ++ai)
#pragma unroll
            for (int m = 0; m < 4; ++m) { const int row = row0 + ai * HALF + m * 16; const float rs = rsv[ai][m]; bf16_t* rowp = (bf16_t*)((char*)O + tl_off(row, col0, ldo));
                const f32x4 g0 = acc[ai][0][m][0] * rs + bg0, g1 = acc[ai][0][m][1] * rs + bg1, u0 = acc[ai][1][m][0] * rs + bu0, u1 = acc[ai][1][m][1] * rs + bu1;
                zero4(acc[ai][0][m][0], zf_); zero4(acc[ai][0][m][1], zf_); zero4(acc[ai][1][m][0], zf_); zero4(acc[ai][1][m][1], zf_);
                u32x4 w;
                w.x = cvt_pk_bf16(silu_f(g0[0]) * u0[0], silu_f(g0[1]) * u0[1]); w.y = cvt_pk_bf16(silu_f(g0[2]) * u0[2], silu_f(g0[3]) * u0[3]);
                w.z = cvt_pk_bf16(silu_f(g1[0]) * u1[0], silu_f(g1[1]) * u1[1]); w.w = cvt_pk_bf16(silu_f(g1[2]) * u1[2], silu_f(g1[3]) * u1[3]);
                *(PG8_GAS u32x4*)rowp = w; }
    }
};
struct EpiResid {
    static constexpr bool PERM = true, AFTER_DRAIN = false, PREFETCH = true, MIDSCALE = false; static constexpr bool KSERP = true;
    __device__ __forceinline__ void prefetch(const Unit& u, PG8_LAS unsigned char* xl, int, int) const {
        int t_ = threadIdx.x; asm volatile("" : "+v"(t_)); const int lane = t_ & 63, wid = __builtin_amdgcn_readfirstlane(t_ >> 6);
        if (wid == 0) __builtin_amdgcn_global_load_lds((const unsigned*)(gate + (size_t)(u.pm >> 3) * mod_stride + u.pn * BM + 4 * lane), (PG8_LAS unsigned*)(xl), 16, 0, 0);
        if (wid == 1) __builtin_amdgcn_global_load_lds((const unsigned*)(gn + u.pn * BM + 4 * lane), (PG8_LAS unsigned*)(xl + 1024), 16, 0, 0);
        if (wid == 2) __builtin_amdgcn_global_load_lds((const unsigned*)(scale + (size_t)(u.pm >> 3) * mod_stride + u.pn * BM + 4 * lane), (PG8_LAS unsigned*)(xl + 2048), 16, 0, 0);
    }
    unsigned* x16;   const float* gate; bf16_t* hs; const float* gn; const float* scale; float* rowsq; int mod_stride; float coef;
    __device__ __forceinline__ void operator()(f32x4 (&acc)[2][2][4][2], const Unit& u, int wr, int wc, int fr, int fq, PG8_LAS unsigned char* xl) const {
        const bf16x8 zf_ = zero_frag();
        const int row0 = u.pm * BM + wr * 64 + fr; const int col0 = u.pn * BM + wc * 32 + 8 * fq;
        f32x4 gv[2][2], av[2][2];
        { f32x4 sv[2][2]; const unsigned la = (unsigned)(size_t)xl + (unsigned)((wc * 32 + 8 * fq) * 4);
          asm volatile("ds_read_b128 %0, %12\n\tds_read_b128 %1, %12 offset:16\n\tds_read_b128 %2, %12 offset:512\n\tds_read_b128 %3, %12 offset:528\n\t"
                       "ds_read_b128 %4, %12 offset:1024\n\tds_read_b128 %5, %12 offset:1040\n\tds_read_b128 %6, %12 offset:1536\n\tds_read_b128 %7, %12 offset:1552\n\t"
                       "ds_read_b128 %8, %12 offset:2048\n\tds_read_b128 %9, %12 offset:2064\n\tds_read_b128 %10, %12 offset:2560\n\tds_read_b128 %11, %12 offset:2576\n\t"
                       "s_waitcnt lgkmcnt(0)"
                       : "=&v"(gv[0][0]), "=&v"(gv[0][1]), "=&v"(gv[1][0]), "=&v"(gv[1][1]), "=&v"(av[0][0]), "=&v"(av[0][1]), "=&v"(av[1][0]), "=&v"(av[1][1]), "=&v"(sv[0][0]), "=&v"(sv[0][1]), "=&v"(sv[1][0]), "=&v"(sv[1][1])
                       : "v"(la) : "memory");
#pragma unroll
          for (int bj = 0; bj < 2; ++bj)
#pragma unroll
              for (int n = 0; n < 2; ++n) { gv[bj][n] = gv[bj][n] * coef; av[bj][n] = av[bj][n] * (sv[bj][n] + 1.0f); } }
        u32x4 xa[2], xb[2], xc[2]; float sqv[8];
#define EPR_LOAD(dst, rg) do { const int rw_ = row0 + ((rg) >> 2) * HALF + ((rg) & 3) * 16; _Pragma("unroll") for (int bj = 0; bj < 2; ++bj) \
            dst[bj] = *(const PG8_GAS u32x4*)((const char*)x16 + tl_off(rw_, col0 + bj * HALF, 1024)); } while (0)
#define EPR_ROW(src, rg) do { const int ai_ = (rg) >> 2, m_ = (rg) & 3; const int rw_ = row0 + ai_ * HALF + m_ * 16; float sq_ = 0.f; \
            _Pragma("unroll") for (int bj = 0; bj < 2; ++bj) { const f32x4 x0 = unpack_f16x4((u32x2){src[bj].x, src[bj].y}) + gv[bj][0] * acc[ai_][bj][m_][0], x1 = unpack_f16x4((u32x2){src[bj].z, src[bj].w}) + gv[bj][1] * acc[ai_][bj][m_][1]; \
                { const u32x4 xw = {cvt_pk_f16(x0[0], x0[1]), cvt_pk_f16(x0[2], x0[3]), cvt_pk_f16(x1[0], x1[1]), cvt_pk_f16(x1[2], x1[3])}; *(PG8_GAS u32x4*)((char*)x16 + tl_off(rw_, col0 + bj * HALF, 1024)) = xw; } \
                sq_ += ((x0[0] * x0[0] + x0[1] * x0[1]) + (x0[2] * x0[2] + x0[3] * x0[3])) + ((x1[0] * x1[0] + x1[1] * x1[1]) + (x1[2] * x1[2] + x1[3] * x1[3])); \
                const f32x4 h0 = x0 * av[bj][0], h1 = x1 * av[bj][1]; const u32x4 w = {cvt_pk_bf16(h0[0], h0[1]), cvt_pk_bf16(h0[2], h0[3]), cvt_pk_bf16(h1[0], h1[1]), cvt_pk_bf16(h1[2], h1[3])}; \
                *(PG8_GAS u32x4*)((char*)hs + tl_off(rw_, col0 + bj * HALF, 1024)) = w; zero4(acc[ai_][bj][m_][0], zf_); zero4(acc[ai_][bj][m_][1], zf_); } \
            sqv[(rg)] = xsum32(xsum16(sq_)); } while (0)
        EPR_LOAD(xa, 0); EPR_LOAD(xb, 1);
        EPR_LOAD(xc, 2); EPR_ROW(xa, 0);
        EPR_LOAD(xa, 3); EPR_ROW(xb, 1);
        EPR_LOAD(xb, 4); EPR_ROW(xc, 2);
        EPR_LOAD(xc, 5); EPR_ROW(xa, 3);
        EPR_LOAD(xa, 6); EPR_ROW(xb, 4);
        EPR_LOAD(xb, 7); EPR_ROW(xc, 5);
        EPR_ROW(xa, 6);
        EPR_ROW(xb, 7);
        { PG8_LAS float* S = (PG8_LAS float*)(xl + 14336);
          if (fq == 0) {
#pragma unroll
              for (int rg = 0; rg < 8; ++rg) S[wc * 256 + (rg >> 2) * HALF + wr * 64 + (rg & 3) * 16 + fr] = sqv[rg]; }
          asm volatile("s_waitcnt lgkmcnt(0)" ::: "memory"); __builtin_amdgcn_s_barrier(); asm volatile("" ::: "memory");
          const int wid_ = wr * 4 + wc;
          if (wid_ < 4) { const int r = wid_ * 64 + fq * 16 + fr; const float s = (S[r] + S[256 + r]) + (S[512 + r] + S[768 + r]);
              *(PG8_GAS float*)(rowsq + (size_t)u.pn * (128 * 256) + (size_t)u.pm * BM + r) = s; } }
#undef EPR_LOAD
#undef EPR_ROW
    }
};


struct EpiResidMix : EpiResid {
    static constexpr bool MIDSCALE = true; static constexpr int MID_T = 8; static constexpr bool KSERP = false;
    const float* asq;
    __device__ __forceinline__ void prefetch(const Unit& u, PG8_LAS unsigned char* xl, int a_, int b_) const {
        EpiResid::prefetch(u, xl, a_, b_);
        int t_ = threadIdx.x; asm volatile("" : "+v"(t_)); const int lane = t_ & 63, wid = __builtin_amdgcn_readfirstlane(t_ >> 6);
        __builtin_amdgcn_global_load_lds((const unsigned*)(asq + ((size_t)u.pm * 256 + 32 * wid) * 8 + 4 * lane), (PG8_LAS unsigned*)(xl + 4096 + wid * 1024), 16, 0, 0);
    }
    __device__ __forceinline__ void midscale(f32x4 (&acc)[2][2][4][2], int wr, int fr, int fq, PG8_LAS unsigned char* xl) const {
        const unsigned la = (unsigned)(size_t)xl + 4096u + (unsigned)((wr * 64 + fr) * 32 + fq * 8);
        f32x2 p[2][4];
        asm volatile("ds_read_b64 %0, %8\n\tds_read_b64 %1, %8 offset:512\n\tds_read_b64 %2, %8 offset:1024\n\tds_read_b64 %3, %8 offset:1536\n\t"
                     "ds_read_b64 %4, %8 offset:4096\n\tds_read_b64 %5, %8 offset:4608\n\tds_read_b64 %6, %8 offset:5120\n\tds_read_b64 %7, %8 offset:5632\n\t"
                     "s_waitcnt lgkmcnt(0)"
                     : "=&v"(p[0][0]), "=&v"(p[0][1]), "=&v"(p[0][2]), "=&v"(p[0][3]), "=&v"(p[1][0]), "=&v"(p[1][1]), "=&v"(p[1][2]), "=&v"(p[1][3])
                     : "v"(la) : "memory");
#pragma unroll
        for (int ai = 0; ai < 2; ++ai)
#pragma unroll
            for (int m = 0; m < 4; ++m) { float sq = p[ai][m][0] + p[ai][m][1]; sq = xsum32(xsum16(sq)); const float r = __builtin_amdgcn_rsqf(sq * (1.0f / 512.0f) + 1e-6f);
#pragma unroll
                for (int bj = 0; bj < 2; ++bj)
#pragma unroll
                    for (int n = 0; n < 2; ++n) acc[ai][bj][m][n] *= r; }
    }
};
template <class Epi, class Sched, bool ALIGN_EPI = false, bool SP2 = false>
__device__ __forceinline__ void gemm_phase(PG8_LAS unsigned char* lds, const Gemm g, const Sched& S, const Epi& E) {
    int tid_ = threadIdx.x; asm volatile("" : "+v"(tid_)); const int tid = tid_, wid = __builtin_amdgcn_readfirstlane(tid >> 6), lane = tid & 63, wr = wid >> 2, wc = wid & 3, fr = lane & 15, fq = lane >> 4;
    const int K = g.K, nt = K / BK;
    unsigned voffA[2], voffB[2];
#pragma unroll
    for (int i = 0; i < 2; ++i) { int R, C; stage_rc(tid * 16 + i * 8192, R, C); const int Rb = Epi::PERM ? ((R & ~31) + perm32(R & 31)) : R;
        voffA[i] = (unsigned)tl_off(R, C, K); voffB[i] = (unsigned)tl_off(Rb, C, K); }
    const size_t kstep = (size_t)2048;
    const size_t hstep = (size_t)HALF * K * 2;
    const size_t tstep = 2 * hstep;
    const unsigned ldsw = (unsigned)wid * 1024u;
    const int aoff = lds_byte(wr * 64 + fr, fq * 8), boff = lds_byte(wc * 32 + fr, fq * 8);
#define PG8_SA(b, h) (((b) * 2 + (h)) * HTB)
#define PG8_SB(b, h) ((4 + (b) * 2 + (h)) * HTB)
#define PG8_STAGE(bufoff, gbase, voff) do { _Pragma("unroll") for (int _i = 0; _i < 2; ++_i) \
        __builtin_amdgcn_global_load_lds((const unsigned*)((const char*)(gbase) + (voff)[_i]), (PG8_LAS unsigned*)(lds + (bufoff) + ldsw + _i * 8192), 16, 0, 0); } while (0)
#define PG8_LDA(dst, b, h) do { _Pragma("unroll") for (int m = 0; m < 4; ++m) _Pragma("unroll") for (int k = 0; k < 2; ++k) dst[m][k] = *(const PG8_LAS bf16x8*)(lds + PG8_SA(b, h) + aoff + m * 2048 + k * 1024); } while (0)
#define PG8_LDB(dst, b, h) do { _Pragma("unroll") for (int n = 0; n < 2; ++n) _Pragma("unroll") for (int k = 0; k < 2; ++k) dst[n][k] = *(const PG8_LAS bf16x8*)(lds + PG8_SB(b, h) + boff + n * 2048 + k * 1024); } while (0)
#define PG8_MMA(ai, bj, At, Bt) do { __builtin_amdgcn_s_setprio(1); _Pragma("unroll") for (int m = 0; m < 4; ++m) _Pragma("unroll") for (int n = 0; n < 2; ++n) _Pragma("unroll") for (int k = 0; k < 2; ++k) \
        acc[ai][bj][m][n] = __builtin_amdgcn_mfma_f32_16x16x32_bf16(Bt[n][k], At[m][k], acc[ai][bj][m][n], 0, 0, 0); __builtin_amdgcn_s_setprio(0); } while (0)
#define PG8_WAIT_V(n) asm volatile("s_waitcnt vmcnt(" #n ")" ::: "memory")
#define PG8_WAIT_L(n) asm volatile("s_waitcnt lgkmcnt(" #n ")" ::: "memory")
#define PG8_BAR __builtin_amdgcn_s_barrier()
#define PG8_SCHED __builtin_amdgcn_sched_barrier(0)
    Unit cur, nxt; int ui = 0;
    if (!S.next(0, cur)) return;
    f32x4 acc[2][2][4][2];
#pragma unroll
    for (int a = 0; a < 2; ++a)
#pragma unroll
        for (int b = 0; b < 2; ++b)
#pragma unroll
            for (int m = 0; m < 4; ++m)
#pragma unroll
                for (int n = 0; n < 2; ++n) acc[a][b][m][n] = (f32x4){0.f, 0.f, 0.f, 0.f};
    bf16x8 At[4][2], B0[2][2], B1[2][2];
    const char* cA = (const char*)g.A + (size_t)cur.pm * tstep; const char* cB = (const char*)g.Bt + (size_t)cur.pn * tstep;
    S.a_ready(cur);
    if constexpr (Epi::PREFETCH) E.prefetch(cur, lds + STAGE_BYTES, wid, lane);
    if constexpr (SP2) {
        PG8_STAGE(PG8_SB(0, 0), cB, voffB); PG8_STAGE(PG8_SB(0, 1), cB + hstep, voffB); PG8_STAGE(PG8_SA(0, 0), cA, voffA); PG8_STAGE(PG8_SA(0, 1), cA + hstep, voffA);
        if (wr == 1) PG8_BAR;
        PG8_WAIT_V(2); PG8_BAR;
        PG8_STAGE(PG8_SB(1, 0), cB + kstep, voffB); PG8_STAGE(PG8_SA(1, 0), cA + kstep, voffA); PG8_STAGE(PG8_SB(1, 1), cB + hstep + kstep, voffB);
        PG8_WAIT_V(6); PG8_BAR;
    } else {
        PG8_STAGE(PG8_SB(0, 0), cB, voffB); PG8_STAGE(PG8_SA(0, 0), cA, voffA); PG8_STAGE(PG8_SB(0, 1), cB + hstep, voffB); PG8_STAGE(PG8_SA(0, 1), cA + hstep, voffA);
        if (wr == 1) PG8_BAR;
        PG8_WAIT_V(4); PG8_BAR;
        PG8_STAGE(PG8_SB(1, 0), cB + kstep, voffB); PG8_STAGE(PG8_SA(1, 0), cA + kstep, voffA); PG8_STAGE(PG8_SB(1, 1), cB + hstep + kstep, voffB);
        PG8_WAIT_V(6); PG8_BAR;
    }
    long ksc = (long)kstep;
    for (;;) {
        const bool has_next = S.next(ui + 1, nxt);
        const bool nrev = Epi::KSERP && has_next && (((ui + 1) & 1) != 0);
        const long ksn = has_next ? (nrev ? -(long)kstep : (long)kstep) : ksc;
        const size_t nofs = nrev ? (size_t)(nt - 1) * kstep : (size_t)0;
        const char* nA = has_next ? (const char*)g.A + (size_t)nxt.pm * tstep + nofs : cA; const char* nB = has_next ? (const char*)g.Bt + (size_t)nxt.pn * tstep + nofs : cB;
        for (int t = 0; t < nt; t += 2) {
            if constexpr (Epi::PREFETCH) { if (t == 2 && ui > 0) E.prefetch(cur, lds + STAGE_BYTES, wid, lane); }
            if constexpr (Epi::MIDSCALE) { if (t == Epi::MID_T) E.midscale(acc, wr, fr, fq, lds + STAGE_BYTES); }
            const bool last = (t == nt - 2);
            const char* a1 = cA + (long)(t + 1) * ksc;
            const char* a2 = last ? nA : cA + (long)(t + 2) * ksc; const char* b2 = last ? nB : cB + (long)(t + 2) * ksc;
            const long ks3 = last ? ksn : ksc;
            const char* a3 = a2 + ks3; const char* b3 = b2 + ks3;
            if (last && has_next) S.a_ready(nxt);
            if constexpr (SP2) {
            PG8_LDB(B0, 0, 0); PG8_LDB(B1, 0, 1); PG8_SCHED; PG8_LDA(At, 0, 0); PG8_STAGE(PG8_SA(1, 1), a1 + hstep, voffA);
            PG8_WAIT_V(8); PG8_WAIT_L(0); PG8_BAR; PG8_MMA(0, 0, At, B0); PG8_MMA(0, 1, At, B1); PG8_BAR; PG8_SCHED;
            PG8_LDA(At, 0, 1); PG8_STAGE(PG8_SB(0, 0), b2, voffB); PG8_STAGE(PG8_SB(0, 1), b2 + hstep, voffB); PG8_STAGE(PG8_SA(0, 0), a2, voffA);
            PG8_WAIT_V(8); PG8_WAIT_L(0); PG8_BAR; PG8_MMA(1, 0, At, B0); PG8_MMA(1, 1, At, B1); PG8_BAR; PG8_SCHED;
            PG8_LDB(B0, 1, 0); PG8_LDB(B1, 1, 1); PG8_SCHED; PG8_LDA(At, 1, 0); PG8_STAGE(PG8_SA(0, 1), a2 + hstep, voffA);
            PG8_WAIT_V(8); PG8_WAIT_L(0); PG8_BAR; PG8_MMA(0, 0, At, B0); PG8_MMA(0, 1, At, B1); PG8_BAR; PG8_SCHED;
            PG8_LDA(At, 1, 1); PG8_STAGE(PG8_SB(1, 0), b3, voffB); PG8_STAGE(PG8_SB(1, 1), b3 + hstep, voffB); PG8_STAGE(PG8_SA(1, 0), a3, voffA);
            PG8_WAIT_V(8); PG8_WAIT_L(0); PG8_BAR; PG8_MMA(1, 0, At, B0); PG8_MMA(1, 1, At, B1); PG8_BAR; PG8_SCHED;
            } else {
            PG8_LDB(B0, 0, 0); PG8_SCHED; PG8_LDA(At, 0, 0); PG8_STAGE(PG8_SA(1, 1), a1 + hstep, voffA);
            PG8_WAIT_L(8); PG8_BAR; PG8_WAIT_L(0); PG8_MMA(0, 0, At, B0); PG8_BAR; PG8_SCHED;
            PG8_LDB(B1, 0, 1); PG8_STAGE(PG8_SB(0, 0), b2, voffB);
            PG8_BAR; PG8_WAIT_L(0); PG8_MMA(0, 1, At, B1); PG8_BAR;
            PG8_LDA(At, 0, 1); PG8_STAGE(PG8_SA(0, 0), a2, voffA);
            PG8_BAR; PG8_WAIT_L(0); PG8_MMA(1, 0, At, B0); PG8_BAR; PG8_SCHED;
            PG8_STAGE(PG8_SB(0, 1), b2 + hstep, voffB);
            PG8_WAIT_V(6); PG8_BAR; PG8_MMA(1, 1, At, B1); PG8_BAR;
            PG8_LDB(B0, 1, 0); PG8_SCHED; PG8_LDA(At, 1, 0); PG8_STAGE(PG8_SA(0, 1), a2 + hstep, voffA);
            PG8_WAIT_L(8); PG8_BAR; PG8_WAIT_L(0); PG8_MMA(0, 0, At, B0); PG8_BAR; PG8_SCHED;
            PG8_LDB(B1, 1, 1); PG8_STAGE(PG8_SB(1, 0), b3, voffB);
            PG8_BAR; PG8_WAIT_L(0); PG8_MMA(0, 1, At, B1); PG8_BAR;
            PG8_LDA(At, 1, 1); PG8_STAGE(PG8_SA(1, 0), a3, voffA);
            PG8_BAR; PG8_WAIT_L(0); PG8_MMA(1, 0, At, B0); PG8_BAR; PG8_SCHED;
            PG8_STAGE(PG8_SB(1, 1), b3 + hstep, voffB);
            PG8_WAIT_V(6); PG8_BAR; PG8_MMA(1, 1, At, B1); PG8_BAR;
            }
        }
        if constexpr (ALIGN_EPI) { if (wr == 0) PG8_BAR; }
        if constexpr (!Epi::AFTER_DRAIN) { E(acc, cur, wr, wc, fr, fq, lds + STAGE_BYTES); S.done(cur); }
        if (!has_next) break;
        cur = nxt; cA = nA; cB = nB; ksc = ksn; ++ui;
        if constexpr (ALIGN_EPI) { if (wr == 1) PG8_BAR; }
    }
    PG8_WAIT_V(0);
    if constexpr (!ALIGN_EPI) { if (wr == 0) PG8_BAR; }
    PG8_BAR;
    if constexpr (Epi::AFTER_DRAIN) { E.fused(acc, cur, wr, wc, fr, fq, lds, wid, lane); S.done(cur); }
#undef PG8_SA
#undef PG8_SB
#undef PG8_STAGE
#undef PG8_LDA
#undef PG8_LDB
#undef PG8_MMA
#undef PG8_WAIT_V
#undef PG8_WAIT_L
#undef PG8_BAR
#undef PG8_SCHED
}
}
constexpr int NB = 16, SEQ = 2048, M = NB * SEQ, D = 1024, FF = 2816, NFI = 2 * FF, ZW = 3072, NIN = 2840, DEPTH = 4, MODW = 9216;
constexpr int ZKC = 512, ZVC = 640, ZKS = 768, ZVS = 896, ZKW = 1024, ZVW = 1152, ZHC = 1280, ZBG = 1792, ZCG = 2304, ZGT = 2816;
constexpr float EPS = 1e-6f;
constexpr float NEGB = -1e30f;
constexpr float C2 = 0.125f * 1.4426950408889634f;
constexpr float LOG2E = 1.4426950408889634f;

constexpr size_t MiB = 1u << 20;
constexpr size_t WS_CTL = 0, CTL_ZERO_BYTES = 64 * 1024;
constexpr size_t WS_MOD = 1 * MiB;
constexpr size_t WS_CB1 = 4 * MiB;
constexpr size_t WS_KCMP = 5 * MiB;
constexpr size_t WS_VCMP = 5 * MiB + 512 * 1024;
constexpr size_t WS_WC1T = 6 * MiB;
constexpr size_t WS_WMO = 8 * MiB;
constexpr size_t WS_WMI = 16 * MiB;
constexpr size_t WS_WFO = 40 * MiB;
constexpr size_t WS_WFI = 84 * MiB;
constexpr size_t WS_H = 172 * MiB;
constexpr size_t WS_ZB = 236 * MiB;
constexpr size_t WS_OATT = 428 * MiB;
constexpr size_t WS_SBW = 492 * MiB;
constexpr size_t WS_RSQ = 498 * MiB;
constexpr size_t WS_OMIX = 500 * MiB;
constexpr size_t WS_X = 564 * MiB;
constexpr size_t WS_ASQ = 628 * MiB;
constexpr size_t WS_END = 629 * MiB;
constexpr int CW_BAR = 4096;

constexpr int RING_BYTES = 131072;
constexpr int LDS_BYTES = 163840;
constexpr int CTRL_OFF = LDS_BYTES - 1024;
constexpr int MISC_OFF = CTRL_OFF + 320;

#define GAS __attribute__((address_space(1)))
#define LAS __attribute__((address_space(3)))
typedef unsigned short bf16;
typedef float f32x4 __attribute__((ext_vector_type(4)));
typedef float f32x16 __attribute__((ext_vector_type(16)));
typedef short bf16x8 __attribute__((ext_vector_type(8)));
typedef short s16x4 __attribute__((ext_vector_type(4)));
typedef unsigned u32x4 __attribute__((ext_vector_type(4)));
using pg8::u32x2;
typedef GAS unsigned gu32;
#define LBAR() do { asm volatile("s_waitcnt lgkmcnt(0)" ::: "memory"); __builtin_amdgcn_s_barrier(); asm volatile("" ::: "memory"); } while (0)
#define MFMA32(a, b, c) __builtin_amdgcn_mfma_f32_32x32x16_bf16((a), (b), (c), 0, 0, 0)
using pg8::cvt_pk_bf16;
using pg8::silu_f;

#define XB_TMO      128
#define XB_XCNT(j)  (256  + 64 * (j))
#define XB_XSUB(j)  (1280 + 64 * (j))
#define XB_XGEN(j)  (2304 + 64 * (j))
#define XB_TOP      3328
#define XB_TOPGEN   3392
#define XCD_BAR_WORDS 3456
#define XB_SPIN_CAP (1u << 18)

__device__ __forceinline__ unsigned xb_ld(unsigned* p)              { return __hip_atomic_load(p, __ATOMIC_RELAXED, __HIP_MEMORY_SCOPE_AGENT); }
__device__ __forceinline__ unsigned xb_add(unsigned* p, unsigned v) { return __hip_atomic_fetch_add(p, v, __ATOMIC_RELAXED, __HIP_MEMORY_SCOPE_AGENT); }
__device__ __forceinline__ unsigned xb_xcc_id() { return (unsigned)__builtin_amdgcn_s_getreg((3 << 11) | 20) & 0xFu; }
#define XB_SPIN(cond, bar) do { unsigned _sp = 0; while (cond) { __builtin_amdgcn_s_sleep(1); \
    if ((++_sp & 255u) == 0u) { if (xb_ld(&(bar)[XB_TMO])) break; if (_sp > XB_SPIN_CAP) { atomicAdd(&(bar)[XB_TMO], 1u); break; } } } } while (0)

struct XcdBarrier {
    unsigned* bar; unsigned x;
    volatile LAS unsigned* st;
};

__device__ __forceinline__ XcdBarrier xcd_barrier_post(unsigned* bar, volatile LAS unsigned* st) {
    XcdBarrier b; b.bar = bar; b.x = (unsigned)__builtin_amdgcn_readfirstlane((int)xb_xcc_id()); b.st = st;
    if (threadIdx.x == 0) (void)xb_add(&bar[XB_XCNT(b.x)], 1u);
    return b;
}
__device__ __forceinline__ void xcd_barrier_complete(unsigned* bar, unsigned x, unsigned& nloc, unsigned& nx) {
    const unsigned G = gridDim.x * gridDim.y * gridDim.z;
    unsigned sum, cnt, mine, sp = 0u;
    for (;;) {
        sum = 0u; cnt = 0u; mine = 0u;
#pragma unroll
        for (unsigned j = 0; j < 16; ++j) { const unsigned c = xb_ld(&bar[XB_XCNT(j)]); sum += c; cnt += (c > 0u) ? 1u : 0u; mine = (j == x) ? c : mine; }
        if (sum == G) break;
        __builtin_amdgcn_s_sleep(1);
        if ((++sp & 255u) == 0u) { if (xb_ld(&bar[XB_TMO])) break; if (sp > XB_SPIN_CAP) { atomicAdd(&bar[XB_TMO], 1u); break; } }
    }
    nloc = mine > 0u ? mine : 1u; nx = cnt > 0u ? cnt : 1u;
}

__device__ __forceinline__ void xcd_barrier(const XcdBarrier& b) {
    asm volatile("s_waitcnt vmcnt(0)" ::: "memory");
    __syncthreads();
    if (threadIdx.x == 0) {
        unsigned* bar = b.bar;
        __builtin_amdgcn_s_waitcnt(0);
        unsigned nloc = b.st[0], nx = b.st[1];
        if (nloc == 0u) { xcd_barrier_complete(bar, b.x, nloc, nx); b.st[0] = nloc; b.st[1] = nx; }
        const unsigned old = xb_add(&bar[XB_XSUB(b.x)], 1u);
        const unsigned gen = old / nloc;
        if (old + 1u == (gen + 1u) * nloc) {
            __builtin_amdgcn_fence(__ATOMIC_RELEASE, "agent");
            asm volatile("s_waitcnt vmcnt(0)" ::: "memory");
            const unsigned og = xb_add(&bar[XB_TOP], 1u);
            const unsigned tg = og / nx;
            if (og + 1u == (tg + 1u) * nx) xb_add(&bar[XB_TOPGEN], 1u);
            else XB_SPIN(xb_ld(&bar[XB_TOPGEN]) == tg, bar);
            __builtin_amdgcn_fence(__ATOMIC_ACQUIRE, "agent");
            xb_add(&bar[XB_XGEN(b.x)], 1u);
            asm volatile("s_waitcnt vmcnt(0)" ::: "memory");
        } else {
            XB_SPIN(xb_ld(&bar[XB_XGEN(b.x)]) == gen, bar);
            __builtin_amdgcn_fence(__ATOMIC_ACQUIRE, "agent");
            asm volatile("s_waitcnt vmcnt(0)" ::: "memory");
        }
    }
    __syncthreads();
}

__device__ __forceinline__ float shx(float v, int mask, int lane) { return __builtin_bit_cast(float, __builtin_amdgcn_ds_bpermute((lane ^ mask) << 2, __builtin_bit_cast(int, v))); }
__device__ __forceinline__ float max32x(float v) { const auto r = __builtin_amdgcn_permlane32_swap(__float_as_uint(v), __float_as_uint(v), false, false); return fmaxf(__uint_as_float(r[0]), __uint_as_float(r[1])); }
__device__ __forceinline__ float sum32x(float v) { const auto r = __builtin_amdgcn_permlane32_swap(__float_as_uint(v), __float_as_uint(v), false, false); return __uint_as_float(r[0]) + __uint_as_float(r[1]); }
template <int CTRL> __device__ __forceinline__ float dpp_f(float v) { return __builtin_bit_cast(float, __builtin_amdgcn_update_dpp(0, __builtin_bit_cast(int, v), CTRL, 0xf, 0xf, true)); }
__device__ __forceinline__ float sum8_dpp(float s) { s += dpp_f<0xB1>(s); s += dpp_f<0x4E>(s); s += dpp_f<0x141>(s); return s; }
__device__ __forceinline__ float sum16x(float v) { const auto r = __builtin_amdgcn_permlane16_swap(__float_as_uint(v), __float_as_uint(v), false, false); return __uint_as_float(r[0]) + __uint_as_float(r[1]); }
__device__ __forceinline__ float sum64_dpp(float s) { s = sum8_dpp(s); s += dpp_f<0x140>(s); s = sum16x(s); return sum32x(s); }
__device__ __forceinline__ float wave_sum(float v, int lane) { (void)lane; return sum64_dpp(v); }
__device__ __forceinline__ const bf16* zt(const bf16* zb, int row, int col) { return (const bf16*)((const char*)zb + pg8::tl_off(row, col, ZW)); }
__device__ __forceinline__ float bf2f(unsigned short h) { return __uint_as_float((unsigned)h << 16); }
__device__ __forceinline__ float bflo(unsigned w) { return __uint_as_float(w << 16); }
__device__ __forceinline__ float bfhi(unsigned w) { return __uint_as_float(w & 0xffff0000u); }
__device__ __forceinline__ float sigmoid_f(float x) { return __builtin_amdgcn_rcpf(1.0f + __builtin_amdgcn_exp2f(-LOG2E * x)); }
__device__ __forceinline__ int crow(int r, int hi) { return (r & 3) + 8 * (r >> 2) + 4 * hi; }

__device__ __forceinline__ int dst_row(int mode, int n) {
    if (mode == 1) { return n < FF ? (n >> 7) * 256 + (n & 127) : ((n - FF) >> 7) * 256 + 128 + ((n - FF) & 127); }
    if (mode == 2) { return n < 1280 ? n : (n < 1304 ? ZGT + (n - 1280) : n - 24); }
    return n;
}
__device__ __forceinline__ void transpose_item(const float* W, int K, int N, bf16* WT, LAS float* scr, int item, int lane, int mode, bool tiled = true) {
    const int nblk = (N + 63) >> 6, kb = item / nblk, nb = item - kb * nblk, k0 = 64 * kb, n0 = 64 * nb;
    const int kr = lane >> 4, c4 = (lane & 15) * 4; const bool inb = (n0 + c4) < N;
    const float* src = W + (size_t)(k0 + kr) * N + n0 + c4;
    f32x4 v[16];
#pragma unroll
    for (int i = 0; i < 16; ++i) v[i] = inb ? __builtin_nontemporal_load((const f32x4*)(src + (size_t)(4 * i) * N)) : (f32x4){0.f, 0.f, 0.f, 0.f};
#pragma unroll
    for (int i = 0; i < 16; ++i) { LAS float* d = scr + (4 * i + kr) * 65 + c4; d[0] = v[i].x; d[1] = v[i].y; d[2] = v[i].z; d[3] = v[i].w; }
    asm volatile("s_waitcnt lgkmcnt(0)" ::: "memory");
    const int c = lane & 7, r8 = lane >> 3;
#pragma unroll
    for (int j = 0; j < 8; ++j) { const int nl = r8 + 8 * j; const int n = n0 + nl; const LAS float* q = scr + (8 * c) * 65 + nl;
        u32x4 o; o.x = cvt_pk_bf16(q[0 * 65], q[1 * 65]); o.y = cvt_pk_bf16(q[2 * 65], q[3 * 65]); o.z = cvt_pk_bf16(q[4 * 65], q[5 * 65]); o.w = cvt_pk_bf16(q[6 * 65], q[7 * 65]);
        if (n < N) { if (tiled) *(u32x4*)((char*)WT + pg8::tl_off(dst_row(mode, n), k0 + 8 * c, K)) = o; else *(u32x4*)(WT + (size_t)dst_row(mode, n) * K + k0 + 8 * c) = o; } }
    asm volatile("s_waitcnt lgkmcnt(0)" ::: "memory");
}

struct Args { const float* in[16]; float* out; unsigned char* ws; };
typedef __attribute__((address_space(4))) const Args* ArgsP;
__device__ __forceinline__ ArgsP get_args() { unsigned long long p = (unsigned long long)__builtin_amdgcn_kernarg_segment_ptr(); asm volatile("" : "+s"(p)); return (ArgsP)p; }
struct Ctx { LAS unsigned char* L; int vcu, G, bx; };
__device__ __forceinline__ Ctx launder(const Ctx& c) { Ctx r; unsigned lb = (unsigned)(size_t)c.L; int v = c.vcu, g = c.G, bx = c.bx; asm volatile("" : "+s"(lb), "+s"(v), "+s"(g), "+s"(bx)); r.L = (LAS unsigned char*)(size_t)lb; r.vcu = v; r.G = g; r.bx = bx; return r; }
#define PHASE_IDS() int tid_ = threadIdx.x; asm volatile("" : "+v"(tid_)); const int tid = tid_; const int lane = tid & 63; const int wave = __builtin_amdgcn_readfirstlane(tid >> 6); (void)lane; (void)wave

__device__ __forceinline__ void prologue(const Ctx& C0) {
    PHASE_IDS(); const ArgsP A = get_args(); const Ctx C = launder(C0);
    {
        LAS float* scr = (LAS float*)(C.L + wave * 16640);
        const int gw = C.vcu * 8 + wave, NGW = C.G * 8;
        constexpr int I_FI = 16 * 88, I_FO = 44 * 16, I_MI = 16 * 45, I_MO = 16 * 16, I_C1 = 32 * 1;
        constexpr int N_FI = 8 * I_FI, N_FO = 8 * I_FO, N_MI = 4 * I_MI, N_MO = 4 * I_MO, N_C1 = 8 * I_C1;
        constexpr int NITEMS = N_FI + N_FO + N_MI + N_MO + N_C1;
        for (int it = gw; it < NITEMS; it += NGW) {
            int r = it;
            if (r < N_FI) { const int q = r / I_FI; transpose_item(A->in[5] + (size_t)q * D * NFI, D, NFI, (bf16*)(A->ws + WS_WFI) + (size_t)q * NFI * D, scr, r - q * I_FI, lane, 1); continue; } r -= N_FI;
            if (r < N_FO) { const int q = r / I_FO; transpose_item(A->in[6] + (size_t)q * FF * D, FF, D, (bf16*)(A->ws + WS_WFO) + (size_t)q * D * FF, scr, r - q * I_FO, lane, 0); continue; } r -= N_FO;
            if (r < N_MI) { const int q = r / I_MI; transpose_item(A->in[7] + (size_t)q * D * NIN, D, NIN, (bf16*)(A->ws + WS_WMI) + (size_t)q * ZW * D, scr, r - q * I_MI, lane, 2); continue; } r -= N_MI;
            if (r < N_MO) { const int q = r / I_MO; transpose_item(A->in[14] + (size_t)q * D * D, D, D, (bf16*)(A->ws + WS_WMO) + (size_t)q * D * D, scr, r - q * I_MO, lane, 0); continue; } r -= N_MO;
            { const int q = r / I_C1; transpose_item(A->in[9] + (size_t)q * 2048 * 64, 2048, 64, (bf16*)(A->ws + WS_WC1T) + (size_t)q * 64 * 2048, scr, r - q * I_C1, lane, 0, false); }
        }
        const int gt = C.vcu * 512 + tid, NGT = C.G * 512;
        for (int i = gt; i < 4 * 232 * 128; i += NGT) { const int l = i / (232 * 128), rr = i - l * (232 * 128); const int row = NIN + rr / 128, ch = rr & 127;
            *(u32x4*)((char*)((bf16*)(A->ws + WS_WMI) + (size_t)l * ZW * D) + pg8::tl_off(row, ch * 8, D)) = (u32x4){0u, 0u, 0u, 0u}; }
    }
    __syncthreads();
    {
        LAS float* cact = (LAS float*)C.L;
        LAS float* red = (LAS float*)(C.L + 65536);
        for (int i = tid; i < NB * D; i += 512) cact[i] = silu_f(A->in[1][i]);
        __syncthreads();
        const int cj = tid & 63, ks = tid >> 6;
        float* mod = (float*)(A->ws + WS_MOD);
        {
            const int c4 = (lane & 7) * 4, kk = lane >> 3;
            for (int item = C.vcu; item < DEPTH * (MODW / 32); item += C.G) {
                const int l = item / (MODW / 32), jb = item - l * (MODW / 32);
                const float* w = A->in[2] + (size_t)l * D * MODW + (size_t)(ks * 128 + kk) * MODW + jb * 32 + c4;
                f32x4 wv[16];
#pragma unroll
                for (int i = 0; i < 16; ++i) wv[i] = __builtin_nontemporal_load((const f32x4*)(w + (size_t)(8 * i) * MODW));
                f32x4 acc[16];
#pragma unroll
                for (int b = 0; b < 16; ++b) acc[b] = (f32x4){0.f, 0.f, 0.f, 0.f};
#pragma unroll
                for (int i = 0; i < 16; ++i) { const LAS float* cp = cact + ks * 128 + 8 * i + kk;
#pragma unroll
                    for (int b = 0; b < 16; ++b) acc[b] += wv[i] * cp[b * D]; }
#pragma unroll
                for (int b = 0; b < 16; ++b)
#pragma unroll
                    for (int e = 0; e < 4; ++e) { float s = acc[b][e]; s += dpp_f<0x128>(s); s = sum16x(s); acc[b][e] = sum32x(s); }
                if (kk == 0) {
#pragma unroll
                    for (int b = 0; b < 16; ++b) *(LAS f32x4*)(red + (ks * 16 + b) * 32 + c4) = acc[b]; }
                __syncthreads();
                { const int b = tid >> 5, c = tid & 31; float s = A->in[3][l * MODW + jb * 32 + c];
#pragma unroll
                  for (int q = 0; q < 8; ++q) s += red[(q * 16 + b) * 32 + c];
                  mod[((size_t)l * NB + b) * MODW + jb * 32 + c] = s; }
                __syncthreads();
            }
        }
        for (int item = C.vcu; item < 8; item += C.G) {
            const float* pos = A->in[8] + (size_t)item * 2048; const float* w1 = A->in[9] + (size_t)item * 2048 * 64;
            float s = 0.f;
            for (int k = ks * 256; k < ks * 256 + 256; ++k) s += pos[k] * w1[(size_t)k * 64 + cj];
            red[ks * 64 + cj] = s;
            __syncthreads();
            if (tid < 64) { float t = 0.f;
#pragma unroll
                for (int q = 0; q < 8; ++q) t += red[q * 64 + tid];
                ((float*)(A->ws + WS_CB1))[item * 64 + tid] = t; }
            __syncthreads();
        }
    }
}

typedef float f32x4v __attribute__((ext_vector_type(4)));
__device__ __forceinline__ void prologue2(const Ctx& C0) {
    PHASE_IDS(); const ArgsP A = get_args(); const Ctx C = launder(C0);
    const int gw = C.vcu * 8 + wave, NGW = C.G * 8;
    {
        const float* mod = (const float*)(A->ws + WS_MOD); float* sbw = (float*)(A->ws + WS_SBW);
        constexpr int T_FF = NFI / 16, T_MI = ZW / 16, T_L = 2 * T_FF + T_MI;
        const int bi = lane & 15, kq = lane >> 4;
        for (int it = gw; it < DEPTH * T_L; it += NGW) {
            const int l = it / T_L; int r = it - l * T_L; int sub, t; const bf16* Bt;
            if (r < T_FF) { sub = 0; t = r; Bt = (const bf16*)(A->ws + WS_WFI) + (size_t)(l * 2) * NFI * D; }
            else if (r < T_FF + T_MI) { sub = 1; t = r - T_FF; Bt = (const bf16*)(A->ws + WS_WMI) + (size_t)l * ZW * D; }
            else { sub = 2; t = r - T_FF - T_MI; Bt = (const bf16*)(A->ws + WS_WFI) + (size_t)(l * 2 + 1) * NFI * D; }
            const float* sh = mod + ((size_t)l * NB + bi) * MODW + sub * 3072 + 8 * kq;
            const char* bp = (const char*)Bt + pg8::tl_off(16 * t + bi, 8 * kq, D);
            f32x4v acc = {0.f, 0.f, 0.f, 0.f};
#pragma unroll 8
            for (int s = 0; s < 32; ++s) { const f32x4 a0 = *(const f32x4*)(sh + 32 * s), a1 = *(const f32x4*)(sh + 32 * s + 4);
                const u32x4 aw = {cvt_pk_bf16(a0.x, a0.y), cvt_pk_bf16(a0.z, a0.w), cvt_pk_bf16(a1.x, a1.y), cvt_pk_bf16(a1.z, a1.w)};
                const bf16x8 bv = *(const bf16x8*)(bp + 1024 * s);
                acc = __builtin_amdgcn_mfma_f32_16x16x32_bf16(__builtin_bit_cast(bf16x8, aw), bv, acc, 0, 0, 0); }
            float* op = sbw + ((size_t)(3 * l + sub) * NB + 4 * kq) * NFI + 16 * t + bi;
#pragma unroll
            for (int e = 0; e < 4; ++e) op[(size_t)e * NFI] = acc[e];
        }
    }
    {
        const float* xin = A->in[0]; bf16* hs = (bf16*)(A->ws + WS_H); float* rowsq = (float*)(A->ws + WS_RSQ); unsigned* x16 = (unsigned*)(A->ws + WS_X);
        const float* g = A->in[4]; const float* mod = (const float*)(A->ws + WS_MOD);
        const int rr = lane >> 2, ch = lane & 3;
        for (int rb = gw; rb < M / 16; rb += NGW) {
            const int row = 16 * rb + rr, b = row >> 11;
            const float* sc = mod + (size_t)b * MODW + D; const float* xr = xin + (size_t)row * D;
            float s = 0.f;
#pragma unroll 4
            for (int cb = 0; cb < 32; ++cb) { const int c = 32 * cb + 8 * ch;
                const f32x4 v0 = __builtin_nontemporal_load((const f32x4*)(xr + c)), v1 = __builtin_nontemporal_load((const f32x4*)(xr + c + 4));
                s += ((v0.x * v0.x + v0.y * v0.y) + (v0.z * v0.z + v0.w * v0.w)) + ((v1.x * v1.x + v1.y * v1.y) + (v1.z * v1.z + v1.w * v1.w));
                const f32x4 y0 = v0 * *(const f32x4*)(g + c) * (*(const f32x4*)(sc + c) + 1.0f), y1 = v1 * *(const f32x4*)(g + c + 4) * (*(const f32x4*)(sc + c + 4) + 1.0f);
                const u32x4 o = {cvt_pk_bf16(y0.x, y0.y), cvt_pk_bf16(y0.z, y0.w), cvt_pk_bf16(y1.x, y1.y), cvt_pk_bf16(y1.z, y1.w)};
                *(u32x4*)((char*)hs + pg8::tl_off(row, c, D)) = o;
                const u32x4 xw = {pg8::cvt_pk_f16(v0.x, v0.y), pg8::cvt_pk_f16(v0.z, v0.w), pg8::cvt_pk_f16(v1.x, v1.y), pg8::cvt_pk_f16(v1.z, v1.w)};
                *(u32x4*)((char*)x16 + pg8::tl_off(row, c, D)) = xw; }
            s += dpp_f<0xB1>(s); s += dpp_f<0x4E>(s);
            rowsq[(size_t)ch * M + row] = ch == 0 ? s : 0.f;
        }
    }
}
__device__ __forceinline__ void finalnorm_phase(const Ctx& C0) {
    PHASE_IDS(); const ArgsP A = get_args(); const Ctx C = launder(C0);
    const unsigned char* x16 = A->ws + WS_X; float* out = A->out; const float* g = A->in[15]; const float* rowsq = (const float*)(A->ws + WS_RSQ);
    const int gw = C.vcu * 8 + wave, NGW = C.G * 8;
    const int rr = lane >> 2, ch = lane & 3;
    for (int rb = gw; rb < M / 16; rb += NGW) {
        const int row = 16 * rb + rr;
        float s = rowsq[(size_t)ch * M + row];
        s += dpp_f<0xB1>(s); s += dpp_f<0x4E>(s);
        const float rstd = __builtin_amdgcn_rsqf(s * (1.0f / D) + EPS);
        float* orow = out + (size_t)row * D;
#pragma unroll 8
        for (int cb = 0; cb < 32; ++cb) { const int c = 32 * cb + 8 * ch;
            const u32x4 p = *(const u32x4*)(x16 + pg8::tl_off(row, c, D));
            const f32x4 v0 = pg8::unpack_f16x4((u32x2){p.x, p.y}), v1 = pg8::unpack_f16x4((u32x2){p.z, p.w});
            *(f32x4*)(orow + c) = v0 * rstd * *(const f32x4*)(g + c); *(f32x4*)(orow + c + 4) = v1 * rstd * *(const f32x4*)(g + c + 4); }
    }
}
__device__ __forceinline__ void unpack8(const u32x4 w, float (&f)[8]) {
    f[0] = bflo(w.x); f[1] = bfhi(w.x); f[2] = bflo(w.y); f[3] = bfhi(w.y); f[4] = bflo(w.z); f[5] = bfhi(w.z); f[6] = bflo(w.w); f[7] = bfhi(w.w);
}
__device__ __forceinline__ void postmix_phase(const Ctx& C0, int l) {
    PHASE_IDS(); const ArgsP A = get_args(); const Ctx C = launder(C0);
    const float* oatt = (const float*)(A->ws + WS_OATT); const bf16* z = (const bf16*)(A->ws + WS_ZB); bf16* omix = (bf16*)(A->ws + WS_OMIX);
    const float* conv_w = A->in[11] + (size_t)l * 3 * 512; const float* conv_b = A->in[12] + (size_t)l * 512; const float* gout = A->in[13] + (size_t)l * D;
    const int gw = C.vcu * 8 + wave, NGW = C.G * 8; const int c8 = lane * 8;
    float w0[8], w1[8], w2[8], cb[8], ga[8], gc[8];
#pragma unroll
    for (int e = 0; e < 8; ++e) { w0[e] = conv_w[c8 + e]; w1[e] = conv_w[512 + c8 + e]; w2[e] = conv_w[1024 + c8 + e]; cb[e] = conv_b[c8 + e]; ga[e] = gout[c8 + e]; gc[e] = gout[512 + c8 + e]; }
    for (int ch = gw; ch < M / 16; ch += NGW) {
        const int row0 = ch * 16; const int s0 = row0 & (SEQ - 1);
        float um2[8], um1[8];
        if (s0 == 0) {
#pragma unroll
            for (int e = 0; e < 8; ++e) { um2[e] = 0.f; um1[e] = 0.f; }
        } else {
            float a[8], b[8];
            unpack8(*(const u32x4*)(z + (size_t)(row0 - 2) * ZW + ZHC + c8), a); unpack8(*(const u32x4*)(z + (size_t)(row0 - 2) * ZW + ZCG + c8), b);
#pragma unroll
            for (int e = 0; e < 8; ++e) um2[e] = a[e] * b[e];
            unpack8(*(const u32x4*)(z + (size_t)(row0 - 1) * ZW + ZHC + c8), a); unpack8(*(const u32x4*)(z + (size_t)(row0 - 1) * ZW + ZCG + c8), b);
#pragma unroll
            for (int e = 0; e < 8; ++e) um1[e] = a[e] * b[e];
        }
        f32x4 na0 = *(const f32x4*)(oatt + (size_t)row0 * 512 + c8), na1 = *(const f32x4*)(oatt + (size_t)row0 * 512 + c8 + 4);
        u32x4 nhc = *(const u32x4*)(z + (size_t)row0 * ZW + ZHC + c8), nbg = *(const u32x4*)(z + (size_t)row0 * ZW + ZBG + c8), ncg = *(const u32x4*)(z + (size_t)row0 * ZW + ZCG + c8);
        for (int i = 0; i < 16; ++i) {
            const size_t row = (size_t)(row0 + i);
            const f32x4 a0 = na0, a1 = na1; const u32x4 whc = nhc, wbg = nbg, wcg = ncg;
            { const size_t rn = (size_t)(row0 + (i < 15 ? i + 1 : 15));
              na0 = *(const f32x4*)(oatt + rn * 512 + c8); na1 = *(const f32x4*)(oatt + rn * 512 + c8 + 4);
              nhc = *(const u32x4*)(z + rn * ZW + ZHC + c8); nbg = *(const u32x4*)(z + rn * ZW + ZBG + c8); ncg = *(const u32x4*)(z + rn * ZW + ZCG + c8); }
            float ss = (a0.x * a0.x + a0.y * a0.y) + (a0.z * a0.z + a0.w * a0.w) + (a1.x * a1.x + a1.y * a1.y) + (a1.z * a1.z + a1.w * a1.w);
            float hc[8], bg[8], cg[8], oc[8];
            unpack8(whc, hc); unpack8(wbg, bg); unpack8(wcg, cg);
            float s2 = 0.f;
#pragma unroll
            for (int e = 0; e < 8; ++e) { const float u = cg[e] * hc[e]; const float v = cb[e] + um2[e] * w0[e] + um1[e] * w1[e] + u * w2[e]; oc[e] = bg[e] * v; s2 += oc[e] * oc[e]; um2[e] = um1[e]; um1[e] = u; }
#pragma unroll
            for (int o = 1; o < 64; o <<= 1) { ss += shx(ss, o, lane); s2 += shx(s2, o, lane); }
            const float rs = __builtin_amdgcn_rsqf(ss * (1.0f / 512.0f) + EPS), rc = __builtin_amdgcn_rsqf(s2 * (1.0f / 512.0f) + EPS);
            u32x4 o;
            o.x = cvt_pk_bf16(a0.x * rs * ga[0], a0.y * rs * ga[1]); o.y = cvt_pk_bf16(a0.z * rs * ga[2], a0.w * rs * ga[3]);
            o.z = cvt_pk_bf16(a1.x * rs * ga[4], a1.y * rs * ga[5]); o.w = cvt_pk_bf16(a1.z * rs * ga[6], a1.w * rs * ga[7]);
            *(u32x4*)(omix + row * D + c8) = o;
            o.x = cvt_pk_bf16(oc[0] * rc * gc[0], oc[1] * rc * gc[1]); o.y = cvt_pk_bf16(oc[2] * rc * gc[2], oc[3] * rc * gc[3]);
            o.z = cvt_pk_bf16(oc[4] * rc * gc[4], oc[5] * rc * gc[5]); o.w = cvt_pk_bf16(oc[6] * rc * gc[6], oc[7] * rc * gc[7]);
            *(u32x4*)(omix + row * D + 512 + c8) = o;
        }
    }
}

__device__ __forceinline__ void compress_phase(const Ctx& C0, int l) {
    PHASE_IDS(); const ArgsP A = get_args(); const Ctx C = launder(C0);
    const bf16* z = (const bf16*)(A->ws + WS_ZB); const bf16* w1T = (const bf16*)(A->ws + WS_WC1T) + (size_t)l * 2 * 64 * 2048; const float* cb1 = (const float*)(A->ws + WS_CB1) + l * 128;
    const float* w2 = A->in[10] + (size_t)l * 2 * 4096; bf16* kcmp = (bf16*)(A->ws + WS_KCMP); bf16* vcmp = (bf16*)(A->ws + WS_VCMP);
    const int wid = wave, r = lane & 31, h = lane >> 5;
    LAS float* part = (LAS float*)C.L;
    LAS float* y1 = (LAS float*)(C.L + 65536);
    for (int task = C.vcu; task < 256; task += C.G) {
        const int nt = task & 3, kv = (task >> 2) & 1, g = (task >> 3) & 1, b = task >> 4;
        const int colb = ZKC + kv * 128 + 64 * g;
        const int tokbase = 16 * (nt * 32 + r);
        const bf16* zb = z + (size_t)b * SEQ * ZW;
        const bf16* wT = w1T + (size_t)kv * 64 * 2048 + (size_t)r * 2048 + 8 * h;
        f32x16 acc0, acc1;
#pragma unroll
        for (int i = 0; i < 16; ++i) { acc0[i] = 0.f; acc1[i] = 0.f; }
#pragma unroll
        for (int ii = 0; ii < 4; ++ii) { const int i = wid * 4 + ii; int tok = tokbase + i; tok = tok > SEQ - 1 ? SEQ - 1 : tok;
            const bf16* b0p = wT + i * 64; const bf16* b1p = b0p + 32 * 2048;
#pragma unroll
            for (int dd = 0; dd < 4; ++dd) { const bf16x8 av = *(const bf16x8*)zt(zb, tok, colb + 8 * h + 16 * dd), b0 = *(const bf16x8*)(b0p + 16 * dd), b1 = *(const bf16x8*)(b1p + 16 * dd);
                acc0 = MFMA32(av, b0, acc0); acc1 = MFMA32(av, b1, acc1); } }
#pragma unroll
        for (int i = 0; i < 16; ++i) { const int nl = crow(i, h); part[(wid * 32 + nl) * 64 + r] = acc0[i]; part[(wid * 32 + nl) * 64 + 32 + r] = acc1[i]; }
        __syncthreads();
        const int nl = tid >> 4, oq = (tid & 15) * 4;
        { f32x4 s = *(const f32x4*)(cb1 + kv * 64 + oq);
#pragma unroll
          for (int w = 0; w < 8; ++w) s += *(const LAS f32x4*)(part + (w * 32 + nl) * 64 + oq);
          f32x4 y; y.x = silu_f(s.x); y.y = silu_f(s.y); y.z = silu_f(s.z); y.w = silu_f(s.w);
          *(LAS f32x4*)(y1 + nl * 64 + oq) = y; }
        __syncthreads();
        { f32x4 acc = {0.f, 0.f, 0.f, 0.f}; const float* w2p = w2 + kv * 4096 + oq;
          for (int o = 0; o < 64; ++o) { const float yv = y1[nl * 64 + o]; acc += *(const f32x4*)(w2p + o * 64) * yv; }
          const int n = nt * 32 + nl; if (n == 127) acc = (f32x4){0.f, 0.f, 0.f, 0.f};
          u32x2 ov; ov.x = cvt_pk_bf16(acc.x, acc.y); ov.y = cvt_pk_bf16(acc.z, acc.w);
          *(u32x2*)((kv ? vcmp : kcmp) + ((size_t)(b * 2 + g) * 128 + n) * 64 + oq) = ov; }
        __syncthreads();
    }
}

constexpr float MFLOOR = -1e20f;
constexpr int AK = 0, AV = 24576, AWS = 57344, AIMP = 59392, ASEL = 93184, AOT = 93440;
static_assert(AOT + 65536 <= CTRL_OFF, "attention LDS map");
typedef short v4i16_t __attribute__((ext_vector_type(4)));
__device__ __forceinline__ s16x4 vtr(const LAS unsigned char* p) { return __builtin_bit_cast(s16x4, __builtin_amdgcn_ds_read_tr16_b64_v4i16((LAS v4i16_t*)p)); }
#define PACKF(X, S) __builtin_bit_cast(bf16x8, (u32x4){cvt_pk_bf16(X[8 * (S)], X[8 * (S) + 1]), cvt_pk_bf16(X[8 * (S) + 2], X[8 * (S) + 3]), cvt_pk_bf16(X[8 * (S) + 4], X[8 * (S) + 5]), cvt_pk_bf16(X[8 * (S) + 6], X[8 * (S) + 7])})
#define PV_STEP(PF, KS) do { const bf16x8 pf_ = (PF); const int vo_ = ((KS) >> 2) * 8192 + ((KS) & 3) * 1024; \
    { const s16x4 lo_ = vtr(vp + vo_), hi_ = vtr(vp + vo_ + 512); const bf16x8 vf_ = {lo_[0], lo_[1], lo_[2], lo_[3], hi_[0], hi_[1], hi_[2], hi_[3]}; o0 = MFMA32(pf_, vf_, o0); } \
    { const s16x4 lo_ = vtr(vp + vo_ + 4096), hi_ = vtr(vp + vo_ + 4608); const bf16x8 vf_ = {lo_[0], lo_[1], lo_[2], lo_[3], hi_[0], hi_[1], hi_[2], hi_[3]}; o1 = MFMA32(pf_, vf_, o1); } } while (0)

constexpr int SLOTB = 8192, RK = 0, RV = 3 * SLOTB;
constexpr float MFL = -1000.0f;
typedef const LAS unsigned char* lcp;
__device__ __forceinline__ void glds16(const void* gsrc, unsigned lds_dst) { unsigned keep;
    asm volatile("s_mov_b32 %0, m0\n\ts_mov_b32 m0, %2\n\ts_nop 0\n\tglobal_load_lds_dwordx4 %1, off\n\ts_mov_b32 m0, %0" : "=&s"(keep) : "v"(gsrc), "s"(lds_dst) : "memory"); }
__device__ __forceinline__ void kload8(bf16x8* kf, lcp kp) {
    kf[0] = *(const LAS bf16x8*)(kp);        kf[1] = *(const LAS bf16x8*)(kp + 512);
    kf[2] = *(const LAS bf16x8*)(kp + 2048); kf[3] = *(const LAS bf16x8*)(kp + 2560);
    kf[4] = *(const LAS bf16x8*)(kp + 4096); kf[5] = *(const LAS bf16x8*)(kp + 4608);
    kf[6] = *(const LAS bf16x8*)(kp + 6144); kf[7] = *(const LAS bf16x8*)(kp + 6656); }
__device__ __forceinline__ void kload2(bf16x8* kf, lcp kp, int j) { kf[2 * j] = *(const LAS bf16x8*)(kp + j * 2048); kf[2 * j + 1] = *(const LAS bf16x8*)(kp + j * 2048 + 512); }
#define SBAR() __builtin_amdgcn_sched_barrier(0)
#define WAIT_BAR(N) asm volatile("s_waitcnt vmcnt(" #N ") lgkmcnt(0)\n\ts_barrier" ::: "memory")
#define MX3(a, b, c) __builtin_fmaxf(__builtin_fmaxf((a), (b)), (c))
__device__ __forceinline__ float rowmax32(const f32x16& C0, const f32x16& C1) {
    float a = MX3(C0[0], C0[1], C1[0]), b = MX3(C0[2], C0[3], C1[1]); a = MX3(a, C1[2], C1[3]);
#pragma unroll
    for (int r = 4; r < 16; r += 4) { a = MX3(a, C0[r], C0[r + 1]); b = MX3(b, C0[r + 2], C0[r + 3]); a = MX3(a, C1[r], C1[r + 1]); b = MX3(b, C1[r + 2], C1[r + 3]); }
    return max32x(__builtin_fmaxf(a, b)); }
__device__ __forceinline__ void attn_issue(LAS unsigned char* L, const bf16* zb, int kcol, int vcol, int jlo, int n, int tid_in, int wid) {
    int tid = tid_in; asm volatile("" : "+v"(tid)); const int lane = tid & 63;
    const unsigned lds0 = (unsigned)(size_t)L;
    const bf16* ksrc = zt(zb, 64 * jlo + lane, kcol + wid * 8);
    const bf16* vsrc = zt(zb, 64 * jlo + 16 * (wid & 3) + (lane >> 2), vcol + (wid >> 2) * 32 + (lane & 3) * 8);
    const unsigned kdst = lds0 + RK + wid * 1024, vdst = lds0 + RV + wid * 1024;
    glds16(ksrc, (unsigned)__builtin_amdgcn_readfirstlane(kdst)); glds16(vsrc, (unsigned)__builtin_amdgcn_readfirstlane(vdst));
    if (n > 1) glds16(ksrc + (size_t)64 * ZW, (unsigned)__builtin_amdgcn_readfirstlane(kdst + SLOTB));
    if (n > 2) glds16(ksrc + (size_t)128 * ZW, (unsigned)__builtin_amdgcn_readfirstlane(kdst + 2 * SLOTB));
    if (n > 1) glds16(vsrc + (size_t)64 * ZW, (unsigned)__builtin_amdgcn_readfirstlane(vdst + SLOTB));
}
template <int MODE, bool PRE = false, int THRL = 8>
__device__ __forceinline__ void attn_branch(LAS unsigned char* L, const bf16* zb, int kcol, int vcol, int jlo, int jhi, int qt, int qrel, unsigned selbits,
                                            const bf16x8 (&qr)[4], f32x16& o0, f32x16& o1, float& lout, int tid_in, int wid) {
    int tid = tid_in; asm volatile("" : "+v"(tid)); const int lane = tid & 63;
    const int r32 = lane & 31, hi = lane >> 5;
    const unsigned lds0 = (unsigned)(size_t)L;
    LAS float* wsf = (LAS float*)(L + AWS) + wid * 64;
    const int n = jhi - jlo + 1;
    const bf16* ksrc = zt(zb, 64 * jlo + lane, kcol + wid * 8);
    const bf16* vsrc = zt(zb, 64 * jlo + 16 * (wid & 3) + (lane >> 2), vcol + (wid >> 2) * 32 + (lane & 3) * 8);
    const unsigned kdst = lds0 + RK + wid * 1024, vdst = lds0 + RV + wid * 1024;
#define DMA_K(t, slot) glds16(ksrc + (size_t)(t) * 64 * ZW, (unsigned)__builtin_amdgcn_readfirstlane(kdst + (slot)))
#define DMA_V(t, slot) glds16(vsrc + (size_t)(t) * 64 * ZW, (unsigned)__builtin_amdgcn_readfirstlane(vdst + (slot)))
    const lcp kp0 = L + RK + hi * 1024 + r32 * 16;
    const lcp vp0 = L + RV + ((lane >> 4) & 1) * 32 + (lane & 3) * 8 + (4 * hi + ((lane & 15) >> 2)) * 64;
    const int clim = qrel - 4 * hi;
    if (!PRE) {
        LBAR();
        DMA_K(0, 0); DMA_V(0, 0); if (n > 1) DMA_K(1, SLOTB); if (n > 2) DMA_K(2, 2 * SLOTB); if (n > 1) DMA_V(1, SLOTB);
    }
    float mhat = 0.f, l_reg = 0.f; f32x16 o[2];
#pragma unroll
    for (int i = 0; i < 16; ++i) { o[0][i] = 0.f; o[1][i] = 0.f; }
    f32x16 negm;
#pragma unroll
    for (int i = 0; i < 16; ++i) negm[i] = 0.f;
    asm volatile("" : "+v"(negm));
    if (n > 2) WAIT_BAR(4); else if (n > 1) WAIT_BAR(3); else WAIT_BAR(1);
    f32x16 pA0, pA1, pB0, pB1;
    bool resc = false;
#define CAUSAL(P0, P1) do { _Pragma("unroll") for (int r = 0; r < 16; ++r) { const int c0 = (r & 3) + 8 * (r >> 2); P0[r] = (c0 <= clim) ? P0[r] : NEGB; P1[r] = (c0 + 32 <= clim) ? P1[r] : NEGB; } } while (0)
    {
        const lcp kb = L + RK + hi * 1024 + r32 * 16;
#pragma unroll
        for (int d0 = 0; d0 < 4; ++d0) { const bf16x8 b0 = *(const LAS bf16x8*)(kb + d0 * 2048), b1 = *(const LAS bf16x8*)(kb + d0 * 2048 + 512);
            if (d0 == 0) { pA0 = MFMA32(b0, qr[0], negm); pA1 = MFMA32(b1, qr[0], negm); } else { pA0 = MFMA32(b0, qr[d0], pA0); pA1 = MFMA32(b1, qr[d0], pA1); } }
        if (MODE == 1 && qt >= 8) {
#pragma unroll
            for (int r = 0; r < 16; ++r) { const int c0 = (r & 3) + 8 * (r >> 2); pA0[r] = (c0 > clim) ? pA0[r] : NEGB; pA1[r] = (c0 + 32 > clim) ? pA1[r] : NEGB; }
        }
        if (n == 1) CAUSAL(pA0, pA1);
        const float rm = rowmax32(pA0, pA1);
        const float dl = __builtin_fmaxf(rm, MFL); mhat = dl;
#pragma unroll
        for (int r = 0; r < 16; ++r) { pA0[r] -= dl; pA1[r] -= dl; }
#pragma unroll
        for (int r = 0; r < 16; ++r) negm[r] = -mhat;
        asm volatile("" : "+v"(negm));
#pragma unroll
        for (int r = 0; r < 16; ++r) { pA0[r] = __builtin_amdgcn_exp2f(pA0[r]); pA1[r] = __builtin_amdgcn_exp2f(pA1[r]); }
    }
    WAIT_BAR(0);
    if (n > 3) DMA_K(3, 0);
    if (n > 2) DMA_V(2, 2 * SLOTB);
    int sl_prev = 0, sl_cur = SLOTB, sl_next = 2 * SLOTB;
#define ROT() do { sl_prev = sl_cur; sl_cur = sl_next; sl_next = (sl_next == 2 * SLOTB) ? 0 : sl_next + SLOTB; } while (0)
    bf16x8 kf[8];
    kload8(kf, kp0 + sl_cur);
    WAIT_BAR(2);
#define RESC() do { if (resc) { asm volatile("s_waitcnt lgkmcnt(0)" ::: "memory"); \
        _Pragma("unroll") for (int d_ = 0; d_ < 2; ++d_) _Pragma("unroll") for (int r = 0; r < 16; ++r) o[d_][r] *= wsf[crow(r, hi)]; } } while (0)
    s16x4 vlo[8], vhi[8]; u32x4 pw0, pw1, pw2, pw3;
#define PKW(P, B) cvt_pk_bf16(P[B], P[B + 1])
#define PAF(k) __builtin_bit_cast(bf16x8, pw##k)
#define VFR(i) (bf16x8){vlo[i][0], vlo[i][1], vlo[i][2], vlo[i][3], vhi[i][0], vhi[i][1], vhi[i][2], vhi[i][3]}
#define PIN(x) asm volatile("" : "+v"(x))
#define GAPA(MF, A0, A1, A2, A3, W0, W1, PW) do { MF; sacc += A0; sacc += A1; sacc += A2; sacc += A3; PIN(sacc); W0; W1; PIN(PW); SBAR(); } while (0)
#define EX(v) __builtin_amdgcn_exp2f(v)
#define GAPB(MF, X, B) do { MF; X[B] = EX(X[B]); X[B + 1] = EX(X[B + 1]); X[B + 2] = EX(X[B + 2]); X[B + 3] = EX(X[B + 3]); PIN(X); SBAR(); } while (0)
#define VRD(i) do { vlo[i] = vtr(vp_ + (((i) >> 2) * 4096 + ((i) & 3) * 1024)); vhi[i] = vtr(vp_ + (((i) >> 2) * 4096 + ((i) & 3) * 1024 + 512)); } while (0)
#define KRD(G, j) do { if (G) { kload2(kf, kp0 + sl_next, j); SBAR(); } } while (0)
#define STEP(C0, C1, P0, P1, t, GK, GV, GL) do { \
    if (MODE == 0) { const float nv_ = ((selbits >> (t)) & 1u) ? -mhat : NEGB; _Pragma("unroll") for (int r = 0; r < 16; ++r) negm[r] = nv_; PIN(negm); } \
    SBAR(); \
    const lcp vp_ = vp0 + ((((t) - 1) & 3) * SLOTB); \
    VRD(0); SBAR(); float sacc = (P0[0] + P0[1]); \
    GAPA(C0 = MFMA32(kf[0], qr[0], negm), P0[2], P0[3], P0[4], P0[5],     pw0[0] = PKW(P0, 0), pw0[1] = PKW(P0, 2), pw0); \
    VRD(4); SBAR(); GAPA(C1 = MFMA32(kf[1], qr[0], negm), P0[6], P0[7], P0[8], P0[9],     pw0[2] = PKW(P0, 4), pw0[3] = PKW(P0, 6), pw0); \
    VRD(1); SBAR(); GAPA(C0 = MFMA32(kf[2], qr[1], C0),   P0[10], P0[11], P0[12], P0[13], pw1[0] = PKW(P0, 8), pw1[1] = PKW(P0, 10), pw1); \
    VRD(5); SBAR(); GAPA(C1 = MFMA32(kf[3], qr[1], C1),   P0[14], P0[15], P1[0], P1[1],   pw1[2] = PKW(P0, 12), pw1[3] = PKW(P0, 14), pw1); \
    VRD(2); SBAR(); GAPA(C0 = MFMA32(kf[4], qr[2], C0),   P1[2], P1[3], P1[4], P1[5],     pw2[0] = PKW(P1, 0), pw2[1] = PKW(P1, 2), pw2); \
    VRD(6); SBAR(); GAPA(C1 = MFMA32(kf[5], qr[2], C1),   P1[6], P1[7], P1[8], P1[9],     pw2[2] = PKW(P1, 4), pw2[3] = PKW(P1, 6), pw2); \
    VRD(3); SBAR(); GAPA(C0 = MFMA32(kf[6], qr[3], C0),   P1[10], P1[11], P1[12], P1[13], pw3[0] = PKW(P1, 8), pw3[1] = PKW(P1, 10), pw3); \
    VRD(7); SBAR(); GAPA(C1 = MFMA32(kf[7], qr[3], C1),   P1[14], P1[15], 0.f, 0.f,       pw3[2] = PKW(P1, 12), pw3[3] = PKW(P1, 14), pw3); \
    l_reg += sacc; \
    if (GK) { DMA_K((t) + 3, sl_cur); } if (GV) { DMA_V((t) + 2, (((t) + 2) & 3) * SLOTB); } \
    if ((t) == n - 1) CAUSAL(C0, C1); \
    { float rm = rowmax32(C0, C1); \
      resc = false; \
      if (__builtin_expect(__any(rm > (float)THRL), 0)) { const float dl = __builtin_fmaxf(rm, 0.f); mhat += dl; \
        _Pragma("unroll") for (int r = 0; r < 16; ++r) { C0[r] -= dl; C1[r] -= dl; } \
        _Pragma("unroll") for (int r = 0; r < 16; ++r) negm[r] = -mhat; asm volatile("" : "+v"(negm)); \
        const float f = __builtin_amdgcn_exp2f(-dl); l_reg *= f; if (hi == 0) wsf[r32] = f; resc = true; } } \
    SBAR(); \
    GAPB(o[0] = MFMA32(PAF(0), VFR(0), o[0]), C0, 0); \
    GAPB(o[1] = MFMA32(PAF(0), VFR(4), o[1]), C0, 4); \
    KRD(GL, 0); GAPB(o[0] = MFMA32(PAF(1), VFR(1), o[0]), C0, 8); \
    KRD(GL, 1); GAPB(o[1] = MFMA32(PAF(1), VFR(5), o[1]), C0, 12); \
    KRD(GL, 2); GAPB(o[0] = MFMA32(PAF(2), VFR(2), o[0]), C1, 0); \
    KRD(GL, 3); GAPB(o[1] = MFMA32(PAF(2), VFR(6), o[1]), C1, 4); \
    GAPB(o[0] = MFMA32(PAF(3), VFR(3), o[0]), C1, 8); \
    GAPB(o[1] = MFMA32(PAF(3), VFR(7), o[1]), C1, 12); \
    } while (0)
#define ENDW(tt) do { if ((tt) + 3 < n) { WAIT_BAR(3); } else if ((tt) + 2 < n) { WAIT_BAR(2); } else if ((tt) + 1 < n) { WAIT_BAR(1); } else { WAIT_BAR(0); } } while (0)
    int t = 1;
    for (; t + 1 < n; t += 2) {
        STEP(pB0, pB1, pA0, pA1, t, (t + 3 < n), (t + 2 < n), (t + 1 < n));         ENDW(t);     RESC(); ROT();
        STEP(pA0, pA1, pB0, pB1, t + 1, (t + 4 < n), (t + 3 < n), (t + 2 < n));     ENDW(t + 1); RESC(); ROT();
    }
    if (t < n) {
        STEP(pB0, pB1, pA0, pA1, t, false, false, false); WAIT_BAR(0); RESC(); ROT();
        pA0 = pB0; pA1 = pB1;
    }
    { float sacc = pA0[0] + pA0[1];
#pragma unroll
      for (int r = 2; r < 16; ++r) sacc += pA0[r];
#pragma unroll
      for (int r = 0; r < 16; ++r) sacc += pA1[r];
      l_reg += sacc;
      pw0 = (u32x4){PKW(pA0, 0), PKW(pA0, 2), PKW(pA0, 4), PKW(pA0, 6)}; pw1 = (u32x4){PKW(pA0, 8), PKW(pA0, 10), PKW(pA0, 12), PKW(pA0, 14)};
      pw2 = (u32x4){PKW(pA1, 0), PKW(pA1, 2), PKW(pA1, 4), PKW(pA1, 6)}; pw3 = (u32x4){PKW(pA1, 8), PKW(pA1, 10), PKW(pA1, 12), PKW(pA1, 14)};
      const lcp vp_ = vp0 + (((n - 1) & 3) * SLOTB);
#pragma unroll
      for (int i = 0; i < 8; ++i) VRD(i);
      o[0] = MFMA32(PAF(0), VFR(0), o[0]); o[1] = MFMA32(PAF(0), VFR(4), o[1]);
      o[0] = MFMA32(PAF(1), VFR(1), o[0]); o[1] = MFMA32(PAF(1), VFR(5), o[1]);
      o[0] = MFMA32(PAF(2), VFR(2), o[0]); o[1] = MFMA32(PAF(2), VFR(6), o[1]);
      o[0] = MFMA32(PAF(3), VFR(3), o[0]); o[1] = MFMA32(PAF(3), VFR(7), o[1]); }
#undef PKW
#undef PAF
#undef VFR
#undef PIN
#undef GAPA
#undef GAPB
#undef EX
#undef VRD
#undef KRD
#undef STEP
#undef ENDW
#undef RESC
#undef ROT
#undef CAUSAL
#undef DMA_K
#undef DMA_V
    o0 = o[0]; o1 = o[1];
    lout = sum32x(l_reg);
}

__device__ __forceinline__ void unit_geom(int U, int& b, int& g, int& qt) { const int v = U & 255, ii = U >> 8, s = v & 7, bgp = v >> 3; b = bgp >> 1; g = bgp & 1; const unsigned w = (s == 0 ? 0x080a0c1cu : s == 1 ? 0x07090b1fu : s == 2 ? 0x030f1617u : s == 3 ? 0x01131419u : s == 4 ? 0x050d1218u : s == 5 ? 0x04061a1bu : s == 6 ? 0x000e151eu : 0x0210111du); qt = (int)((w >> (8 * ii)) & 255u); }
__device__ __forceinline__ void cmp_issue(LAS unsigned char* L, const bf16* kc, const bf16* vc, int tid_in, int wid) {
    int tid = tid_in; asm volatile("" : "+v"(tid)); const int lane = tid & 63;
    const unsigned lds0 = (unsigned)(size_t)L;
    const bf16* ksrc = kc + (size_t)lane * 64 + wid * 8;
    const bf16* vsrc = vc + (size_t)(16 * (wid & 3) + (lane >> 2)) * 64 + (wid >> 2) * 32 + (lane & 3) * 8;
    const unsigned kdst = lds0 + RK + wid * 1024, vdst = lds0 + RV + wid * 1024;
    glds16(ksrc, (unsigned)__builtin_amdgcn_readfirstlane(kdst)); glds16(ksrc + 64 * 64, (unsigned)__builtin_amdgcn_readfirstlane(kdst + SLOTB));
    glds16(vsrc, (unsigned)__builtin_amdgcn_readfirstlane(vdst)); glds16(vsrc + 64 * 64, (unsigned)__builtin_amdgcn_readfirstlane(vdst + SLOTB));
}
__device__ __forceinline__ void attn_phase(const Ctx& C0, int l) {
    PHASE_IDS(); const ArgsP A = get_args(); const Ctx C = launder(C0);
    const bf16* z = (const bf16*)(A->ws + WS_ZB); const bf16* kcmp = (const bf16*)(A->ws + WS_KCMP); const bf16* vcmp = (const bf16*)(A->ws + WS_VCMP); bf16* omix = (bf16*)(A->ws + WS_OMIX); float* asq = (float*)(A->ws + WS_ASQ);
    const float* conv_w = A->in[11] + (size_t)l * 3 * 512; const float* conv_b = A->in[12] + (size_t)l * 512; const float* gout = A->in[13] + (size_t)l * D;
    LAS unsigned char* L = C.L;
    const int wid = wave, hh = wid & 3, th = wid >> 2;
    if (wid >= 4) __builtin_amdgcn_s_setprio(1);
    bf16x8 qn[4]; unsigned short gn0, gn1, gn2;
#define UNIT_FETCH(UU) do { int b_, g_, qt_; unit_geom((UU), b_, g_, qt_); int tf_ = tid_; asm volatile("" : "+v"(tf_)); const int lf_ = tf_ & 63; \
        const bf16* zbq_ = z + (size_t)b_ * SEQ * ZW; const int rq_ = 64 * qt_ + 32 * th + (lf_ & 31); \
        _Pragma("unroll") for (int d0 = 0; d0 < 4; ++d0) qn[d0] = *(const bf16x8*)zt(zbq_, rq_, 64 * (4 * g_ + hh) + 16 * d0 + 8 * (lf_ >> 5)); \
        { const int gc_ = ZGT + 3 * (4 * g_ + hh); gn0 = *zt(zbq_, rq_, gc_); gn1 = *zt(zbq_, rq_, gc_ + 1); gn2 = *zt(zbq_, rq_, gc_ + 2); } \
        cmp_issue(L, kcmp + (size_t)(b_ * 2 + g_) * 128 * 64, vcmp + (size_t)(b_ * 2 + g_) * 128 * 64, tid_, wid); } while (0)
    if (C.vcu < 1024) UNIT_FETCH(C.vcu);
    for (int U = C.vcu; U < 1024; U += C.G) {
        int tid = tid_; asm volatile("" : "+v"(tid)); const int lane = tid & 63, r32 = lane & 31, hi = lane >> 5;
        LAS float* wsf = (LAS float*)(L + AWS) + wid * 64;
        LAS float* imp = (LAS float*)(L + AIMP); LAS unsigned* sel = (LAS unsigned*)(L + ASEL);
        int b, g, qt; unit_geom(U, b, g, qt);
        const int head = 4 * g + hh, qrel = 32 * th + r32, tq = 64 * qt + qrel;
        const bf16* zb = z + (size_t)b * SEQ * ZW;
        bf16x8 qr[4];
#pragma unroll
        for (int d0 = 0; d0 < 4; ++d0) qr[d0] = qn[d0];
        const float sg0 = sigmoid_f(bf2f(gn0)), sg1 = sigmoid_f(bf2f(gn1)), sg2 = sigmoid_f(bf2f(gn2));
        f32x16 o0, o1;
#pragma unroll
        for (int i = 0; i < 16; ++i) { o0[i] = 0.f; o1[i] = 0.f; }
        LAS float* otl = (LAS float*)(L + AOT) + wid * 2048 + lane;
        const lcp kp = L + RK + hi * 1024 + r32 * 16;
        const lcp vp = L + RV + ((lane >> 4) & 1) * 32 + (lane & 3) * 8 + (4 * hi + ((lane & 15) >> 2)) * 64;
        {
            WAIT_BAR(0);
            const int nlim = ((tq - 31) >> 4) - 4 * hi;
            f32x16 pu[4];
#pragma unroll
            for (int u = 0; u < 4; ++u) {
#pragma unroll
                for (int i = 0; i < 16; ++i) pu[u][i] = 0.f;
#pragma unroll
                for (int d0 = 0; d0 < 4; ++d0) { const bf16x8 a = *(const LAS bf16x8*)(kp + (u >> 1) * SLOTB + (u & 1) * 512 + d0 * 2048); pu[u] = MFMA32(a, qr[d0], pu[u]); } }
            float mx = MFLOOR;
#pragma unroll
            for (int u = 0; u < 4; ++u)
#pragma unroll
                for (int r = 0; r < 16; ++r) { pu[u][r] = (32 * u + (r & 3) + 8 * (r >> 2) <= nlim) ? pu[u][r] : NEGB; mx = fmaxf(mx, pu[u][r]); }
            mx = max32x(mx);
            float ls = 0.f;
#pragma unroll
            for (int u = 0; u < 4; ++u)
#pragma unroll
                for (int r = 0; r < 16; ++r) { pu[u][r] = __builtin_amdgcn_exp2f(pu[u][r] - mx); ls += pu[u][r]; }
            ls = sum32x(ls);
            const float inv = ls > 0.f ? __builtin_amdgcn_rcpf(ls) : 0.f;
            {
                LAS float* ip = imp + ((size_t)hh * 64 + qrel) * 33;
                float prevrecv = 0.f;
#pragma unroll
                for (int u = 0; u < 4; ++u) {
#pragma unroll
                    for (int q4 = 0; q4 < 4; ++q4) { const int k = 4 * u + q4;
                        const float gs = ((pu[u][4 * q4] + pu[u][4 * q4 + 1]) + (pu[u][4 * q4 + 2] + pu[u][4 * q4 + 3])) * inv; const float le = pu[u][4 * q4 + 3] * inv;
                        const auto rr = __builtin_amdgcn_permlane32_swap(__float_as_uint(le), __float_as_uint(le), false, false);
                        const float recv = __uint_as_float(hi ? rr[0] : rr[1]);
                        const float prev = hi ? recv : prevrecv;
                        ip[2 * k + hi] = gs + prev; prevrecv = recv; }
                    PV_STEP(PACKF(pu[u], 0), 2 * u); PV_STEP(PACKF(pu[u], 1), 2 * u + 1); }
            }
            if (hi == 0) wsf[r32] = sg0 * inv;
            asm volatile("s_waitcnt lgkmcnt(0)" ::: "memory");
#pragma unroll
            for (int r = 0; r < 16; ++r) { const float w = wsf[crow(r, hi)]; otl[r * 64] = o0[r] * w; otl[(16 + r) * 64] = o1[r] * w; }
        }
        LBAR();
        attn_issue(L, zb, ZKS + 64 * g, ZVS + 64 * g, 0, qt + 1, tid, wid);
        {
            const int tok = tid >> 3, part = tid & 7;
            const LAS float* i0 = imp + (size_t)tok * 33;
            unsigned long long key[4];
#pragma unroll
            for (int q = 0; q < 4; ++q) { const int j = part + 8 * q; const float vj = ((i0[j] + i0[64 * 33 + j]) + i0[2 * 64 * 33 + j]) + i0[3 * 64 * 33 + j];
                key[q] = (j >= 1 && j <= qt - 2) ? (((unsigned long long)__float_as_uint(vj) << 32) | (unsigned)(32 - j)) : 0ull; }
            unsigned bits = 0u;
            if (qt > 7) {
#pragma unroll
                for (int round = 0; round < 5; ++round) {
                    unsigned long long m = key[0] > key[1] ? key[0] : key[1]; { const unsigned long long m2 = key[2] > key[3] ? key[2] : key[3]; m = m > m2 ? m : m2; }
                    { const unsigned long long o_ = ((unsigned long long)(unsigned)__builtin_amdgcn_update_dpp(0, (int)(m >> 32), 0xB1, 0xf, 0xf, true) << 32) | (unsigned)__builtin_amdgcn_update_dpp(0, (int)m, 0xB1, 0xf, 0xf, true); m = m > o_ ? m : o_; }
                    { const unsigned long long o_ = ((unsigned long long)(unsigned)__builtin_amdgcn_update_dpp(0, (int)(m >> 32), 0x4E, 0xf, 0xf, true) << 32) | (unsigned)__builtin_amdgcn_update_dpp(0, (int)m, 0x4E, 0xf, 0xf, true); m = m > o_ ? m : o_; }
                    { const unsigned long long o_ = ((unsigned long long)(unsigned)__builtin_amdgcn_update_dpp(0, (int)(m >> 32), 0x141, 0xf, 0xf, true) << 32) | (unsigned)__builtin_amdgcn_update_dpp(0, (int)m, 0x141, 0xf, 0xf, true); m = m > o_ ? m : o_; }
#pragma unroll
                    for (int q = 0; q < 4; ++q) { const bool hit = key[q] == m; bits |= hit ? (1u << (part + 8 * q)) : 0u; key[q] = hit ? 0ull : key[q]; }
                }
                bits |= (unsigned)__builtin_amdgcn_update_dpp(0, (int)bits, 0xB1, 0xf, 0xf, true);
                bits |= (unsigned)__builtin_amdgcn_update_dpp(0, (int)bits, 0x4E, 0xf, 0xf, true);
                bits |= (unsigned)__builtin_amdgcn_update_dpp(0, (int)bits, 0x141, 0xf, 0xf, true);
            }
            if (part == 0) sel[tok] = bits | ((qt <= 7) ? ((2u << qt) - 1u) : (1u | (1u << qt) | (1u << (qt - 1))));
        }
        LBAR();
        const unsigned selbits = sel[qrel];
        { float lsum;
          attn_branch<0, true>(L, zb, ZKS + 64 * g, ZVS + 64 * g, 0, qt, qt, qrel, selbits, qr, o0, o1, lsum, tid, wid);
          if (hi == 0) wsf[r32] = sg1 * __builtin_amdgcn_rcpf(lsum);
          asm volatile("s_waitcnt lgkmcnt(0)" ::: "memory");
#pragma unroll
          for (int r = 0; r < 16; ++r) { const float w = wsf[crow(r, hi)]; otl[r * 64] += o0[r] * w; otl[(16 + r) * 64] += o1[r] * w; } }
        { float lsum;
          attn_branch<1>(L, zb, ZKW + 64 * g, ZVW + 64 * g, qt >= 8 ? qt - 8 : 0, qt, qt, qrel, 0u, qr, o0, o1, lsum, tid, wid);
          if (hi == 0) wsf[r32] = sg2 * __builtin_amdgcn_rcpf(lsum);
          asm volatile("s_waitcnt lgkmcnt(0)" ::: "memory");
#pragma unroll
          for (int r = 0; r < 16; ++r) { const float w = wsf[crow(r, hi)]; otl[r * 64] += o0[r] * w; otl[(16 + r) * 64] += o1[r] * w; }
          asm volatile("s_waitcnt lgkmcnt(0)" ::: "memory"); }
        LBAR();
        if (U + C.G < 1024) UNIT_FETCH(U + C.G);
        const int c8 = lane * 8; const int tk0 = 64 * qt + 32 * g + 4 * wid;
        u32x4 whc[4], wbg[4], wcg[4], wpa[2], wpb[2];
        { const int tp = tk0 >= 2 ? tk0 - 2 : 0;
#pragma unroll
          for (int i = 0; i < 2; ++i) { wpa[i] = *(const u32x4*)zt(zb, tp + i, ZHC + c8); wpb[i] = *(const u32x4*)zt(zb, tp + i, ZCG + c8); }
#pragma unroll
          for (int i = 0; i < 4; ++i) { whc[i] = *(const u32x4*)zt(zb, tk0 + i, ZHC + c8); wbg[i] = *(const u32x4*)zt(zb, tk0 + i, ZBG + c8); wcg[i] = *(const u32x4*)zt(zb, tk0 + i, ZCG + c8); } }
        { const LAS float* ow = (const LAS float*)(L + AOT) + wid * 2048; const size_t rowb = (size_t)b * SEQ + 64 * qt + 32 * th;
          const int d = 8 * (lane & 7);
          const f32x4 g0 = *(const f32x4*)(gout + 64 * head + d), g1 = *(const f32x4*)(gout + 64 * head + d + 4);
#pragma unroll
          for (int i = 0; i < 4; ++i) { const int q = i * 8 + (lane >> 3);
              const LAS float* src = ow + (16 * (d >> 5) + (q & 3) + 4 * (q >> 3)) * 64 + (d & 31) + 32 * ((q >> 2) & 1);
              const f32x4 v0 = *(const LAS f32x4*)src, v1 = *(const LAS f32x4*)(src + 4);
              float ss = (v0.x * v0.x + v0.y * v0.y) + (v0.z * v0.z + v0.w * v0.w) + (v1.x * v1.x + v1.y * v1.y) + (v1.z * v1.z + v1.w * v1.w);
              ss = sum8_dpp(ss);
              const u32x4 w4 = {cvt_pk_bf16(v0.x * g0.x, v0.y * g0.y), cvt_pk_bf16(v0.z * g0.z, v0.w * g0.w), cvt_pk_bf16(v1.x * g1.x, v1.y * g1.y), cvt_pk_bf16(v1.z * g1.z, v1.w * g1.w)};
              *(u32x4*)((char*)omix + pg8::tl_off((int)(rowb + q), 64 * head + d, D)) = w4;
              if ((lane & 7) == 0) asq[(rowb + q) * 8 + head] = ss; } }
        { float w0[8], w1[8], w2[8], cb[8], gc[8];
#pragma unroll
          for (int e = 0; e < 8; ++e) { w0[e] = conv_w[c8 + e]; w1[e] = conv_w[512 + c8 + e]; w2[e] = conv_w[1024 + c8 + e]; cb[e] = conv_b[c8 + e]; gc[e] = gout[512 + c8 + e]; }
          float um2[8], um1[8];
          { float ta[8], tb[8]; const float zf = tk0 == 0 ? 0.f : 1.f;
            unpack8(wpa[0], ta); unpack8(wpb[0], tb);
#pragma unroll
            for (int e = 0; e < 8; ++e) um2[e] = ta[e] * tb[e] * zf;
            unpack8(wpa[1], ta); unpack8(wpb[1], tb);
#pragma unroll
            for (int e = 0; e < 8; ++e) um1[e] = ta[e] * tb[e] * zf; }
          float oc[4][8], s2[4];
#pragma unroll
          for (int i = 0; i < 4; ++i) {
              float hc[8], bg[8], cg[8];
              unpack8(whc[i], hc); unpack8(wbg[i], bg); unpack8(wcg[i], cg);
              s2[i] = 0.f;
#pragma unroll
              for (int e = 0; e < 8; ++e) { const float u = cg[e] * hc[e]; const float v = cb[e] + um2[e] * w0[e] + um1[e] * w1[e] + u * w2[e]; oc[i][e] = bg[e] * v; s2[i] += oc[i][e] * oc[i][e]; um2[e] = um1[e]; um1[e] = u; } }
#pragma unroll
          for (int i = 0; i < 4; ++i) s2[i] = sum64_dpp(s2[i]);
#pragma unroll
          for (int i = 0; i < 4; ++i) { const float rc = __builtin_amdgcn_rsqf(s2[i] * (1.0f / 512.0f) + EPS);
              u32x4 o;
              o.x = cvt_pk_bf16(oc[i][0] * rc * gc[0], oc[i][1] * rc * gc[1]); o.y = cvt_pk_bf16(oc[i][2] * rc * gc[2], oc[i][3] * rc * gc[3]);
              o.z = cvt_pk_bf16(oc[i][4] * rc * gc[4], oc[i][5] * rc * gc[5]); o.w = cvt_pk_bf16(oc[i][6] * rc * gc[6], oc[i][7] * rc * gc[7]);
              *(u32x4*)((char*)omix + pg8::tl_off(b * SEQ + tk0 + i, 512 + c8, D)) = o; } }
    }
#undef UNIT_FETCH
    asm volatile("s_waitcnt lgkmcnt(0)" ::: "memory"); __builtin_amdgcn_s_barrier();
    __builtin_amdgcn_s_setprio(0);
}

__global__ void __launch_bounds__(512, 2) nsa_fwd(Args args) {
    extern __shared__ __attribute__((aligned(16))) unsigned char lds[];
    Ctx C;
    C.L = (LAS unsigned char*)lds;
    C.G = gridDim.x; C.bx = blockIdx.x; { const int bx = blockIdx.x; C.vcu = (C.G % 8 == 0) ? (bx % 8) * (C.G / 8) + bx / 8 : bx; }
    for (int u = threadIdx.x; u < (LDS_BYTES - CTRL_OFF) / 4; u += 512) ((LAS unsigned*)(C.L + CTRL_OFF))[u] = 0u;
    __syncthreads();
    XcdBarrier bar = xcd_barrier_post((unsigned*)(args.ws + WS_CTL) + CW_BAR, (volatile LAS unsigned*)(C.L + MISC_OFF + 32));

#define GRID_SYNC() do { XcdBarrier b_ = bar; unsigned long long bp_ = (unsigned long long)b_.bar; unsigned bx_ = b_.x; asm volatile("" : "+s"(bp_), "+s"(bx_)); b_.bar = (unsigned*)bp_; b_.x = bx_; xcd_barrier(b_); } while (0)
    prologue(C);
    GRID_SYNC();
    prologue2(C);
    GRID_SYNC();

    for (int l = 0; l < DEPTH; ++l) {
        for (int half = 0; half < 2; ++half) {
            const int sub = half ? 2 : 0;
            { const ArgsP A = get_args(); const Ctx Cl = launder(C);
              pg8::Gemm g{(const bf16*)(A->ws + WS_H), (const bf16*)(A->ws + WS_WFI) + (size_t)(l * 2 + half) * NFI * D, M, NFI, D}; pg8::StaticOrder S; S.init(M, NFI, Cl.G, Cl.bx);
              pg8::EpiSwiGLU E{(bf16*)(A->ws + WS_ZB), FF, (const float*)(A->ws + WS_RSQ), (const float*)(A->ws + WS_SBW) + (size_t)(3 * l + sub) * NB * NFI, NFI};
              pg8::gemm_phase<pg8::EpiSwiGLU, pg8::StaticOrder, true, true>(Cl.L, g, S, E); }
            GRID_SYNC();
            { const ArgsP A = get_args(); const Ctx Cl = launder(C);
              const int nl = half ? (l < DEPTH - 1 ? l + 1 : l) : l, nsub = half ? 0 : 1;
              const float* modn = (const float*)(A->ws + WS_MOD) + (size_t)nl * NB * MODW + nsub * 3072;
              pg8::Gemm g{(const bf16*)(A->ws + WS_ZB), (const bf16*)(A->ws + WS_WFO) + (size_t)(l * 2 + half) * D * FF, M, D, FF}; pg8::StaticOrder S; S.init(M, D, Cl.G, Cl.bx);
              pg8::EpiResid E{(unsigned*)(A->ws + WS_X), (const float*)(A->ws + WS_MOD) + (size_t)l * NB * MODW + sub * 3072 + 2048,
                              (bf16*)(A->ws + WS_H), A->in[4] + (size_t)(nl * 3 + nsub) * D, modn + 1024, (float*)(A->ws + WS_RSQ), MODW, 0.5f};
              pg8::gemm_phase<pg8::EpiResid, pg8::StaticOrder, true, true>(Cl.L, g, S, E); }
            GRID_SYNC();
            if (half == 0) {
                { const ArgsP A = get_args(); const Ctx Cl = launder(C);
                  pg8::Gemm g{(const bf16*)(A->ws + WS_H), (const bf16*)(A->ws + WS_WMI) + (size_t)l * ZW * D, M, ZW, D}; pg8::StaticOrder S; S.init(M, ZW, Cl.G, Cl.bx);
                  pg8::EpiBf16Plain E{(bf16*)(A->ws + WS_ZB), ZW, (const float*)(A->ws + WS_RSQ), (const float*)(A->ws + WS_SBW) + (size_t)(3 * l + 1) * NB * NFI, NFI, 2};
                  pg8::gemm_phase<pg8::EpiBf16Plain, pg8::StaticOrder, true, true>(Cl.L, g, S, E); }
                GRID_SYNC();
                compress_phase(C, l);
                GRID_SYNC();
                attn_phase(C, l);
                GRID_SYNC();
                { const ArgsP A = get_args(); const Ctx Cl = launder(C);
                  const float* modn = (const float*)(A->ws + WS_MOD) + (size_t)l * NB * MODW + 2 * 3072;
                  pg8::Gemm g{(const bf16*)(A->ws + WS_OMIX), (const bf16*)(A->ws + WS_WMO) + (size_t)l * D * D, M, D, D}; pg8::StaticOrder S; S.init(M, D, Cl.G, Cl.bx);
                  pg8::EpiResidMix E; E.x16 = (unsigned*)(A->ws + WS_X); E.gate = (const float*)(A->ws + WS_MOD) + (size_t)l * NB * MODW + 3072 + 2048; E.hs = (bf16*)(A->ws + WS_H);
                  E.gn = A->in[4] + (size_t)(l * 3 + 2) * D; E.scale = modn + 1024; E.rowsq = (float*)(A->ws + WS_RSQ); E.mod_stride = MODW; E.coef = 1.0f; E.asq = (const float*)(A->ws + WS_ASQ);
                  pg8::gemm_phase<pg8::EpiResidMix, pg8::StaticOrder, true, true>(Cl.L, g, S, E); }
                GRID_SYNC();
            }
        }
    }
    finalnorm_phase(C);
}

extern "C" void kernel_launch(void* const* d_in, const int* in_sizes, int n_in, void* d_out, int out_size, void* d_ws, size_t ws_size, hipStream_t stream) {
    static int grid = 0;
    if (grid == 0) {
        if (n_in != 16 || in_sizes[0] != M * D || out_size != M * D || ws_size < WS_END) { fprintf(stderr, "kernel_launch: unexpected shapes (n_in %d, in0 %d, out %d, ws %zu); nothing launched\n", n_in, n_in > 0 ? in_sizes[0] : -1, out_size, ws_size); grid = -1; return; }
        int dev = 0, cus = 0;
        if (hipGetDevice(&dev) != hipSuccess || hipDeviceGetAttribute(&cus, hipDeviceAttributeMultiprocessorCount, dev) != hipSuccess) { grid = -1; return; }
        if (hipFuncSetAttribute((const void*)nsa_fwd, hipFuncAttributeMaxDynamicSharedMemorySize, LDS_BYTES) != hipSuccess) { fprintf(stderr, "kernel_launch: hipFuncSetAttribute failed\n"); grid = -1; return; }
        int per_cu = 0;
        if (hipOccupancyMaxActiveBlocksPerMultiprocessor(&per_cu, (const void*)nsa_fwd, 512, LDS_BYTES) != hipSuccess || per_cu < 1) fprintf(stderr, "kernel_launch: occupancy query reports %d\n", per_cu);
        (void)hipGetLastError();
        grid = cus;
    }
    if (grid < 0) return;
    if (hipMemsetAsync((char*)d_ws + WS_CTL, 0, CTL_ZERO_BYTES, stream) != hipSuccess) return;
    Args a{};
    for (int i = 0; i < 16; ++i) a.in[i] = (const float*)d_in[i];
    a.out = (float*)d_out; a.ws = (unsigned char*)d_ws;
    hipLaunchKernelGGL(nsa_fwd, dim3(grid), dim3(512), LDS_BYTES, stream, a);
}
```
